# Optimizing an MI355X kernel written in HIP

```python
import numpy as np
import jax
import jax.numpy as jnp
from jax import lax

D_MODEL = 1024
BATCH = 16
SEQ = 2048
DEPTH = 2

MLSTM_HEADS = 4
MLSTM_QK_DIM = 64
MLSTM_V_DIM = 128
MLSTM_CHUNK = 64
MLSTM_WIDTH = MLSTM_HEADS * MLSTM_V_DIM
SCONV_WIDTH = D_MODEL - MLSTM_WIDTH
SCONV_TAPS = 3
CONF_WIDTH = D_MODEL
CONF_TAPS = 31
N_EXPERTS = 32
TOP_K = 4
D_EXPERT = D_MODEL
SWIGLU_LIMIT = 7.0
SWIGLU_ALPHA = 1.702
EXPERT_ROWS = 128
LN_EPS = 1e-5
HEAD_NORM_EPS = 1e-6
DEEPNORM_ALPHA = (2 * DEPTH) ** 0.25
DEEPNORM_BETA = (8 * DEPTH) ** -0.25
N_EVEN = (DEPTH + 1) // 2
N_ODD = DEPTH // 2
AB_SPLIT_SIZES = (MLSTM_HEADS * MLSTM_QK_DIM, MLSTM_HEADS * MLSTM_QK_DIM, MLSTM_WIDTH, MLSTM_WIDTH,
                  MLSTM_HEADS, MLSTM_HEADS, SCONV_WIDTH, SCONV_WIDTH, SCONV_WIDTH)
AB_IN_WIDTH = sum(AB_SPLIT_SIZES)

kernel_name = 'hybrid_mlstm_shortconv_conformer_moe_deepnorm'


def layer_norm(x, g, b, eps=LN_EPS):
    xf = x.astype(jnp.float32)
    mu = jnp.mean(xf, axis=-1, keepdims=True)
    var = jnp.mean(jnp.square(xf - mu), axis=-1, keepdims=True)
    y = (xf - mu) * lax.rsqrt(var + eps) * g.astype(jnp.float32) + b.astype(jnp.float32)
    return y.astype(x.dtype)


def causal_depthwise_conv(u, w):
    taps, ch = w.shape
    return lax.conv_general_dilated(u, w[:, None, :].astype(u.dtype), window_strides=(1,),
                                    padding=[(taps - 1, 0)],
                                    dimension_numbers=('NWC', 'WIO', 'NWC'),
                                    feature_group_count=ch)


def mlstm_chunkwise(q, k, v, i_pre, f_pre):
    Bn, S, H, dk = q.shape
    dv = v.shape[-1]
    L = MLSTM_CHUNK
    NC = S // L
    q = q.reshape(Bn, NC, L, H, dk).transpose(0, 3, 1, 2, 4)
    k = k.reshape(Bn, NC, L, H, dk).transpose(0, 3, 1, 2, 4) * (dk ** -0.5)
    v = v.reshape(Bn, NC, L, H, dv).transpose(0, 3, 1, 2, 4)
    ig = i_pre.reshape(Bn, NC, L, H).transpose(0, 3, 1, 2)
    logf = jax.nn.log_sigmoid(f_pre).reshape(Bn, NC, L, H).transpose(0, 3, 1, 2)
    b = jnp.cumsum(logf, axis=-1)
    g = b[..., -1]
    a = g[..., None] - b + ig

    def step(carry, inp):
        C, n, m = carry
        k_c, v_c, a_c, g_c = inp
        m_new = jnp.maximum(g_c + m, jnp.max(a_c, axis=-1))
        decay = jnp.exp(g_c + m - m_new)
        w = jnp.exp(a_c - m_new[..., None])
        C_new = decay[..., None, None] * C + jnp.einsum('bhl,bhlk,bhlv->bhkv', w, k_c, v_c)
        n_new = decay[..., None] * n + jnp.einsum('bhl,bhlk->bhk', w, k_c)
        return (C_new, n_new, m_new), (C, n, m)

    init = (jnp.zeros((Bn, H, dk, dv), jnp.float32), jnp.zeros((Bn, H, dk), jnp.float32),
            jnp.zeros((Bn, H), jnp.float32))
    xs = (k.transpose(2, 0, 1, 3, 4), v.transpose(2, 0, 1, 3, 4), a.transpose(2, 0, 1, 3), g.transpose(2, 0, 1))
    _, (C_prev, n_prev, m_prev) = lax.scan(step, init, xs)
    C_prev = C_prev.transpose(1, 2, 0, 3, 4)
    n_prev = n_prev.transpose(1, 2, 0, 3)
    m_prev = m_prev.transpose(1, 2, 0)

    causal = jnp.tril(jnp.ones((L, L), dtype=bool))
    dmat = b[..., :, None] - b[..., None, :] + ig[..., None, :]
    dmat = jnp.where(causal, dmat, -jnp.inf)
    e_inter = b + m_prev[..., None]
    m_t = jnp.maximum(e_inter, jnp.max(dmat, axis=-1))
    w_intra = jnp.exp(dmat - m_t[..., None])
    w_inter = jnp.exp(e_inter - m_t)
    s = jnp.einsum('bhctk,bhcsk->bhcts', q, k) * w_intra
    num = w_inter[..., None] * jnp.einsum('bhctk,bhckv->bhctv', q, C_prev) + jnp.einsum('bhcts,bhcsv->bhctv', s, v)
    den = w_inter * jnp.einsum('bhctk,bhck->bhct', q, n_prev) + jnp.sum(s, axis=-1)
    h = num / jnp.maximum(jnp.abs(den), jnp.exp(-m_t))[..., None]
    return h.transpose(0, 2, 3, 1, 4).reshape(Bn, S, H, dv)


def mixer_ab(x, w_in, b_igate, b_fgate, conv_w, head_gain, w_out):
    Bn, S, _ = x.shape
    H, dk, dv = MLSTM_HEADS, MLSTM_QK_DIM, MLSTM_V_DIM
    f32 = jnp.float32
    z = x @ w_in
    cuts = np.cumsum(AB_SPLIT_SIZES)[:-1].tolist()
    q, k, v, o_pre, i_pre, f_pre, sb, sc, sx = jnp.split(z, cuts, axis=-1)
    h = mlstm_chunkwise(q.reshape(Bn, S, H, dk).astype(f32), k.reshape(Bn, S, H, dk).astype(f32),
                        v.reshape(Bn, S, H, dv).astype(f32), (i_pre + b_igate).astype(f32),
                        (f_pre + b_fgate).astype(f32))
    mu = jnp.mean(h, axis=-1, keepdims=True)
    var = jnp.mean(jnp.square(h - mu), axis=-1, keepdims=True)
    h = (h - mu) * lax.rsqrt(var + HEAD_NORM_EPS) * head_gain.reshape(H, dv).astype(f32)
    h = (jax.nn.sigmoid(o_pre.astype(f32)) * h.reshape(Bn, S, MLSTM_WIDTH)).astype(x.dtype)
    y = sb * causal_depthwise_conv(sc * sx, conv_w)
    return jnp.concatenate([h, y], axis=-1) @ w_out


def conformer_conv(x, w_pw1, w_dw, b_dw, ln_g, ln_b, w_pw2):
    a, gate = jnp.split(x @ w_pw1, 2, axis=-1)
    u = a * jax.nn.sigmoid(gate)
    u = causal_depthwise_conv(u, w_dw) + b_dw
    u = jax.nn.silu(layer_norm(u, ln_g, ln_b))
    return u @ w_pw2


def moe(x, router_w, router_b, w_up, b_up, w_down, b_down):
    Bn, S, D = x.shape
    T = Bn * S
    E, K, R = N_EXPERTS, TOP_K, EXPERT_ROWS
    xt = x.reshape(T, D)
    logits = (xt @ router_w + router_b).astype(jnp.float32)
    top_vals, top_idx = lax.top_k(logits, K)
    gates = jax.nn.softmax(top_vals, axis=-1)
    A = T * K
    e_flat = top_idx.reshape(A).astype(jnp.int32)
    tok_flat = jnp.repeat(jnp.arange(T, dtype=jnp.int32), K)
    g_flat = gates.reshape(A)
    order = jnp.argsort(e_flat)
    e_sorted = e_flat[order]
    counts = jnp.bincount(e_flat, length=E).astype(jnp.int32)
    starts = jnp.cumsum(counts) - counts
    padded = ((counts + R - 1) // R) * R
    pends = jnp.cumsum(padded)
    pstarts = pends - padded
    dest = pstarts[e_sorted] + (jnp.arange(A, dtype=jnp.int32) - starts[e_sorted])
    P = -(-(A + E * (R - 1)) // R) * R
    nb = P // R
    row_tok = jnp.full((P,), T, jnp.int32).at[dest].set(tok_flat[order])
    row_gate = jnp.zeros((P,), x.dtype).at[dest].set(g_flat[order].astype(x.dtype))
    group_expert = jnp.minimum(jnp.searchsorted(pends, jnp.arange(nb, dtype=jnp.int32) * R, side='right'),
                               E - 1).astype(jnp.int32)
    x_pad = jnp.concatenate([xt, jnp.zeros((1, D), xt.dtype)], axis=0)
    xs = x_pad[row_tok].reshape(nb, R, D)

    def expert_rows(args):
        xb, e = args
        hb = xb @ w_up[e] + b_up[e]
        glu, lin = jnp.split(hb, 2, axis=-1)
        glu = jnp.minimum(glu, SWIGLU_LIMIT)
        lin = jnp.clip(lin, -SWIGLU_LIMIT, SWIGLU_LIMIT)
        act = glu * jax.nn.sigmoid(SWIGLU_ALPHA * glu) * (lin + 1.0)
        return act @ w_down[e] + b_down[e]

    ys = lax.map(expert_rows, (xs, group_expert)).reshape(P, D)
    out = jnp.zeros((T + 1, D), x.dtype).at[row_tok].add(ys * row_gate[:, None])[:T]
    return out.reshape(Bn, S, D)


def setup_inputs(seed: int = 0) -> dict:
    key = jax.random.key(seed)
    ks = jax.random.split(key, 24)
    f32 = jnp.float32

    def nrm(k, shape, scale):
        return jax.random.normal(k, shape, f32) * scale

    D, H, E, F = D_MODEL, MLSTM_HEADS, N_EXPERTS, D_EXPERT
    beta = DEEPNORM_BETA
    x = nrm(ks[0], (BATCH, SEQ, D), 1.0)
    col_scale = jnp.concatenate([
        jnp.ones((2 * H * MLSTM_QK_DIM,), f32), jnp.full((MLSTM_WIDTH,), beta, f32),
        jnp.ones((MLSTM_WIDTH + 2 * H + 2 * SCONV_WIDTH,), f32), jnp.full((SCONV_WIDTH,), beta, f32)])
    ab_w_in = nrm(ks[1], (N_EVEN, D, AB_IN_WIDTH), D ** -0.5) * col_scale
    ab_b_igate = nrm(ks[2], (N_EVEN, H), 0.1)
    ab_b_fgate = jnp.linspace(3.0, 6.0, H, dtype=f32) + nrm(ks[3], (N_EVEN, H), 0.1)
    ab_conv_w = nrm(ks[4], (N_EVEN, SCONV_TAPS, SCONV_WIDTH), SCONV_TAPS ** -0.5)
    ab_head_gain = 1.0 + nrm(ks[5], (N_EVEN, MLSTM_WIDTH), 0.02)
    ab_w_out = nrm(ks[6], (N_EVEN, MLSTM_WIDTH + SCONV_WIDTH, D), (MLSTM_WIDTH + SCONV_WIDTH) ** -0.5 * beta)
    glu_scale = jnp.concatenate([jnp.full((CONF_WIDTH,), beta, f32), jnp.ones((CONF_WIDTH,), f32)])
    cf_w_pw1 = nrm(ks[7], (N_ODD, D, 2 * CONF_WIDTH), D ** -0.5) * glu_scale
    cf_w_dw = nrm(ks[8], (N_ODD, CONF_TAPS, CONF_WIDTH), CONF_TAPS ** -0.5)
    cf_b_dw = nrm(ks[9], (N_ODD, CONF_WIDTH), 0.02)
    cf_ln_g = 1.0 + nrm(ks[10], (N_ODD, CONF_WIDTH), 0.02)
    cf_ln_b = nrm(ks[11], (N_ODD, CONF_WIDTH), 0.02)
    cf_w_pw2 = nrm(ks[12], (N_ODD, CONF_WIDTH, D), CONF_WIDTH ** -0.5 * beta)
    router_w = nrm(ks[13], (DEPTH, D, E), D ** -0.5)
    router_b = nrm(ks[14], (DEPTH, E), 0.01)
    exp_w_up = nrm(ks[15], (DEPTH, E, D, 2 * F), D ** -0.5 * beta)
    exp_b_up = nrm(ks[16], (DEPTH, E, 2 * F), 0.02)
    exp_w_down = nrm(ks[17], (DEPTH, E, F, D), F ** -0.5 * beta)
    exp_b_down = nrm(ks[18], (DEPTH, E, D), 0.02)
    post_ln_g = 1.0 + nrm(ks[19], (DEPTH, 2, D), 0.02)
    post_ln_b = nrm(ks[20], (DEPTH, 2, D), 0.02)
    return {'x': x, 'ab_w_in': ab_w_in, 'ab_b_igate': ab_b_igate, 'ab_b_fgate': ab_b_fgate,
            'ab_conv_w': ab_conv_w, 'ab_head_gain': ab_head_gain, 'ab_w_out': ab_w_out,
            'cf_w_pw1': cf_w_pw1, 'cf_w_dw': cf_w_dw, 'cf_b_dw': cf_b_dw, 'cf_ln_g': cf_ln_g,
            'cf_ln_b': cf_ln_b, 'cf_w_pw2': cf_w_pw2, 'router_w': router_w, 'router_b': router_b,
            'exp_w_up': exp_w_up, 'exp_b_up': exp_b_up, 'exp_w_down': exp_w_down, 'exp_b_down': exp_b_down,
            'post_ln_g': post_ln_g, 'post_ln_b': post_ln_b}


def reference(x, ab_w_in, ab_b_igate, ab_b_fgate, ab_conv_w, ab_head_gain, ab_w_out,
              cf_w_pw1, cf_w_dw, cf_b_dw, cf_ln_g, cf_ln_b, cf_w_pw2,
              router_w, router_b, exp_w_up, exp_b_up, exp_w_down, exp_b_down,
              post_ln_g, post_ln_b):
    for layer in range(DEPTH):
        j = layer // 2
        if layer % 2 == 0:
            h = mixer_ab(x, ab_w_in[j], ab_b_igate[j], ab_b_fgate[j], ab_conv_w[j], ab_head_gain[j], ab_w_out[j])
        else:
            h = conformer_conv(x, cf_w_pw1[j], cf_w_dw[j], cf_b_dw[j], cf_ln_g[j], cf_ln_b[j], cf_w_pw2[j])
        x = layer_norm(DEEPNORM_ALPHA * x + h, post_ln_g[layer, 0], post_ln_b[layer, 0])
        f = moe(x, router_w[layer], router_b[layer], exp_w_up[layer], exp_b_up[layer],
                exp_w_down[layer], exp_b_down[layer])
        x = layer_norm(DEEPNORM_ALPHA * x + f, post_ln_g[layer, 1], post_ln_b[layer, 1])
    return x
```

```cpp
#include <hip/hip_runtime.h>
#include <cstdio>

#ifndef MK_PER_PHASE
#define MK_PER_PHASE 0
#endif
#define GAS __attribute__((address_space(1)))
#define LAS __attribute__((address_space(3)))
typedef unsigned short bf16;
typedef unsigned v4u __attribute__((ext_vector_type(4)));
typedef unsigned v2u __attribute__((ext_vector_type(2)));
typedef float f32x4 __attribute__((ext_vector_type(4)));
typedef float f32x2 __attribute__((ext_vector_type(2)));
typedef short bf16x8 __attribute__((ext_vector_type(8)));
typedef int i32x4 __attribute__((ext_vector_type(4)));
typedef int i32x8 __attribute__((ext_vector_type(8)));
#define LDS_WAIT() asm volatile("s_waitcnt lgkmcnt(0)" ::: "memory")
#define VM_WAIT() asm volatile("s_waitcnt vmcnt(0)" ::: "memory")
#define LBAR() do { asm volatile("s_waitcnt lgkmcnt(0)" ::: "memory"); __builtin_amdgcn_s_barrier(); asm volatile("" ::: "memory"); } while (0)

__device__ __forceinline__ unsigned cvt_pk_bf16(float lo, float hi) { unsigned r; asm volatile("v_cvt_pk_bf16_f32 %0, %1, %2" : "=v"(r) : "v"(lo), "v"(hi)); return r; }
__device__ __forceinline__ unsigned cvt_pk_bf16_nv(float lo, float hi) { unsigned r; asm("v_cvt_pk_bf16_f32 %0, %1, %2" : "=v"(r) : "v"(lo), "v"(hi)); return r; }
__device__ __forceinline__ unsigned pk4_fp8(float a, float b, float c, float d) { unsigned w = 0u; w = (unsigned)__builtin_amdgcn_cvt_pk_fp8_f32(a, b, (int)w, false); w = (unsigned)__builtin_amdgcn_cvt_pk_fp8_f32(c, d, (int)w, true); return w; }
__device__ __forceinline__ __amdgpu_buffer_rsrc_t mk_rsrc(const void* p, unsigned bytes) { return __builtin_amdgcn_make_buffer_rsrc((void*)p, 0, (int)bytes, 0x00020000); }
__device__ __forceinline__ unsigned f2bf(float f) { unsigned u = __builtin_bit_cast(unsigned, f); return (u + 0x7fffu + ((u >> 16) & 1u)) >> 16; }
__device__ __forceinline__ unsigned pk2(float lo, float hi) { return f2bf(lo) | (f2bf(hi) << 16); }
__device__ __forceinline__ float bflo(unsigned w) { return __builtin_bit_cast(float, w << 16); }
__device__ __forceinline__ float bfhi(unsigned w) { return __builtin_bit_cast(float, w & 0xffff0000u); }
__device__ __forceinline__ float bf1(unsigned short b) { return __builtin_bit_cast(float, ((unsigned)b) << 16); }
__device__ __forceinline__ float sigmoidf_(float x) { return __builtin_amdgcn_rcpf(1.0f + __expf(-x)); }

namespace pg8 {
constexpr int BM = 256, BK = 64, HALF = 128, HTB = HALF * BK * 2, STAGE_BYTES = 8 * HTB, NXCD = 8, WGM = 8, KD = 1024;
constexpr int BIAS_OFF = 136192;
__host__ __device__ __forceinline__ int lds_byte(int r, int c) { const int st = (r >> 4) * 2 + (c >> 5), rr = r & 15, cc = c & 31, ob = rr * 64 + cc * 2; return st * 1024 + (ob ^ (((ob >> 9) & 1) << 5)); }
__host__ __device__ __forceinline__ void stage_rc(int b, int& R, int& C) { const int st = b / 1024, sb = b % 1024, swz = sb ^ (((sb >> 9) & 1) << 5); R = (st >> 1) * 16 + swz / 64; C = (st & 1) * 32 + (swz % 64) / 2; }
__host__ __device__ __forceinline__ int perm32(int rho) { const int n = rho >> 4, i = rho & 15; return 8 * (i >> 2) + 4 * n + (i & 3); }
struct Unit { int pm, pn; };

template <bool GROUPED> struct Order {
    int nM, nN, nwg, G, c; const char* A; const char* Bt; size_t bexp, tstep; const LAS int* texp;
    __device__ __forceinline__ void init(int nM_, int nN_, int G_, int c_) { nM = nM_; nN = nN_; nwg = nM * nN; G = G_; c = c_; tstep = (size_t)(BM * KD * 2); }
    __device__ __forceinline__ bool next(int i, Unit& u) const {
        const long L = (long)i * G + c; if (L >= nwg) return false;
        int wgid = (int)L; { const int q = nwg / NXCD, r = nwg % NXCD, xcd = wgid % NXCD, off = wgid / NXCD; wgid = (xcd < r ? xcd * (q + 1) : r * (q + 1) + (xcd - r) * q) + off; }
        const int nig = WGM * nN, gid = wgid / nig, fm = gid * WGM, gsz = (nM - fm) < WGM ? (nM - fm) : WGM;
        u.pm = fm + ((wgid % nig) % gsz); u.pn = (wgid % nig) / gsz; return true;
    }
    __device__ __forceinline__ const char* aptr(const Unit& u) const { return A + (size_t)u.pm * tstep; }
    __device__ __forceinline__ const char* bptr(const Unit& u) const { return Bt + (GROUPED ? (size_t)texp[u.pm] * bexp : (size_t)0) + (size_t)u.pn * tstep; }
};

struct EpiZ {
    static constexpr int PERM = 2, NBIAS = 0;
    bf16* O; int ldc;
    __device__ __forceinline__ void operator()(const f32x4 (&acc)[2][2][4][2], const Unit& u, int wr, int wc, int fr, int fq, const LAS float* lb) const {
        const int row0 = u.pm * BM + wr * 64 + fr, col0 = u.pn * BM + wc * 64 + 16 * fq;
#pragma unroll
        for (int ai = 0; ai < 2; ++ai)
#pragma unroll
            for (int m = 0; m < 4; ++m) { bf16* rowp = O + (size_t)(row0 + ai * HALF + m * 16) * ldc + col0;
#pragma unroll
                for (int bj = 0; bj < 2; ++bj) { const f32x4 v0 = acc[ai][bj][m][0], v1 = acc[ai][bj][m][1];
                    v4u w; w.x = cvt_pk_bf16(v0[0], v0[1]); w.y = cvt_pk_bf16(v0[2], v0[3]); w.z = cvt_pk_bf16(v1[0], v1[1]); w.w = cvt_pk_bf16(v1[2], v1[3]);
                    *(v4u*)(rowp + bj * 8) = w; } }
    }
};
template <bool BASE_BF16> struct EpiRes {
    static constexpr int PERM = 2, NBIAS = 0;
    const void* base; bf16* out; float alpha;
    __device__ __forceinline__ void operator()(const f32x4 (&acc)[2][2][4][2], const Unit& u, int wr, int wc, int fr, int fq, const LAS float* lb) const {
        const int row0 = u.pm * BM + wr * 64 + fr, col0 = u.pn * BM + wc * 64 + 16 * fq;
#pragma unroll
        for (int ai = 0; ai < 2; ++ai) {
            f32x4 b0[4][2], b1[4][2];
#pragma unroll
            for (int m = 0; m < 4; ++m) { const size_t off = (size_t)(row0 + ai * HALF + m * 16) * 1024 + col0;
#pragma unroll
                for (int bj = 0; bj < 2; ++bj) {
                    if constexpr (BASE_BF16) { const v4u bw = *(const v4u*)((const bf16*)base + off + bj * 8); b0[m][bj] = __builtin_bit_cast(f32x4, bw); }
                    else { b0[m][bj] = *(const f32x4*)((const float*)base + off + bj * 8); b1[m][bj] = *(const f32x4*)((const float*)base + off + bj * 8 + 4); } } }
            __builtin_amdgcn_sched_barrier(0);
#pragma unroll
            for (int m = 0; m < 4; ++m) { const size_t off = (size_t)(row0 + ai * HALF + m * 16) * 1024 + col0;
#pragma unroll
                for (int bj = 0; bj < 2; ++bj) { f32x4 c0, c1;
                    if constexpr (BASE_BF16) { const v4u bw = __builtin_bit_cast(v4u, b0[m][bj]); c0 = (f32x4){bflo(bw.x), bfhi(bw.x), bflo(bw.y), bfhi(bw.y)}; c1 = (f32x4){bflo(bw.z), bfhi(bw.z), bflo(bw.w), bfhi(bw.w)}; }
                    else { c0 = b0[m][bj]; c1 = b1[m][bj]; }
                    const f32x4 v0 = c0 * alpha + acc[ai][bj][m][0], v1 = c1 * alpha + acc[ai][bj][m][1];
                    v4u w; w.x = cvt_pk_bf16(v0[0], v0[1]); w.y = cvt_pk_bf16(v0[2], v0[3]); w.z = cvt_pk_bf16(v1[0], v1[1]); w.w = cvt_pk_bf16(v1[2], v1[3]);
                    *(v4u*)(out + off + bj * 8) = w; } }
        }
    }
};
struct EpiSwiglu8 {
    static constexpr int PERM = 1, NBIAS = 256;
    unsigned char* O; const float* bias; const LAS int* texp; float inscale;
    __device__ __forceinline__ const float* bias_src(const Unit& u, int i) const { return bias + (size_t)texp[u.pm] * 2048 + (i >> 7) * 1024 + u.pn * HALF + (i & 127); }
    __device__ __forceinline__ void operator()(const f32x4 (&acc)[2][2][4][2], const Unit& u, int wr, int wc, int fr, int fq, const LAS float* lb) const {
        const int row0 = u.pm * BM + wr * 64 + fr, jc = u.pn * HALF + wc * 32 + 8 * fq;
        const LAS float* bp = lb + wc * 32 + 8 * fq; const float s1 = inscale, s4 = 4.0f * inscale; const __amdgpu_buffer_rsrc_t rs = mk_rsrc(O, 0x7fffff00u);
        f32x4 bg[2], bl[2];
#pragma unroll
        for (int n = 0; n < 2; ++n) { bg[n] = *(const LAS f32x4*)(bp + 4 * n); bl[n] = *(const LAS f32x4*)(bp + 128 + 4 * n) * 4.0f + 4.0f; }
#pragma unroll
        for (int ai = 0; ai < 2; ++ai)
#pragma unroll
            for (int m = 0; m < 4; ++m) { const unsigned ob = (unsigned)(row0 + ai * HALF + m * 16) * 1024u + (unsigned)jc; float r[8];
#pragma unroll
                for (int n = 0; n < 2; ++n) { const f32x4 g4 = acc[ai][0][m][n] * s1 + bg[n], l4 = acc[ai][1][m][n] * s4 + bl[n];
#pragma unroll
                    for (int p = 0; p < 2; ++p) {
                        const f32x2 g2 = (f32x2){fminf(g4[2 * p], 7.0f), fminf(g4[2 * p + 1], 7.0f)}, l2 = (f32x2){__builtin_amdgcn_fmed3f(l4[2 * p], -24.0f, 32.0f), __builtin_amdgcn_fmed3f(l4[2 * p + 1], -24.0f, 32.0f)};
                        const f32x2 t2 = g2 * -2.45546696f; const f32x2 d2 = (f32x2){__builtin_amdgcn_exp2f(t2[0]), __builtin_amdgcn_exp2f(t2[1])} + 1.0f;
                        const f32x2 q2 = (f32x2){__builtin_amdgcn_rcpf(d2[0]), __builtin_amdgcn_rcpf(d2[1])}; const f32x2 r2 = (g2 * l2) * q2;
                        r[4 * n + 2 * p] = r2[0]; r[4 * n + 2 * p + 1] = r2[1]; } }
                v2u w; w.x = pk4_fp8(r[0], r[1], r[2], r[3]); w.y = pk4_fp8(r[4], r[5], r[6], r[7]);
                __builtin_amdgcn_raw_buffer_store_b64(w, rs, (int)ob, 0, 16); }
    }
};
struct EpiBiasG8 {
    static constexpr int PERM = 2, NBIAS = 256;
    unsigned char* O; const float* bias; const LAS int* texp; float inscale;
    __device__ __forceinline__ const float* bias_src(const Unit& u, int i) const { return bias + (size_t)texp[u.pm] * 1024 + u.pn * BM + i; }
    __device__ __forceinline__ void operator()(const f32x4 (&acc)[2][2][4][2], const Unit& u, int wr, int wc, int fr, int fq, const LAS float* lb) const {
        const int row0 = u.pm * BM + wr * 64 + fr, col0 = u.pn * BM + wc * 64 + 16 * fq;
        const LAS float* bp = lb + wc * 64 + 16 * fq; const float s16 = 16.0f * inscale;
        f32x4 bv[2][2];
#pragma unroll
        for (int bj = 0; bj < 2; ++bj)
#pragma unroll
            for (int n = 0; n < 2; ++n) bv[bj][n] = *(const LAS f32x4*)(bp + bj * 8 + 4 * n) * 16.0f;
#pragma unroll
        for (int ai = 0; ai < 2; ++ai)
#pragma unroll
            for (int m = 0; m < 4; ++m) { unsigned char* rowp = O + (size_t)(row0 + ai * HALF + m * 16) * 1024 + col0; v4u w;
                { const f32x4 v0 = acc[ai][0][m][0] * s16 + bv[0][0], v1 = acc[ai][0][m][1] * s16 + bv[0][1]; w.x = pk4_fp8(v0[0], v0[1], v0[2], v0[3]); w.y = pk4_fp8(v1[0], v1[1], v1[2], v1[3]); }
                { const f32x4 v0 = acc[ai][1][m][0] * s16 + bv[1][0], v1 = acc[ai][1][m][1] * s16 + bv[1][1]; w.z = pk4_fp8(v0[0], v0[1], v0[2], v0[3]); w.w = pk4_fp8(v1[0], v1[1], v1[2], v1[3]); }
                *(v4u*)rowp = w; }
    }
};
struct EpiGlu {
    static constexpr int PERM = 1, NBIAS = 0;
    bf16* O;
    __device__ __forceinline__ void operator()(const f32x4 (&acc)[2][2][4][2], const Unit& u, int wr, int wc, int fr, int fq, const LAS float* lb) const {
        const int row0 = u.pm * BM + wr * 64 + fr, jc = u.pn * HALF + wc * 32 + 8 * fq;
#pragma unroll
        for (int ai = 0; ai < 2; ++ai)
#pragma unroll
            for (int m = 0; m < 4; ++m) { bf16* rowp = O + (size_t)(row0 + ai * HALF + m * 16) * 1024 + jc; float r[8];
#pragma unroll
                for (int n = 0; n < 2; ++n) { const f32x4 a4 = acc[ai][0][m][n], g4 = acc[ai][1][m][n];
#pragma unroll
                    for (int p = 0; p < 2; ++p) {
                        const f32x2 t2 = (f32x2){g4[2 * p], g4[2 * p + 1]} * -1.44269504f; const f32x2 d2 = (f32x2){__builtin_amdgcn_exp2f(t2[0]), __builtin_amdgcn_exp2f(t2[1])} + 1.0f;
                        const f32x2 r2 = (f32x2){a4[2 * p], a4[2 * p + 1]} * (f32x2){__builtin_amdgcn_rcpf(d2[0]), __builtin_amdgcn_rcpf(d2[1])};
                        r[4 * n + 2 * p] = r2[0]; r[4 * n + 2 * p + 1] = r2[1]; } }
                v4u w; w.x = cvt_pk_bf16(r[0], r[1]); w.y = cvt_pk_bf16(r[2], r[3]); w.z = cvt_pk_bf16(r[4], r[5]); w.w = cvt_pk_bf16(r[6], r[7]);
                *(v4u*)rowp = w; }
    }
};

__device__ __forceinline__ bf16x8 lo8(i32x8 v) { return __builtin_bit_cast(bf16x8, (i32x4)__builtin_shufflevector(v, v, 0, 1, 2, 3)); }
__device__ __forceinline__ bf16x8 hi8(i32x8 v) { return __builtin_bit_cast(bf16x8, (i32x4)__builtin_shufflevector(v, v, 4, 5, 6, 7)); }
struct Hand { unsigned* cnt; unsigned* tot; unsigned expect; };
template <class Epi, class Sched, bool ALIGN_EPI = true, bool FP8 = false, bool GATHER = false, int HANDOFF = 0  >
__device__ __forceinline__ void gemm_phase(LAS unsigned char* lds, const Sched& S, const Epi& E, const LAS unsigned short* rowtab = nullptr, const Hand hand = Hand{nullptr, nullptr, 0u}) {
    const int tid = threadIdx.x, wid = __builtin_amdgcn_readfirstlane(tid >> 6), lane = tid & 63, wr = wid >> 2, wc = wid & 3, fr = lane & 15, fq = lane >> 4;
    constexpr int ROWB = FP8 ? KD : KD * 2, nt = ROWB / (BK * 2);
    unsigned voffB[2][2], offC[2][2], offN[2][2]; int rA[2], cA2[2];
#pragma unroll
    for (int i = 0; i < 2; ++i) { int R, C; stage_rc(tid * 16 + i * 8192, R, C); const int Rb = (Epi::PERM == 1) ? ((R & ~31) + perm32(R & 31)) : R;
        rA[i] = R; cA2[i] = C * 2;
#pragma unroll
        for (int bj = 0; bj < 2; ++bj) { int grow;
            if constexpr (Epi::PERM == 2) { const int wc_ = R >> 5, rho = R & 31; grow = 64 * wc_ + 16 * ((rho & 15) >> 2) + 8 * bj + 4 * (rho >> 4) + (rho & 3); }
            else grow = bj * HALF + Rb;
            voffB[bj][i] = (unsigned)(grow * ROWB + C * 2); }
#pragma unroll
        for (int h = 0; h < 2; ++h) { offC[h][i] = (unsigned)((h * HALF + R) * ROWB + C * 2); offN[h][i] = offC[h][i]; } }
#define PG8_GOFF(dst, unit_idx) do { if constexpr (GATHER) { _Pragma("unroll") for (int h_ = 0; h_ < 2; ++h_) _Pragma("unroll") for (int i_ = 0; i_ < 2; ++i_) \
        dst[h_][i_] = (unsigned)rowtab[(unit_idx) * 256 + h_ * HALF + rA[i_]] * (unsigned)ROWB + (unsigned)cA2[i_]; } } while (0)
    constexpr size_t kstep = (size_t)(BK * 2);
    constexpr size_t hstep = (size_t)HALF * ROWB;
    const unsigned ldsw = (unsigned)wid * 1024u;
    const int aoff = lds_byte(wr * 64 + fr, fq * 8), boff = lds_byte(wc * 32 + fr, fq * 8);
#define PG8_SA(b, h) (((b) * 2 + (h)) * HTB)
#define PG8_SB(b, h) ((4 + (b) * 2 + (h)) * HTB)
#define PG8_STAGE(bufoff, gbase, voff) do { _Pragma("unroll") for (int _i = 0; _i < 2; ++_i) \
        __builtin_amdgcn_global_load_lds((const unsigned*)((const char*)(gbase) + (voff)[_i]), (LAS unsigned*)(lds + (bufoff) + ldsw + _i * 8192), 16, 0, 0); } while (0)
#define PG8_LDA(dst, b, h) do { _Pragma("unroll") for (int m = 0; m < 4; ++m) { const i32x4 x_ = *(const LAS i32x4*)(lds + PG8_SA(b, h) + aoff + m * 2048), y_ = *(const LAS i32x4*)(lds + PG8_SA(b, h) + aoff + m * 2048 + 1024); dst[m] = __builtin_shufflevector(x_, y_, 0, 1, 2, 3, 4, 5, 6, 7); } } while (0)
#define PG8_LDB(dst, b, h) do { _Pragma("unroll") for (int n = 0; n < 2; ++n) { const i32x4 x_ = *(const LAS i32x4*)(lds + PG8_SB(b, h) + boff + n * 2048), y_ = *(const LAS i32x4*)(lds + PG8_SB(b, h) + boff + n * 2048 + 1024); dst[n] = __builtin_shufflevector(x_, y_, 0, 1, 2, 3, 4, 5, 6, 7); } } while (0)
#define PG8_MMA(ai, bj, At, Bt) do { __builtin_amdgcn_s_setprio(1); _Pragma("unroll") for (int m = 0; m < 4; ++m) _Pragma("unroll") for (int n = 0; n < 2; ++n) { \
        if constexpr (FP8) asm volatile("s_nop 1\n\tv_mfma_scale_f32_16x16x128_f8f6f4 %0, %1, %2, %0, %3, %3 op_sel_hi:[0,0,0]" : "+v"(acc[ai][bj][m][n]) : "v"(Bt[n]), "v"(At[m]), "v"(sc127)); \
        else { acc[ai][bj][m][n] = __builtin_amdgcn_mfma_f32_16x16x32_bf16(lo8(Bt[n]), lo8(At[m]), acc[ai][bj][m][n], 0, 0, 0); acc[ai][bj][m][n] = __builtin_amdgcn_mfma_f32_16x16x32_bf16(hi8(Bt[n]), hi8(At[m]), acc[ai][bj][m][n], 0, 0, 0); } } __builtin_amdgcn_s_setprio(0); } while (0)
#define PG8_WAIT_V(n) asm volatile("s_waitcnt vmcnt(" #n ")" ::: "memory")
#define PG8_WAIT_L(n) asm volatile("s_waitcnt lgkmcnt(" #n ")" ::: "memory")
#define PG8_BAR __builtin_amdgcn_s_barrier()
#define PG8_SCHED __builtin_amdgcn_sched_barrier(0)
#define PG8_SCHED8 do { } while (0)
    Unit cur, nxt; int ui = 0;
    if (!S.next(0, cur)) return;
    int prev_pm = -1; bool all_done = false;
#define PG8_AREADY(u_) do { if constexpr (HANDOFF == 2) { if (wid == 0 && !all_done) { \
            all_done = (unsigned)__builtin_amdgcn_readfirstlane((int)__hip_atomic_load(hand.tot, __ATOMIC_RELAXED, __HIP_MEMORY_SCOPE_AGENT)) >= hand.expect;     \
            if (!all_done) { unsigned spins_ = 0u; \
                while ((unsigned)__builtin_amdgcn_readfirstlane((int)__hip_atomic_load(hand.cnt + 64 * (u_).pm, __ATOMIC_RELAXED, __HIP_MEMORY_SCOPE_AGENT)) < 64u) { __builtin_amdgcn_s_sleep(2); if (++spins_ > (1u << 22)) break; } } } \
        asm volatile("" ::: "memory"); __builtin_amdgcn_s_barrier(); asm volatile("" ::: "memory"); } } while (0)
    f32x4 acc[2][2][4][2];
#pragma unroll
    for (int a = 0; a < 2; ++a)
#pragma unroll
        for (int b = 0; b < 2; ++b)
#pragma unroll
            for (int m = 0; m < 4; ++m)
#pragma unroll
                for (int n = 0; n < 2; ++n) acc[a][b][m][n] = (f32x4){0.f, 0.f, 0.f, 0.f};
    i32x8 At[4], B0[2], B1[2];
    const int sc127 = 127;
    const char* cA = GATHER ? S.A : S.aptr(cur); const char* cB = S.bptr(cur);
    PG8_GOFF(offC, 0);
    PG8_AREADY(cur);
    PG8_STAGE(PG8_SB(0, 0), cB, voffB[0]); PG8_STAGE(PG8_SB(0, 1), cB, voffB[1]); PG8_STAGE(PG8_SA(0, 0), cA, offC[0]); PG8_STAGE(PG8_SA(0, 1), cA, offC[1]);
    if (wr == 1) PG8_BAR;
    PG8_WAIT_V(2); PG8_BAR;
    PG8_STAGE(PG8_SB(1, 0), cB + kstep, voffB[0]); PG8_STAGE(PG8_SA(1, 0), cA + kstep, offC[0]); PG8_STAGE(PG8_SB(1, 1), cB + kstep, voffB[1]);
    PG8_WAIT_V(6); PG8_BAR;
    for (;;) {
        if constexpr (Epi::NBIAS != 0) { if (wid < 4) {
            __builtin_amdgcn_global_load_lds((const unsigned*)E.bias_src(cur, wid * 64 + lane), (LAS unsigned*)(lds + BIAS_OFF + (ui & 1) * 1024 + wid * 256), 4, 0, 0); } }
        const bool has_next = S.next(ui + 1, nxt);
        const char* nA = GATHER ? cA : (has_next ? S.aptr(nxt) : cA); const char* nB = has_next ? S.bptr(nxt) : cB;
        if constexpr (GATHER) { if (has_next) PG8_GOFF(offN, ui + 1); else {
#pragma unroll
            for (int h = 0; h < 2; ++h) { offN[h][0] = offC[h][0]; offN[h][1] = offC[h][1]; } } }
#pragma nounroll
        for (int t = 0; t < nt; t += 2) {
            const bool last = (t == nt - 2);
            if (last && has_next) PG8_AREADY(nxt);
            const char* a1 = cA + (size_t)(t + 1) * kstep;
            const char* a2 = last ? nA : cA + (size_t)(t + 2) * kstep; const char* b2 = last ? nB : cB + (size_t)(t + 2) * kstep;
            const char* a3 = a2 + kstep; const char* b3 = b2 + kstep;
            unsigned o2[2][2];
#pragma unroll
            for (int h = 0; h < 2; ++h) { o2[h][0] = (GATHER && last) ? offN[h][0] : offC[h][0]; o2[h][1] = (GATHER && last) ? offN[h][1] : offC[h][1]; }
            PG8_LDB(B0, 0, 0); PG8_LDB(B1, 0, 1); PG8_SCHED; PG8_LDA(At, 0, 0); PG8_STAGE(PG8_SA(1, 1), a1, offC[1]);
            PG8_WAIT_V(8); PG8_WAIT_L(0); PG8_BAR; PG8_SCHED8; PG8_MMA(0, 0, At, B0); PG8_MMA(0, 1, At, B1); PG8_BAR; PG8_SCHED;
            PG8_LDA(At, 0, 1); PG8_STAGE(PG8_SB(0, 0), b2, voffB[0]); PG8_STAGE(PG8_SB(0, 1), b2, voffB[1]); PG8_STAGE(PG8_SA(0, 0), a2, o2[0]);
            PG8_WAIT_V(8); PG8_WAIT_L(0); PG8_BAR; PG8_SCHED8; PG8_MMA(1, 0, At, B0); PG8_MMA(1, 1, At, B1); PG8_BAR; PG8_SCHED;
            PG8_LDB(B0, 1, 0); PG8_LDB(B1, 1, 1); PG8_SCHED; PG8_LDA(At, 1, 0); PG8_STAGE(PG8_SA(0, 1), a2, o2[1]);
            PG8_WAIT_V(8); PG8_WAIT_L(0); PG8_BAR; PG8_SCHED8; PG8_MMA(0, 0, At, B0); PG8_MMA(0, 1, At, B1); PG8_BAR; PG8_SCHED;
            PG8_LDA(At, 1, 1); PG8_STAGE(PG8_SB(1, 0), b3, voffB[0]); PG8_STAGE(PG8_SB(1, 1), b3, voffB[1]); PG8_STAGE(PG8_SA(1, 0), a3, o2[0]);
            PG8_WAIT_V(8); PG8_WAIT_L(0); PG8_BAR; PG8_SCHED8; PG8_MMA(1, 0, At, B0); PG8_MMA(1, 1, At, B1); PG8_BAR; PG8_SCHED;
        }
        if constexpr (HANDOFF == 1) { if (prev_pm >= 0 && lane == 0) {
            __hip_atomic_fetch_add(hand.cnt + 64 * prev_pm, 1u, __ATOMIC_RELAXED, __HIP_MEMORY_SCOPE_AGENT); } prev_pm = cur.pm; }
        if constexpr (ALIGN_EPI) { if (wr == 0) PG8_BAR; }
        if constexpr (FP8) asm volatile("s_nop 15\n\ts_nop 15" ::: "memory");
        E(acc, cur, wr, wc, fr, fq, (const LAS float*)(lds + BIAS_OFF + (ui & 1) * 1024));
        if (!has_next) break;
#pragma unroll
        for (int a = 0; a < 2; ++a)
#pragma unroll
            for (int b = 0; b < 2; ++b)
#pragma unroll
                for (int m = 0; m < 4; ++m)
#pragma unroll
                    for (int n = 0; n < 2; ++n) acc[a][b][m][n] = (f32x4){0.f, 0.f, 0.f, 0.f};
        cur = nxt; cA = nA; cB = nB; ++ui;
        if constexpr (GATHER) {
#pragma unroll
            for (int h = 0; h < 2; ++h) { offC[h][0] = offN[h][0]; offC[h][1] = offN[h][1]; } }
        if constexpr (ALIGN_EPI) { if (wr == 1) PG8_BAR; }
    }
    PG8_WAIT_V(0);
    if constexpr (HANDOFF == 1) { if (lane == 0) { __hip_atomic_fetch_add(hand.cnt + 64 * prev_pm, 1u, __ATOMIC_RELAXED, __HIP_MEMORY_SCOPE_AGENT); } }
    if constexpr (!ALIGN_EPI) { if (wr == 0) PG8_BAR; }
    PG8_BAR;
#undef PG8_SA
#undef PG8_SB
#undef PG8_STAGE
#undef PG8_LDA
#undef PG8_LDB
#undef PG8_MMA
#undef PG8_WAIT_V
#undef PG8_WAIT_L
#undef PG8_BAR
#undef PG8_SCHED
#undef PG8_SCHED8
#undef PG8_GOFF
#undef PG8_AREADY
}

}

constexpr int NWAVES = 8;
constexpr int T = 32768, D = 1024, SEQ = 2048, NB = 16;
constexpr int NZ = 3072;
constexpr int ZQ = 0, ZK = 256, ZV = 512, ZO = 1024, ZSB = 1536, ZSC = 2048, ZSX = 2560;
constexpr int NE = 32, TOPK = 4;
constexpr int PROWS = 139264;
constexpr float ALPHA = 1.41421356237309515f;
constexpr float LN_EPS = 1e-5f, HEAD_EPS = 1e-6f;
constexpr int NPH = 17;

constexpr size_t MiB = 1u << 20;
constexpr size_t WS_CTL = 0, CTL_ZERO_BYTES = 1 * MiB;
constexpr size_t WS_TOPI = 1 * MiB, WS_TOPG = WS_TOPI + MiB / 2, WS_SLOT = 2 * MiB, WS_CNTT = WS_SLOT + MiB / 2, WS_META = WS_CNTT + MiB / 4, WS_GATES = 3 * MiB;
constexpr size_t WS_RWH = 4 * MiB, WS_RWL = WS_RWH + MiB / 4, WS_RGB = WS_RWL + MiB / 4, WS_STATS = 5 * MiB, WS_WSC = 6 * MiB, WS_ROWTOK = 7 * MiB;
constexpr size_t WS_WIN = 8 * MiB, WS_WOUT = 14 * MiB, WS_PW1 = 16 * MiB, WS_PW2 = 20 * MiB, WS_UP = 22 * MiB, WS_DN = 278 * MiB;
constexpr size_t WS_ABF = 406 * MiB, WS_X1B = 470 * MiB, WS_HCAT = 534 * MiB, WS_R = 598 * MiB;
constexpr size_t WS_ACT = 1254 * MiB, WS_YS = 1526 * MiB, WS_Z = 1798 * MiB, WS_U = 1798 * MiB, WS_V = 1862 * MiB, WS_END = 1990 * MiB;
static_assert((size_t)PROWS * 2048 <= 272 * MiB, "grouped buffers");
constexpr int CW_LBAR = 8192, CW_MAPX = 12288;
constexpr int CW_BAR = 4096, CW_QUEUE = 64, Q_CHUNK = 8, CW_UPCNT = 32768, UPCNT_LAYER = 544 * 64, CW_UPTOT = 110592;

constexpr int RING_BYTES = 131072;
constexpr int LDSCTL_OFF = 139264, MISC_OFF = LDSCTL_OFF + 320;
constexpr int TEXP_OFF = 132096;
constexpr int ROWTAB_OFF = 147456;
constexpr int LDS_BYTES = 147456 + 20 * 512;
static_assert(TEXP_OFF + 4096 <= LDSCTL_OFF && MISC_OFF + 128 <= LDS_BYTES, "LDS map");

#define XB_TMO      128
#define XB_XCNT(j)  (256  + 64 * (j))
#define XB_XSUB(j)  (1280 + 64 * (j))
#define XB_XGEN(j)  (2304 + 64 * (j))
#define XB_TOP      3328
#define XB_TOPGEN   3392
#define XCD_BAR_WORDS 3456
#define XB_SPIN_CAP (1u << 18)
__device__ __forceinline__ unsigned xb_ld(unsigned* p)              { return __hip_atomic_load(p, __ATOMIC_RELAXED, __HIP_MEMORY_SCOPE_AGENT); }
__device__ __forceinline__ unsigned xb_add(unsigned* p, unsigned v) { return __hip_atomic_fetch_add(p, v, __ATOMIC_RELAXED, __HIP_MEMORY_SCOPE_AGENT); }
__device__ __forceinline__ unsigned xb_xcc_id() { return (unsigned)__builtin_amdgcn_s_getreg((3 << 11) | 20) & 0xFu; }
#define XB_SPIN(cond, bar) do { unsigned _sp = 0; while (cond) { __builtin_amdgcn_s_sleep(1); \
    if ((++_sp & 255u) == 0u) { if (xb_ld(&(bar)[XB_TMO])) break; if (_sp > XB_SPIN_CAP) { atomicAdd(&(bar)[XB_TMO], 1u); break; } } } } while (0)
struct XcdBarrier { unsigned* bar; unsigned x; volatile LAS unsigned* st; };
__device__ __forceinline__ XcdBarrier xcd_barrier_post(unsigned* bar, volatile LAS unsigned* st) {
    XcdBarrier b; b.bar = bar; b.x = xb_xcc_id(); b.st = st;
    if (threadIdx.x == 0) (void)xb_add(&bar[XB_XCNT(b.x)], 1u);
    return b;
}
__device__ __forceinline__ void xcd_barrier_complete(unsigned* bar, unsigned x, unsigned& nloc, unsigned& nx) {
    const unsigned G = gridDim.x * gridDim.y * gridDim.z;
    unsigned sum, cnt, mine, sp = 0u;
    for (;;) {
        sum = 0u; cnt = 0u; mine = 0u;
#pragma unroll
        for (unsigned j = 0; j < 16; ++j) { const unsigned c = xb_ld(&bar[XB_XCNT(j)]); sum += c; cnt += (c > 0u) ? 1u : 0u; mine = (j == x) ? c : mine; }
        if (sum == G) break;
        __builtin_amdgcn_s_sleep(1);
        if ((++sp & 255u) == 0u) { if (xb_ld(&bar[XB_TMO])) break; if (sp > XB_SPIN_CAP) { atomicAdd(&bar[XB_TMO], 1u); break; } }
    }
    nloc = mine > 0u ? mine : 1u; nx = cnt > 0u ? cnt : 1u;
}
__device__ __forceinline__ void xcd_barrier(const XcdBarrier& b) {
    asm volatile("s_waitcnt vmcnt(0)" ::: "memory");
    __syncthreads();
    if (threadIdx.x == 0) {
        unsigned* bar = b.bar;
        __builtin_amdgcn_s_waitcnt(0);
        unsigned nloc = b.st[0], nx = b.st[1];
        if (nloc == 0u) { xcd_barrier_complete(bar, b.x, nloc, nx); b.st[0] = nloc; b.st[1] = nx; }
        const unsigned old = xb_add(&bar[XB_XSUB(b.x)], 1u);
        const unsigned gen = old / nloc;
        if (old + 1u == (gen + 1u) * nloc) {
            __builtin_amdgcn_fence(__ATOMIC_RELEASE, "agent");
            asm volatile("s_waitcnt vmcnt(0)" ::: "memory");
            const unsigned og = xb_add(&bar[XB_TOP], 1u);
            const unsigned tg = og / nx;
            if (og + 1u == (tg + 1u) * nx) xb_add(&bar[XB_TOPGEN], 1u);
            else XB_SPIN(xb_ld(&bar[XB_TOPGEN]) == tg, bar);
            __builtin_amdgcn_fence(__ATOMIC_ACQUIRE, "agent");
            xb_add(&bar[XB_XGEN(b.x)], 1u);
            asm volatile("s_waitcnt vmcnt(0)" ::: "memory");
        } else {
            XB_SPIN(xb_ld(&bar[XB_XGEN(b.x)]) == gen, bar);
            __builtin_amdgcn_fence(__ATOMIC_ACQUIRE, "agent");
            asm volatile("s_waitcnt vmcnt(0)" ::: "memory");
        }
    }
    __syncthreads();
}

__device__ __forceinline__ void xcd_local_barrier(const XcdBarrier& b, unsigned* lb) {
    asm volatile("s_waitcnt vmcnt(0)" ::: "memory");
    __syncthreads();
    if (threadIdx.x == 0) {
        __builtin_amdgcn_s_waitcnt(0);
        const unsigned nloc = b.st[0];
        const unsigned old = xb_add(&lb[64 * b.x], 1u), gen = old / nloc;
        if (old + 1u == (gen + 1u) * nloc) (void)xb_add(&lb[1024 + 64 * b.x], 1u);
        else XB_SPIN(xb_ld(&lb[1024 + 64 * b.x]) == gen, b.bar);
        __builtin_amdgcn_fence(__ATOMIC_ACQUIRE, "agent");
        asm volatile("s_waitcnt vmcnt(0)" ::: "memory");
    }
    __syncthreads();
}

struct Args { const float* in[21]; float* out; unsigned char* ws; int ph_lo, ph_hi; };
struct Frame {
    LAS unsigned char* lds;
    int tid, lane, wave, vcu, G;
    bool own;
    unsigned char* ws;
};
__device__ __forceinline__ float wave_sum(float v) {
#pragma unroll
    for (int o = 1; o < 64; o <<= 1) v += __shfl_xor(v, o);
    return v;
}
__device__ __forceinline__ float wave_max(float v) {
#pragma unroll
    for (int o = 1; o < 64; o <<= 1) v = fmaxf(v, __shfl_xor(v, o));
    return v;
}

struct TrItem { const float* src; bf16* dst; int ld; float scale; int fp8; };
__device__ __forceinline__ void tr_load(const TrItem& I, int lane, f32x4 (&tv)[8]) {
#pragma unroll
    for (int i = 0; i < 8; ++i) tv[i] = *(const GAS f32x4*)(I.src + (size_t)((lane >> 3) + 8 * i) * I.ld + 4 * (lane & 7));
}
__device__ __forceinline__ void tr_store(const TrItem& I, const f32x4 (&tv)[8], LAS float* scr, int lane) {
#pragma unroll
    for (int i = 0; i < 8; ++i) { LAS float* p = scr + ((lane >> 3) + 8 * i) * 33 + 4 * (lane & 7); p[0] = tv[i][0]; p[1] = tv[i][1]; p[2] = tv[i][2]; p[3] = tv[i][3]; }
    LDS_WAIT(); asm volatile("" ::: "memory");
    const int c = lane & 7; const float scale = I.scale;
#pragma unroll
    for (int j = 0; j < 4; ++j) { const int n = (lane >> 3) + 8 * j; const LAS float* s = scr + (8 * c) * 33 + n;
        if (I.fp8) { v2u o; o.x = pk4_fp8(s[0 * 33] * scale, s[1 * 33] * scale, s[2 * 33] * scale, s[3 * 33] * scale); o.y = pk4_fp8(s[4 * 33] * scale, s[5 * 33] * scale, s[6 * 33] * scale, s[7 * 33] * scale);
            *(GAS v2u*)((unsigned char*)I.dst + (size_t)n * 1024 + 8 * c) = o; }
        else { v4u o; o.x = cvt_pk_bf16(s[0 * 33] * scale, s[1 * 33] * scale); o.y = cvt_pk_bf16(s[2 * 33] * scale, s[3 * 33] * scale); o.z = cvt_pk_bf16(s[4 * 33] * scale, s[5 * 33] * scale); o.w = cvt_pk_bf16(s[6 * 33] * scale, s[7 * 33] * scale);
            *(GAS v4u*)(I.dst + (size_t)n * 1024 + 8 * c) = o; } }
    LDS_WAIT(); asm volatile("" ::: "memory");
}
__device__ __forceinline__ int glu_src_col(int d0) { const int pn = d0 >> 8, j0 = d0 & 255; return j0 < 128 ? 128 * pn + j0 : 1024 + 128 * pn + (j0 - 128); }

constexpr int I_IN = 16 * 96, I_OUT = 16 * 32, I_PW1 = 16 * 64, I_PW2 = 16 * 32, I_UP = 64 * 1024, I_DN = 64 * 512;
constexpr int I_EARLY = I_IN + I_OUT, NITEMS = I_IN + I_OUT + I_PW1 + I_PW2 + I_UP + I_DN;
#ifndef MK_P0_ITEMS
#define MK_P0_ITEMS 0
#endif
constexpr int I_P0 = I_EARLY + MK_P0_ITEMS;
__device__ __forceinline__ TrItem tr_decode(Frame& F, const Args& A, int it, const float (&wsc)[4]) {
    bf16* WIN = (bf16*)(F.ws + WS_WIN); bf16* WOUT = (bf16*)(F.ws + WS_WOUT); bf16* PW1 = (bf16*)(F.ws + WS_PW1); bf16* PW2 = (bf16*)(F.ws + WS_PW2);
    bf16* UP = (bf16*)(F.ws + WS_UP); bf16* DN = (bf16*)(F.ws + WS_DN);
    TrItem I; I.scale = 1.0f; I.fp8 = 0; int r = it;
    if (r < I_IN) { const int kb = r / 96, nb = r % 96, d0 = 32 * nb, sc0 = d0 + (d0 >= 1536 ? 8 : 0); I.scale = (d0 >= 256 && d0 < 512) ? 0.125f : 1.0f;
        I.src = A.in[1] + (size_t)kb * 64 * 3080 + sc0; I.ld = 3080; I.dst = WIN + (size_t)d0 * 1024 + kb * 64; return I; } r -= I_IN;
    if (r < I_OUT) { const int kb = r >> 5, nb = r & 31; I.src = A.in[6] + (size_t)kb * 64 * 1024 + 32 * nb; I.ld = 1024; I.dst = WOUT + (size_t)(32 * nb) * 1024 + kb * 64; return I; } r -= I_OUT;
    if (r < I_PW1) { const int kb = r >> 6, nb = r & 63, d0 = 32 * nb; I.src = A.in[7] + (size_t)kb * 64 * 2048 + glu_src_col(d0); I.ld = 2048; I.dst = PW1 + (size_t)d0 * 1024 + kb * 64; return I; } r -= I_PW1;
    if (r < I_PW2) { const int kb = r >> 5, nb = r & 31; I.src = A.in[12] + (size_t)kb * 64 * 1024 + 32 * nb; I.ld = 1024; I.dst = PW2 + (size_t)(32 * nb) * 1024 + kb * 64; return I; } r -= I_PW2;
    if (r < I_UP) { const int le = r >> 10, rr = r & 1023, kb = rr >> 6, nb = rr & 63, d0 = 32 * nb;
        I.src = A.in[15] + (size_t)le * 1024 * 2048 + (size_t)kb * 64 * 2048 + glu_src_col(d0); I.ld = 2048;
        I.fp8 = 1; I.scale = (le >> 5) ? wsc[2] : wsc[0]; I.dst = (bf16*)((unsigned char*)UP + (size_t)le * 2048 * 1024 + (size_t)d0 * 1024 + kb * 64); return I; } r -= I_UP;
    { const int le = r >> 9, rr = r & 511, kb = rr >> 5, nb = rr & 31;
        I.src = A.in[17] + (size_t)le * 1024 * 1024 + (size_t)kb * 64 * 1024 + 32 * nb; I.ld = 1024;
        I.fp8 = 1; I.scale = (le >> 5) ? wsc[3] : wsc[1]; I.dst = (bf16*)((unsigned char*)DN + (size_t)le * 1024 * 1024 + (size_t)(32 * nb) * 1024 + kb * 64); return I; }
}
__device__ __forceinline__ void convert_items(Frame& F, const Args& A, int first, int last, int w0, int nw, const float (&wsc)[4]) {
    LAS float* scr = (LAS float*)(F.lds + F.wave * 17408); LAS float* scr2 = scr + 2176;
    int it = first + w0; if (it >= last) return;
    f32x4 ta[8], tb[8];
    TrItem a = tr_decode(F, A, it, wsc), b = a; tr_load(a, F.lane, ta);
    for (;;) {
        const int itb = it + nw; const bool hb = itb < last;
        b = tr_decode(F, A, hb ? itb : it, wsc); tr_load(b, F.lane, tb);
        tr_store(a, ta, scr, F.lane);
        if (!hb) break;
        const int ita = itb + nw; const bool ha = ita < last;
        a = tr_decode(F, A, ha ? ita : itb, wsc); tr_load(a, F.lane, ta);
        tr_store(b, tb, scr2, F.lane);
        if (!ha) break;
        it = ita;
    }
}

constexpr int XT_UP = 64 * 128, XT_DN = 64 * 64, XT_ALL = XT_UP + XT_DN;
struct XTask { const float* lsrc; unsigned char* dst; int N; float scale; };
__device__ __forceinline__ int xt_task(int q) { return q < 4096 ? q : (q < 6144 ? XT_UP + (q - 4096) : (q < 10240 ? 4096 + (q - 6144) : q)); }
__device__ __forceinline__ XTask xt_setup(Frame& F, const Args& A, int t, float sc_up0, float sc_dn0, float sc_up1, float sc_dn1) {
    XTask X; const float* src; const int r2 = F.lane >> 5, c = F.lane & 31;
    if (t < XT_UP) { const int le = t >> 7, r = t & 127, ks = r >> 4, nb = r & 15, c0 = nb * 128; X.N = 2048; X.scale = (le >> 5) ? sc_up1 : sc_up0;
        const int d0 = (c0 < 1024) ? 2 * c0 : 2 * (c0 - 1024) + 128;
        src = A.in[15] + (size_t)le * 1024 * 2048 + (size_t)(ks * 128) * 2048 + c0;
        X.dst = (unsigned char*)(F.ws + WS_UP) + (size_t)le * 2048 * 1024 + (size_t)d0 * 1024 + ks * 128; }
    else { const int tt = t - XT_UP, le = tt >> 6, r = tt & 63, ks = r >> 3, nb = r & 7; X.N = 1024; X.scale = (le >> 5) ? sc_dn1 : sc_dn0;
        src = A.in[17] + (size_t)le * 1024 * 1024 + (size_t)(ks * 128) * 1024 + nb * 128;
        X.dst = (unsigned char*)(F.ws + WS_DN) + (size_t)le * 1024 * 1024 + (size_t)(nb * 128) * 1024 + ks * 128; }
    X.lsrc = src + (size_t)(64 * r2) * X.N + 4 * c;
    return X;
}

__device__ __forceinline__ float sample_scale(const float* w, int lane) {
    float a = 0.f;
#pragma unroll 4
    for (int i = 0; i < 16; ++i) { const f32x4 v = *(const GAS f32x4*)(w + 4 * lane + 256 * i); a = fmaxf(a, fmaxf(fmaxf(fabsf(v[0]), fabsf(v[1])), fmaxf(fabsf(v[2]), fabsf(v[3])))); }
    a = wave_max(a); return (a > 0.f) ? ldexpf(1.0f, 4 - ilogbf(a)) : 1.0f;
}
constexpr int NSMALL = (I_PW1 + I_PW2) / Q_CHUNK;
#ifndef MK_XT_DEFER
#define MK_XT_DEFER 4800
#endif
constexpr int XT_DEFER = MK_XT_DEFER;
static_assert(XT_DEFER >= 0 && XT_DEFER <= 6144, "only layer-1 tasks can be deferred");
static_assert(MK_P0_ITEMS == 0 && (I_PW1 + I_PW2) % Q_CHUNK == 0, "queue layout");
__device__ __forceinline__ void convert_queue(Frame& F, const Args& A, int qword, int qbase, int QEND) {
    unsigned* qhead = (unsigned*)(F.ws + WS_CTL) + CW_QUEUE + 16 * qword;
    float wsc[4];
#pragma unroll
    for (int i = 0; i < 4; ++i) wsc[i] = ((const float*)(F.ws + WS_WSC))[i];
    int pos;
    for (;;) { unsigned pos_ = 0u; if (F.lane == 0) pos_ = __hip_atomic_fetch_add(qhead, 1u, __ATOMIC_RELAXED, __HIP_MEMORY_SCOPE_AGENT);
        pos = qbase + (int)__builtin_amdgcn_readfirstlane(pos_); if (pos >= NSMALL || pos >= QEND) break;
        convert_items(F, A, I_EARLY + pos * Q_CHUNK, I_EARLY + (pos + 1) * Q_CHUNK, 0, 1, wsc); }
    if (pos >= QEND) return;
    const int lane = F.lane, r2 = lane >> 5, c = lane & 31;
    LAS unsigned char* tile = F.lds + F.wave * 17408;
    f32x4 va[16], vb[16];
#define XT_LOAD(v_, X_, st_) do { _Pragma("unroll") for (int i_ = 0; i_ < 16; ++i_) v_[i_] = __builtin_nontemporal_load((const GAS f32x4*)(X_.lsrc + (size_t)((st_) * 16 + i_) * X_.N)); } while (0)
#define XT_PUT(v_, X_, st_) do { const float sc_ = X_.scale; _Pragma("unroll") for (int j_ = 0; j_ < 4; ++j_) { v4u o_; \
        o_.x = pk4_fp8(v_[0][j_] * sc_, v_[1][j_] * sc_, v_[2][j_] * sc_, v_[3][j_] * sc_); o_.y = pk4_fp8(v_[4][j_] * sc_, v_[5][j_] * sc_, v_[6][j_] * sc_, v_[7][j_] * sc_); \
        o_.z = pk4_fp8(v_[8][j_] * sc_, v_[9][j_] * sc_, v_[10][j_] * sc_, v_[11][j_] * sc_); o_.w = pk4_fp8(v_[12][j_] * sc_, v_[13][j_] * sc_, v_[14][j_] * sc_, v_[15][j_] * sc_); \
        *(LAS v4u*)(tile + (4 * c + j_) * 128 + (((4 * r2 + (st_)) ^ (c & 7)) << 4)) = o_; } } while (0)
    XTask cur = xt_setup(F, A, xt_task(pos - NSMALL), wsc[0], wsc[1], wsc[2], wsc[3]);
    XT_LOAD(va, cur, 0); XT_LOAD(vb, cur, 1);
    for (;;) {
        unsigned np_ = (unsigned)QEND; if (lane == 0) np_ = (unsigned)qbase + __hip_atomic_fetch_add(qhead, 1u, __ATOMIC_RELAXED, __HIP_MEMORY_SCOPE_AGENT);
        XT_PUT(va, cur, 0); XT_LOAD(va, cur, 2); XT_PUT(vb, cur, 1); XT_LOAD(vb, cur, 3); XT_PUT(va, cur, 2); XT_PUT(vb, cur, 3);
        const int npos = (int)__builtin_amdgcn_readfirstlane(np_); const bool has_next = npos < QEND;
        XTask nxt = cur;
        if (has_next) { nxt = xt_setup(F, A, xt_task(npos - NSMALL), wsc[0], wsc[1], wsc[2], wsc[3]); XT_LOAD(va, nxt, 0); XT_LOAD(vb, nxt, 1); }
        LDS_WAIT(); asm volatile("" ::: "memory");
#pragma unroll
        for (int i = 0; i < 16; ++i) { const int n = 8 * i + (lane >> 3), ch = lane & 7;
            const v4u w_ = *(const LAS v4u*)(tile + n * 128 + ((ch ^ ((n >> 2) & 7)) << 4));
            __builtin_nontemporal_store(w_, (GAS v4u*)(cur.dst + (size_t)n * 1024 + ch * 16)); }
        LDS_WAIT(); asm volatile("" ::: "memory");
        if (!has_next) break;
        cur = nxt; pos = npos;
    }
#undef XT_LOAD
#undef XT_PUT
}
__device__ __forceinline__ void p0_prologue(Frame& F, const Args& A) {
    const int gw = F.vcu * NWAVES + F.wave, NGW = F.G * NWAVES;
    for (int le = gw; le < 64; le += NGW) { const int l = le >> 5, e = le & 31; const float* rw = A.in[13] + (size_t)l * 1024 * 32; const float* lg = A.in[19] + (size_t)(l * 2) * D; const float* lb = A.in[20] + (size_t)(l * 2) * D;
        bf16* RWH = (bf16*)(F.ws + WS_RWH) + (size_t)le * 1024; bf16* RWL = (bf16*)(F.ws + WS_RWL) + (size_t)le * 1024; float sG = 0.f, sB = 0.f;
        for (int i = 0; i < 16; ++i) { const int d = F.lane + 64 * i; const float w0 = rw[d * 32 + e]; const float wv = lg[d] * w0; const unsigned hi = f2bf(wv); const unsigned lo = f2bf(wv - bf1((unsigned short)hi));
            RWH[d] = (unsigned short)hi; RWL[d] = (unsigned short)lo; sG += wv; sB += lb[d] * w0; }
        sG = wave_sum(sG); sB = wave_sum(sB);
        if (F.lane == 0) { float* RGB = (float*)(F.ws + WS_RGB); RGB[l * 64 + e] = sG; RGB[l * 64 + 32 + e] = sB + A.in[14][l * 32 + e]; } }
    static_assert(MK_P0_ITEMS <= I_PW1 + I_PW2 + 32 * 1024, "P0 may only convert layer-0 up-projection weights among the expert weights");
    if (gw >= 64 && gw < 68) { const int l = (gw - 64) >> 1, dn = (gw - 64) & 1; const float sc = sample_scale(dn ? A.in[17] + (size_t)l * 32 * 1024 * 1024 : A.in[15] + (size_t)l * 32 * 1024 * 2048, F.lane);
        if (F.lane == 0) ((float*)(F.ws + WS_WSC))[l * 2 + dn] = sc; }
    { const float w0s = sample_scale(A.in[15], F.lane); const float wsc[4] = {w0s, 0.f, 0.f, 0.f};
      convert_items(F, A, 0, I_P0, gw, NGW, wsc); }
    __syncthreads();
    LAS float* Wg = (LAS float*)F.lds;
    for (int idx = F.tid; idx < 8192; idx += NWAVES * 64) { const int k = idx >> 3, g = idx & 7; Wg[g * 1024 + k] = A.in[1][(size_t)k * 3080 + 1536 + g]; }
    __syncthreads();
    bf16* XB = (bf16*)(F.ws + WS_ABF); float* GATES = (float*)(F.ws + WS_GATES);
    const float bias_l = F.lane < 4 ? A.in[2][F.lane & 3] : A.in[3][F.lane & 3];
    f32x4 vn[4];
    if (gw < T) { const GAS f32x4* xr = (const GAS f32x4*)(A.in[0] + (size_t)gw * D) + F.lane;
#pragma unroll
        for (int j = 0; j < 4; ++j) vn[j] = xr[64 * j]; }
    for (int m = gw; m < T; m += NGW) {
        f32x4 v[4];
#pragma unroll
        for (int j = 0; j < 4; ++j) v[j] = vn[j];
        if (m + NGW < T) { const GAS f32x4* xr = (const GAS f32x4*)(A.in[0] + (size_t)(m + NGW) * D) + F.lane;
#pragma unroll
            for (int j = 0; j < 4; ++j) vn[j] = xr[64 * j]; }
        GAS v2u* o8 = (GAS v2u*)(XB + (size_t)m * D) + F.lane;
#pragma unroll
        for (int j = 0; j < 4; ++j) { v2u w; w.x = cvt_pk_bf16(v[j][0], v[j][1]); w.y = cvt_pk_bf16(v[j][2], v[j][3]); o8[64 * j] = w; }
        float mine = 0.f;
#pragma unroll
        for (int g = 0; g < 8; ++g) { float s = 0.f;
#pragma unroll
            for (int j = 0; j < 4; ++j) { const f32x4 w = *(const LAS f32x4*)(Wg + g * 1024 + 4 * F.lane + 256 * j); s += (v[j][0] * w[0] + v[j][1] * w[1]) + (v[j][2] * w[2] + v[j][3] * w[3]); }
            s = wave_sum(s); mine = (F.lane == g) ? s : mine; }
        if (F.lane < 8) { float val = mine + bias_l; if (F.lane >= 4) val = fminf(val, 0.f) - log1pf(__expf(-fabsf(val))); GATES[(size_t)m * 8 + F.lane] = val; }
    }
}

#define DPPF(old_, src_, ctrl_, rmask_) __builtin_bit_cast(float, __builtin_amdgcn_update_dpp(__builtin_bit_cast(int, (float)(old_)), __builtin_bit_cast(int, (float)(src_)), (ctrl_), (rmask_), 0xf, false))
__device__ __forceinline__ float row16_sum(float x) { x += DPPF(0.f, x, 0x128, 0xf); x += DPPF(0.f, x, 0x124, 0xf); x += DPPF(0.f, x, 0x122, 0xf); x += DPPF(0.f, x, 0x121, 0xf); return x; }
__device__ __forceinline__ float scan_add64(float x) { x += DPPF(0.f, x, 0x111, 0xf); x += DPPF(0.f, x, 0x112, 0xf); x += DPPF(0.f, x, 0x114, 0xf); x += DPPF(0.f, x, 0x118, 0xf);
    x += DPPF(0.f, x, 0x142, 0xa); x += DPPF(0.f, x, 0x143, 0xc); return x; }
__device__ __forceinline__ float scan_max64(float x) { const float ni = -INFINITY;
    x = fmaxf(x, DPPF(ni, x, 0x111, 0xf)); x = fmaxf(x, DPPF(ni, x, 0x112, 0xf)); x = fmaxf(x, DPPF(ni, x, 0x114, 0xf)); x = fmaxf(x, DPPF(ni, x, 0x118, 0xf));
    x = fmaxf(x, DPPF(ni, x, 0x142, 0xa)); x = fmaxf(x, DPPF(ni, x, 0x143, 0xc)); return x; }
__device__ __forceinline__ float lane63(float x) { return __builtin_bit_cast(float, __builtin_amdgcn_readlane(__builtin_bit_cast(int, x), 63)); }
__device__ __forceinline__ int swz16(int r, int c) { return r * 144 + ((((c >> 3) ^ ((r >> 3) & 7))) << 4) + (c & 7) * 2; }
__device__ __forceinline__ void mlstm_item(Frame& F, const Args& A, int item2) {
    const int item = item2 >> 1, T0 = 32 * (item2 & 1);
    const int b = item >> 2, h = item & 3, tid = F.tid, lane = F.lane, w = F.wave;
    LAS unsigned char* L = F.lds;
    constexpr int P = 144, PO = 272;
    constexpr int QS = 0, KS = QS + 64 * P, VT = KS + 64 * P, KW = VT + 128 * P, CT = KW + 64 * P, SS = CT + 128 * P, OS = SS + 64 * P, HS = OS + 64 * PO, FA = HS + 64 * PO;
    LAS float* fa = (LAS float*)(L + FA);
    constexpr int BV = 0, UV = 64, MT = 128, WI = 192, WL = 256, EI = 320, NP = 384, QNP = 448, RS = 960, HSUM = 1216, HSQ = 1344, SCAL = 1472;
    static_assert(FA + 1480 * 4 <= RING_BYTES, "mlstm LDS");
    const bf16* Z = (const bf16*)(F.ws + WS_Z); const float* GATES = (const float*)(F.ws + WS_GATES); bf16* HCAT = (bf16*)(F.ws + WS_HCAT);
    int fr_ = lane & 15, fq_ = lane >> 4; const int fr = lane & 15;
    for (int i = tid; i < 128 * P / 4; i += 512) ((LAS unsigned*)(L + CT))[i] = 0u;
    if (tid < 64) fa[NP + tid] = 0.f;
    f32x4 accC[4];
#pragma unroll
    for (int j = 0; j < 4; ++j) accC[j] = (f32x4){0.f, 0.f, 0.f, 0.f};
    float m_prev = 0.f;
    float gain[2];
#pragma unroll
    for (int j = 0; j < 2; ++j) gain[j] = A.in[5][h * 128 + 16 * ((w >> 1) * 2 + j) + fr];
    int srow_ = tid >> 3, spc_ = tid & 7;
    int vrow0_ = tid >> 4, vpc_ = tid & 15;
    const int srow = tid >> 3, spc = tid & 7, vrow0 = tid >> 4, vpc = tid & 15;
    struct StageRegs { v4u q, k, v[2], o; float ig, lf; };
    StageRegs sA, sB; sA.ig = sA.lf = sB.ig = sB.lf = 0.f; sA.q = sB.q = (v4u){0u, 0u, 0u, 0u};
    const size_t zb = (size_t)(b * SEQ) * NZ;
#define MLSTM_LOAD(RS, c) do { const size_t t0 = (size_t)(c) * 64; \
        if (tid < 256) RS.q = *(const GAS v4u*)(Z + zb + (t0 + T0 + srow) * NZ + ZQ + h * 64 + spc * 8); \
        RS.k = *(const GAS v4u*)(Z + zb + (t0 + srow) * NZ + ZK + h * 64 + spc * 8); \
        _Pragma("unroll") for (int i = 0; i < 2; ++i) RS.v[i] = *(const GAS v4u*)(Z + zb + (t0 + vrow0 + 32 * i) * NZ + ZV + h * 128 + vpc * 8); \
        RS.o = *(const GAS v4u*)(Z + zb + (t0 + T0 + vrow0) * NZ + ZO + h * 128 + vpc * 8); \
        if (tid < 64) { RS.ig = GATES[((size_t)(b * SEQ) + t0 + tid) * 8 + h]; RS.lf = GATES[((size_t)(b * SEQ) + t0 + tid) * 8 + 4 + h]; } } while (0)
#define MLSTM_SCALARS(RS) do { if (w == 0) { \
            const float bcum = scan_add64(RS.lf); \
            const float g_ = lane63(bcum); const float u_ = RS.ig - bcum; const float cm = scan_max64(u_); \
            const float a_ = g_ + u_, amax = lane63(scan_max64(a_)); const float m_new = fmaxf(g_ + m_prev, amax); const float mt_ = bcum + fmaxf(m_prev, cm); \
            fa[BV + lane] = bcum; fa[UV + lane] = u_; fa[MT + lane] = mt_; fa[WI + lane] = __expf(bcum + m_prev - mt_); fa[WL + lane] = __expf(a_ - m_new); fa[EI + lane] = __expf(-mt_); \
            if (lane == 0) fa[SCAL] = __expf(g_ + m_prev - m_new); \
            m_prev = m_new; } } while (0)
    MLSTM_LOAD(sA, 0); MLSTM_LOAD(sB, 1);
    MLSTM_SCALARS(sA);
    __syncthreads();
    auto chunk = [&](StageRegs& RSC, StageRegs& RSN, const int cc) __attribute__((always_inline)) {
        asm volatile("" : "+v"(fr_), "+v"(fq_), "+v"(srow_), "+v"(spc_), "+v"(vrow0_), "+v"(vpc_));
        const int fr = fr_, fq = fq_, srow = srow_, spc = spc_, vrow0 = vrow0_, vpc = vpc_;
        if (tid < 256) *(LAS v4u*)(L + QS + srow * P + spc * 16) = RSC.q;
        *(LAS v4u*)(L + KS + srow * P + spc * 16) = RSC.k;
        *(LAS v4u*)(L + OS + vrow0 * PO + vpc * 16) = RSC.o;
#pragma unroll
        for (int i = 0; i < 2; ++i) { const int s = vrow0 + 32 * i;
            const unsigned ww[4] = {RSC.v[i].x, RSC.v[i].y, RSC.v[i].z, RSC.v[i].w};
#pragma unroll
            for (int e = 0; e < 8; ++e) { const unsigned short val = (unsigned short)((e & 1) ? (ww[e >> 1] >> 16) : (ww[e >> 1] & 0xffffu)); *(LAS unsigned short*)(L + VT + swz16(vpc * 8 + e, s)) = val; } }
        if (cc + 2 < 32) MLSTM_LOAD(RSC, cc + 2);
        LBAR();
        { const v4u kk = *(const LAS v4u*)(L + KS + srow * P + spc * 16); const float wl = fa[WL + srow]; const unsigned ww[4] = {kk.x, kk.y, kk.z, kk.w};
#pragma unroll
          for (int e = 0; e < 8; ++e) { const float kv = (e & 1) ? bfhi(ww[e >> 1]) : bflo(ww[e >> 1]); *(LAS unsigned short*)(L + KW + swz16(spc * 8 + e, srow)) = (unsigned short)f2bf(kv * wl); } }
        { const int tr = w >> 2, tc = w & 3; f32x4 acc = (f32x4){0.f, 0.f, 0.f, 0.f};
#pragma unroll
          for (int ks = 0; ks < 2; ++ks) { const bf16x8 qa = *(const LAS bf16x8*)(L + QS + (16 * tr + fr) * P + ks * 64 + fq * 16); const bf16x8 kb = *(const LAS bf16x8*)(L + KS + (16 * tc + fr) * P + ks * 64 + fq * 16);
              acc = __builtin_amdgcn_mfma_f32_16x16x32_bf16(qa, kb, acc, 0, 0, 0); }
          const int s = 16 * tc + fr; const float us = fa[UV + s]; float rs[4];
#pragma unroll
          for (int r = 0; r < 4; ++r) { const int tl = 16 * tr + 4 * fq + r, t = T0 + tl; const float wgt = (s <= t) ? __expf(fa[BV + t] - fa[MT + t] + us) : 0.f; const float val = acc[r] * wgt;
              *(LAS unsigned short*)(L + SS + tl * P + s * 2) = (unsigned short)f2bf(val); rs[r] = val; }
#pragma unroll
          for (int r = 0; r < 4; ++r) rs[r] = row16_sum(rs[r]);
          if (fr == 0) {
#pragma unroll
              for (int r = 0; r < 4; ++r) fa[RS + tc * 64 + 16 * tr + 4 * fq + r] = rs[r]; } }
        if (tid < 256) { const int t = tid & 31, p = tid >> 5; const v4u qq = *(const LAS v4u*)(L + QS + t * P + p * 16); const unsigned ww[4] = {qq.x, qq.y, qq.z, qq.w}; float s = 0.f;
#pragma unroll
          for (int e = 0; e < 8; ++e) s += ((e & 1) ? bfhi(ww[e >> 1]) : bflo(ww[e >> 1])) * fa[NP + 8 * p + e];
          fa[QNP + p * 64 + t] = s; }
        LBAR();
        const int tr4 = w & 1, hf = w >> 1;
        f32x4 hv[2];
        { f32x4 ai_[2], as_[2];
#pragma unroll
          for (int j = 0; j < 2; ++j) { ai_[j] = (f32x4){0.f, 0.f, 0.f, 0.f}; as_[j] = (f32x4){0.f, 0.f, 0.f, 0.f}; }
#pragma unroll
          for (int ks = 0; ks < 2; ++ks) { const bf16x8 qa = *(const LAS bf16x8*)(L + QS + (16 * tr4 + fr) * P + ks * 64 + fq * 16); const bf16x8 sa = *(const LAS bf16x8*)(L + SS + (16 * tr4 + fr) * P + ks * 64 + fq * 16);
#pragma unroll
            for (int j = 0; j < 2; ++j) { const int dv = 16 * (hf * 2 + j) + fr; const bf16x8 cb = *(const LAS bf16x8*)(L + CT + dv * P + ks * 64 + fq * 16); const bf16x8 vb = *(const LAS bf16x8*)(L + VT + dv * P + (((ks * 4 + fq) ^ ((dv >> 3) & 7)) << 4));
                ai_[j] = __builtin_amdgcn_mfma_f32_16x16x32_bf16(qa, cb, ai_[j], 0, 0, 0); as_[j] = __builtin_amdgcn_mfma_f32_16x16x32_bf16(sa, vb, as_[j], 0, 0, 0); } }
          float s1[4], s2[4];
#pragma unroll
          for (int r = 0; r < 4; ++r) { const int tl = 16 * tr4 + 4 * fq + r, t = T0 + tl; float qn = 0.f;
#pragma unroll
            for (int p = 0; p < 8; ++p) qn += fa[QNP + p * 64 + tl];
            const float wi = fa[WI + t]; const float den = wi * qn + ((fa[RS + tl] + fa[RS + 64 + tl]) + (fa[RS + 128 + tl] + fa[RS + 192 + tl]));
            const float inv = 1.0f / fmaxf(fabsf(den), fa[EI + t]); float a1 = 0.f, a2 = 0.f;
#pragma unroll
            for (int j = 0; j < 2; ++j) { const float x = (wi * ai_[j][r] + as_[j][r]) * inv; hv[j][r] = x; a1 += x; a2 += x * x; }
            s1[r] = a1; s2[r] = a2; }
#pragma unroll
          for (int r = 0; r < 4; ++r) { float x = s1[r], y = s2[r];
            s1[r] = row16_sum(x); s2[r] = row16_sum(y); }
          if (fr == 0) {
#pragma unroll
            for (int r = 0; r < 4; ++r) { fa[HSUM + hf * 32 + 16 * tr4 + 4 * fq + r] = s1[r]; fa[HSQ + hf * 32 + 16 * tr4 + 4 * fq + r] = s2[r]; } } }
        LBAR();
#pragma unroll
        for (int r = 0; r < 4; ++r) { const int tl = 16 * tr4 + 4 * fq + r; const float mean = ((fa[HSUM + tl] + fa[HSUM + 32 + tl]) + (fa[HSUM + 64 + tl] + fa[HSUM + 96 + tl])) * (1.0f / 128.0f);
            const float var = fmaxf(((fa[HSQ + tl] + fa[HSQ + 32 + tl]) + (fa[HSQ + 64 + tl] + fa[HSQ + 96 + tl])) * (1.0f / 128.0f) - mean * mean, 0.f);
            const float rstd = 1.0f / sqrtf(var + HEAD_EPS);
#pragma unroll
            for (int j = 0; j < 2; ++j) { const int dv = 16 * (hf * 2 + j) + fr; const float og = bf1(*(const LAS unsigned short*)(L + OS + tl * PO + dv * 2));
                *(LAS unsigned short*)(L + HS + tl * PO + dv * 2) = (unsigned short)f2bf((hv[j][r] - mean) * rstd * gain[j] * sigmoidf_(og)); } }
        const float decay = fa[SCAL];
#pragma unroll
        for (int j = 0; j < 4; ++j) accC[j] = accC[j] * decay;
#pragma unroll
        for (int ks = 0; ks < 2; ++ks) { const int dv = 16 * w + fr; const bf16x8 va = *(const LAS bf16x8*)(L + VT + dv * P + (((ks * 4 + fq) ^ ((dv >> 3) & 7)) << 4));
#pragma unroll
            for (int j = 0; j < 4; ++j) { const int dk = 16 * j + fr; const bf16x8 kb = *(const LAS bf16x8*)(L + KW + dk * P + (((ks * 4 + fq) ^ ((dk >> 3) & 7)) << 4));
                accC[j] = __builtin_amdgcn_mfma_f32_16x16x32_bf16(va, kb, accC[j], 0, 0, 0); } }
        { const int dk = tid & 63; float s = 0.f;
#pragma unroll
          for (int e = 0; e < 8; ++e) s += fa[WL + 8 * w + e] * bf1(*(const LAS unsigned short*)(L + KS + (8 * w + e) * P + dk * 2));
          fa[QNP + w * 64 + dk] = s; }
        LBAR();
        float nnew = 0.f;
        if (tid < 64) { float s = 0.f;
#pragma unroll
            for (int p = 0; p < 8; ++p) s += fa[QNP + p * 64 + tid];
            nnew = decay * fa[NP + tid] + s; }
#pragma unroll
        for (int j = 0; j < 4; ++j)
#pragma unroll
            for (int r = 0; r < 4; ++r) *(LAS unsigned short*)(L + CT + (16 * w + 4 * fq + r) * P + (16 * j + fr) * 2) = (unsigned short)f2bf(accC[j][r]);
        if (tid < 64) fa[NP + tid] = nnew;
        { const v4u hh = *(const LAS v4u*)(L + HS + vrow0 * PO + vpc * 16);
          *(GAS v4u*)(HCAT + ((size_t)(b * SEQ) + (size_t)(cc) * 64 + T0 + vrow0) * D + h * 128 + vpc * 8) = hh; }
        if (cc + 1 < 32) MLSTM_SCALARS(RSN);
    };
#pragma nounroll
    for (int c = 0; c < 32; c += 2) { chunk(sA, sB, c); chunk(sB, sA, c + 1); }
#undef MLSTM_LOAD
#undef MLSTM_SCALARS
    __syncthreads();
}
__device__ __forceinline__ void sconv_units(Frame& F, const Args& A, int first, int stride) {
    const bf16* Z = (const bf16*)(F.ws + WS_Z); bf16* HCAT = (bf16*)(F.ws + WS_HCAT);
    const int c0 = F.lane * 8;
    float w0[8], w1[8], w2[8];
#pragma unroll
    for (int e = 0; e < 8; ++e) { w0[e] = A.in[4][c0 + e]; w1[e] = A.in[4][512 + c0 + e]; w2[e] = A.in[4][1024 + c0 + e]; }
    for (int wu = first; wu < T / 32; wu += stride) {
        const int t0 = wu * 32; float p2[8], p1[8];
#pragma unroll
        for (int e = 0; e < 8; ++e) { p2[e] = 0.f; p1[e] = 0.f; }
        if ((t0 & (SEQ - 1)) != 0) {
#pragma unroll
            for (int back = 2; back >= 1; --back) { const v4u a = *(const GAS v4u*)(Z + (size_t)(t0 - back) * NZ + ZSC + c0), x = *(const GAS v4u*)(Z + (size_t)(t0 - back) * NZ + ZSX + c0);
                const unsigned aw[4] = {a.x, a.y, a.z, a.w}, xw[4] = {x.x, x.y, x.z, x.w};
#pragma unroll
                for (int e = 0; e < 8; ++e) { const float pv = ((e & 1) ? bfhi(aw[e >> 1]) : bflo(aw[e >> 1])) * ((e & 1) ? bfhi(xw[e >> 1]) : bflo(xw[e >> 1])); if (back == 2) p2[e] = pv; else p1[e] = pv; } } }
#pragma nounroll
        for (int i0 = 0; i0 < 32; i0 += 4) {
            v4u bq[4], a[4], x[4];
#pragma unroll
            for (int i = 0; i < 4; ++i) { const size_t t = (size_t)(t0 + i0 + i); bq[i] = *(const GAS v4u*)(Z + t * NZ + ZSB + c0); a[i] = *(const GAS v4u*)(Z + t * NZ + ZSC + c0); x[i] = *(const GAS v4u*)(Z + t * NZ + ZSX + c0); }
#pragma unroll
            for (int i = 0; i < 4; ++i) { const size_t t = (size_t)(t0 + i0 + i);
                const unsigned bw[4] = {bq[i].x, bq[i].y, bq[i].z, bq[i].w}, aw[4] = {a[i].x, a[i].y, a[i].z, a[i].w}, xw[4] = {x[i].x, x[i].y, x[i].z, x[i].w}; float y[8];
#pragma unroll
                for (int e = 0; e < 8; ++e) { const float pv = ((e & 1) ? bfhi(aw[e >> 1]) : bflo(aw[e >> 1])) * ((e & 1) ? bfhi(xw[e >> 1]) : bflo(xw[e >> 1]));
                    y[e] = ((e & 1) ? bfhi(bw[e >> 1]) : bflo(bw[e >> 1])) * (w0[e] * p2[e] + w1[e] * p1[e] + w2[e] * pv); p2[e] = p1[e]; p1[e] = pv; }
                v4u o; o.x = cvt_pk_bf16(y[0], y[1]); o.y = cvt_pk_bf16(y[2], y[3]); o.z = cvt_pk_bf16(y[4], y[5]); o.w = cvt_pk_bf16(y[6], y[7]);
                *(GAS v4u*)(HCAT + t * D + 512 + c0) = o; } }
    }
}
__device__ __forceinline__ void p2_mixer_ab(Frame& F, const Args& A) {
    const int nm = F.G < 128 ? F.G : 128; const int bx = (int)blockIdx.x;
    if (F.own) {
        const int x = bx & 7, j = (bx & 127) >> 3;
        if (bx < 128) mlstm_item(F, A, ((((2 * x + (j >> 3)) * 4 + ((j >> 1) & 3)) << 1) | (j & 1)));
        else sconv_units(F, A, 128 * x + j * NWAVES + F.wave, T / 32);
    } else {
    if (bx < nm) { for (int item2 = bx; item2 < 128; item2 += nm) mlstm_item(F, A, item2); }
    if (F.G > nm) { if (bx >= nm) sconv_units(F, A, (bx - nm) * NWAVES + F.wave, (F.G - nm) * NWAVES); }
    else sconv_units(F, A, bx * NWAVES + F.wave, F.G * NWAVES);
    }
    convert_queue(F, A, 0, 0, NSMALL + XT_ALL - (F.own ? XT_DEFER : 0));
}

__device__ __forceinline__ void p_router(Frame& F, const Args& A, int layer) {
    LAS unsigned char* L = F.lds;
    constexpr int PW = 2064, WHO = 0, WLO = 32 * PW, CNTO = 64 * PW;
    static_assert(CNTO + 128 <= LDSCTL_OFF, "router LDS");
    LAS int* cnt = (LAS int*)(L + CNTO);
    const bf16* RWH = (const bf16*)(F.ws + WS_RWH) + (size_t)layer * 32 * 1024; const bf16* RWL = (const bf16*)(F.ws + WS_RWL) + (size_t)layer * 32 * 1024; const float* RGB = (const float*)(F.ws + WS_RGB) + layer * 64;
    __syncthreads();
    for (int i = 0; i < 8; ++i) { const int idx = F.tid + 512 * i, e = idx >> 7, pc = idx & 127;
        *(LAS v4u*)(L + WHO + e * PW + pc * 16) = *(const GAS v4u*)(RWH + e * 1024 + pc * 8); *(LAS v4u*)(L + WLO + e * PW + pc * 16) = *(const GAS v4u*)(RWL + e * 1024 + pc * 8); }
    const int lane = F.lane, n = lane & 15, q = lane >> 4;
    const bf16* R = (const bf16*)(F.ws + WS_R); int* TOPI = (int*)(F.ws + WS_TOPI); float* TOPG = (float*)(F.ws + WS_TOPG); int* CNTT = (int*)(F.ws + WS_CNTT); float* STATS = (float*)(F.ws + WS_STATS);
    for (int tile = F.vcu; tile < T / 128; tile += F.G) {
        const size_t t = (size_t)tile * 128 + F.wave * 16 + n;
        const bf16* rowp = R + t * D + 8 * q;
        v4u h0[8], h1[8];
#pragma unroll
        for (int s = 0; s < 8; ++s) { h0[s] = *(const GAS v4u*)(rowp + 32 * s); h1[s] = *(const GAS v4u*)(rowp + 32 * (8 + s)); }
        __syncthreads();
        if (F.tid < 32) cnt[F.tid] = 0;
        __syncthreads();
        f32x4 acc[2]; acc[0] = (f32x4){0.f, 0.f, 0.f, 0.f}; acc[1] = (f32x4){0.f, 0.f, 0.f, 0.f};
        float s1 = 0.f, s2 = 0.f;
#define RT_STEPS(HB_, s0_) do { _Pragma("unroll") for (int s_ = 0; s_ < 8; ++s_) { const int s = (s0_) + s_; const v4u h = HB_[s_]; \
            const float x0 = bflo(h.x), x1 = bfhi(h.x), x2 = bflo(h.y), x3 = bfhi(h.y), x4 = bflo(h.z), x5 = bfhi(h.z), x6 = bflo(h.w), x7 = bfhi(h.w); \
            s1 += ((x0 + x1) + (x2 + x3)) + ((x4 + x5) + (x6 + x7)); \
            s2 += ((x0 * x0 + x1 * x1) + (x2 * x2 + x3 * x3)) + ((x4 * x4 + x5 * x5) + (x6 * x6 + x7 * x7)); \
            const bf16x8 bh = __builtin_bit_cast(bf16x8, h); \
            _Pragma("unroll") for (int et = 0; et < 2; ++et) { const bf16x8 wh = *(const LAS bf16x8*)(L + WHO + (16 * et + n) * PW + s * 64 + q * 16), wl = *(const LAS bf16x8*)(L + WLO + (16 * et + n) * PW + s * 64 + q * 16); \
                acc[et] = __builtin_amdgcn_mfma_f32_16x16x32_bf16(wh, bh, acc[et], 0, 0, 0); acc[et] = __builtin_amdgcn_mfma_f32_16x16x32_bf16(wl, bh, acc[et], 0, 0, 0); } \
            } } while (0)
        RT_STEPS(h0, 0);
#pragma unroll
        for (int s = 0; s < 8; ++s) h0[s] = *(const GAS v4u*)(rowp + 32 * (16 + s));
        RT_STEPS(h1, 8);
#pragma unroll
        for (int s = 0; s < 8; ++s) h1[s] = *(const GAS v4u*)(rowp + 32 * (24 + s));
        RT_STEPS(h0, 16); RT_STEPS(h1, 24);
#undef RT_STEPS
        float Gv[8], Bv[8];
#pragma unroll
        for (int m = 0; m < 8; ++m) { const int e = 16 * (m >> 2) + 4 * q + (m & 3); Gv[m] = RGB[e]; Bv[m] = RGB[32 + e]; }
        s1 += __shfl_xor(s1, 16); s1 += __shfl_xor(s1, 32); s2 += __shfl_xor(s2, 16); s2 += __shfl_xor(s2, 32);
        const float mean = s1 * (1.0f / D), var = fmaxf(s2 * (1.0f / D) - mean * mean, 0.f), rstd = 1.0f / sqrtf(var + LN_EPS);
        float val[8];
#pragma unroll
        for (int m = 0; m < 8; ++m) val[m] = rstd * (acc[m >> 2][m & 3] - mean * Gv[m]) + Bv[m];
        float tv[4]; int ti[4];
#pragma unroll
        for (int k = 0; k < 4; ++k) { float bv = val[0]; int bi = 4 * q;
#pragma unroll
            for (int m = 1; m < 8; ++m) { const int e = 16 * (m >> 2) + 4 * q + (m & 3); if (val[m] > bv) { bv = val[m]; bi = e; } }
#pragma unroll
            for (int o = 16; o < 64; o <<= 1) { const float ov = __shfl_xor(bv, o); const int oi = __shfl_xor(bi, o); const bool take = (ov > bv) || (ov == bv && oi < bi); bv = take ? ov : bv; bi = take ? oi : bi; }
            tv[k] = bv; ti[k] = bi;
#pragma unroll
            for (int m = 0; m < 8; ++m) { const int e = 16 * (m >> 2) + 4 * q + (m & 3); if (e == bi) val[m] = -INFINITY; } }
        const float e1 = __expf(tv[1] - tv[0]), e2 = __expf(tv[2] - tv[0]), e3 = __expf(tv[3] - tv[0]); const float inv = 1.0f / (1.0f + e1 + e2 + e3);
        if (q == 0) { *(GAS i32x4*)(TOPI + t * 4) = (i32x4){ti[0], ti[1], ti[2], ti[3]}; *(GAS f32x4*)(TOPG + t * 4) = (f32x4){inv, e1 * inv, e2 * inv, e3 * inv}; *(GAS f32x2*)(STATS + t * 2) = (f32x2){mean, rstd};
            __hip_atomic_fetch_add(&cnt[ti[0]], 1, __ATOMIC_RELAXED, __HIP_MEMORY_SCOPE_WORKGROUP); __hip_atomic_fetch_add(&cnt[ti[1]], 1, __ATOMIC_RELAXED, __HIP_MEMORY_SCOPE_WORKGROUP);
            __hip_atomic_fetch_add(&cnt[ti[2]], 1, __ATOMIC_RELAXED, __HIP_MEMORY_SCOPE_WORKGROUP); __hip_atomic_fetch_add(&cnt[ti[3]], 1, __ATOMIC_RELAXED, __HIP_MEMORY_SCOPE_WORKGROUP); }
        __syncthreads();
        if (F.tid < 32) CNTT[tile * 32 + F.tid] = cnt[F.tid];
    }
    __syncthreads();
}

__device__ __forceinline__ void p_slots(Frame& F, const Args& A, int layer) {
    LAS int* li = (LAS int*)F.lds;
    LAS int* redA = li;
    LAS int* redP = li + 512;
    LAS int* tot = li + 1024;
    LAS int* pre = li + 1056;
    LAS int* base = li + 1088;
    LAS int* wcn = li + 1152;
    const int* CNTT = (const int*)(F.ws + WS_CNTT); const int* TOPI = (const int*)(F.ws + WS_TOPI); int* SLOT = (int*)(F.ws + WS_SLOT); int* META = (int*)(F.ws + WS_META);
    const bf16* R = (const bf16*)(F.ws + WS_R); const float* STATS = (const float*)(F.ws + WS_STATS); unsigned char* X1B = (unsigned char*)(F.ws + WS_X1B); int* ROWTOK = (int*)(F.ws + WS_ROWTOK);
    const float* lg = A.in[19] + (size_t)(layer * 2) * D; const float* lb = A.in[20] + (size_t)(layer * 2) * D;
    f32x4 g4[4], b4[4];
#pragma unroll
    for (int j = 0; j < 4; ++j) { g4[j] = *(const GAS f32x4*)(lg + 4 * F.lane + 256 * j); b4[j] = *(const GAS f32x4*)(lb + 4 * F.lane + 256 * j); }
    const int tid = F.tid, lane = F.lane, e_ = tid & 31, part = tid >> 5;
    int cv[16];
#pragma unroll
    for (int k = 0; k < 16; ++k) cv[k] = CNTT[(part + 16 * k) * 32 + e_];
    { int sa = 0;
#pragma unroll
      for (int k = 0; k < 16; ++k) sa += cv[k];
      redA[part * 32 + e_] = sa; }
    __syncthreads();
    if (tid < 32) { int s = 0; for (int p = 0; p < 16; ++p) s += redA[p * 32 + tid]; tot[tid] = s; }
    __syncthreads();
    if (tid == 0) { int bsum = 0; for (int e = 0; e < 32; ++e) { base[e] = bsum; bsum += (tot[e] + 255) & ~255; } base[32] = bsum; }
    __syncthreads();
    for (int tile = F.vcu; tile < T / 128; tile += F.G) {
        v2u rw[16][4];
#pragma unroll
        for (int i = 0; i < 16; ++i) { const GAS v2u* rr = (const GAS v2u*)(R + ((size_t)tile * 128 + F.wave * 16 + i) * D) + lane;
#pragma unroll
            for (int j = 0; j < 4; ++j) rw[i][j] = rr[64 * j]; }
        const float mean_l = STATS[((size_t)tile * 128 + F.wave * 16 + (lane & 15)) * 2], rstd_l = STATS[((size_t)tile * 128 + F.wave * 16 + (lane & 15)) * 2 + 1];
        { int sp = 0;
#pragma unroll
          for (int k = 0; k < 16; ++k) sp += (part + 16 * k < tile) ? cv[k] : 0;
          redP[part * 32 + e_] = sp; }
        __syncthreads();
        if (tid < 32) { int s = 0; for (int p = 0; p < 16; ++p) s += redP[p * 32 + tid]; pre[tid] = s; }
        const int tok = tile * 128 + (tid >> 2); const int e = TOPI[(size_t)tile * 512 + tid];
        int rank = 0;
        for (int ee = 0; ee < 32; ++ee) { const unsigned long long mask = __ballot(e == ee); if (e == ee) rank = __builtin_amdgcn_mbcnt_hi((unsigned)(mask >> 32), __builtin_amdgcn_mbcnt_lo((unsigned)mask, 0u)); if (lane == 0) wcn[F.wave * 32 + ee] = __popcll(mask); }
        __syncthreads();
        for (int ww = 0; ww < F.wave; ++ww) rank += wcn[ww * 32 + e];
        const int slot = base[e] + pre[e] + rank;
        SLOT[(size_t)tile * 512 + tid] = slot; ROWTOK[slot] = tok;
#pragma unroll
        for (int i = 0; i < 16; ++i) { const size_t tk = (size_t)tile * 128 + F.wave * 16 + i;
            const float mean = __builtin_bit_cast(float, __builtin_amdgcn_readlane(__builtin_bit_cast(int, mean_l), i)), rstd = __builtin_bit_cast(float, __builtin_amdgcn_readlane(__builtin_bit_cast(int, rstd_l), i));
            GAS unsigned* dst = (GAS unsigned*)(X1B + tk * D) + lane;
#pragma unroll
            for (int j = 0; j < 4; ++j) { const v2u r2 = rw[i][j]; const f32x4 y = ((f32x4){bflo(r2.x), bfhi(r2.x), bflo(r2.y), bfhi(r2.y)} - mean) * rstd * g4[j] + b4[j]; dst[64 * j] = pk4_fp8(y[0], y[1], y[2], y[3]); } }
        __syncthreads();
    }
    for (int e = F.vcu; e < 32; e += F.G) { const int r0 = base[e] + tot[e], r1 = base[e + 1]; for (int i = r0 + tid; i < r1; i += 512) ROWTOK[i] = 0; }
    if (F.vcu == 0) { const int nMt = base[32] >> 8; if (tid == 0) META[0] = nMt;
        for (int gm = tid; gm < nMt; gm += 512) { int e = 0; for (int q = 0; q < 32; ++q) if (base[q] <= gm * 256 && gm * 256 < base[q + 1]) e = q; META[16 + gm] = e; } }
    __syncthreads();
}
__device__ __forceinline__ int load_texp(Frame& F) {
    const int* META = (const int*)(F.ws + WS_META); LAS int* texp = (LAS int*)(F.lds + TEXP_OFF);
    const int nMt = __builtin_amdgcn_readfirstlane(*(const GAS int*)META);
    for (int i = F.tid; i < 1024; i += 512) texp[i] = (i < nMt) ? *(const GAS int*)(META + 16 + i) : 0;
    __syncthreads();
    return nMt;
}
template <class Sched> __device__ __forceinline__ void load_rowtab(Frame& F, const Sched& S) {
    const int* ROWTOK = (const int*)(F.ws + WS_ROWTOK); LAS unsigned short* tab = (LAS unsigned short*)(F.lds + ROWTAB_OFF);
    const int half = F.tid >> 8, r = F.tid & 255; int val[10];
#pragma unroll
    for (int j = 0; j < 10; ++j) { pg8::Unit u; const bool ok = S.next(2 * j + half, u); val[j] = ok ? *(const GAS int*)(ROWTOK + u.pm * 256 + r) : 0; }
#pragma unroll
    for (int j = 0; j < 10; ++j) tab[(2 * j + half) * 256 + r] = (unsigned short)val[j];
    __syncthreads();
}

__device__ __forceinline__ void p_combine(Frame& F, const Args& A, int layer) {
    const bf16* R = (const bf16*)(F.ws + WS_R); const float* STATS = (const float*)(F.ws + WS_STATS); const unsigned char* YS = (const unsigned char*)(F.ws + WS_YS); const int* SLOT = (const int*)(F.ws + WS_SLOT); const float* TOPG = (const float*)(F.ws + WS_TOPG);
    bf16* OB = (bf16*)(F.ws + WS_ABF);
    const float* lg = A.in[19] + (size_t)(layer * 2 + 1) * D; const float* lb = A.in[20] + (size_t)(layer * 2 + 1) * D;
    const float* lg0 = A.in[19] + (size_t)(layer * 2) * D; const float* lb0 = A.in[20] + (size_t)(layer * 2) * D;
    const int lane = F.lane; f32x4 g4[4], b4[4], g0[4], b0[4];
#pragma unroll
    for (int j = 0; j < 4; ++j) { g4[j] = *(const GAS f32x4*)(lg + 4 * lane + 256 * j); b4[j] = *(const GAS f32x4*)(lb + 4 * lane + 256 * j); g0[j] = *(const GAS f32x4*)(lg0 + 4 * lane + 256 * j) * ALPHA; b0[j] = *(const GAS f32x4*)(lb0 + 4 * lane + 256 * j) * ALPHA; }
    const int gw = F.vcu * NWAVES + F.wave, NGW = F.G * NWAVES;
    struct CMeta { i32x4 sl; f32x4 gt; f32x2 st; };
    struct CData { unsigned yw[4][4]; v2u xr[4]; f32x4 gt; f32x2 st; };
#define CMB_META(M_, t_) do { M_.st = *(const GAS f32x2*)(STATS + (size_t)(t_) * 2); M_.sl = *(const GAS i32x4*)(SLOT + (size_t)(t_) * 4); M_.gt = *(const GAS f32x4*)(TOPG + (size_t)(t_) * 4); } while (0)
#define CMB_DATA(D_, M_, t_) do { const int sls_[4] = {M_.sl[0], M_.sl[1], M_.sl[2], M_.sl[3]}; D_.gt = M_.gt * (1.0f / 16.0f); D_.st = M_.st;     \
        _Pragma("unroll") for (int k = 0; k < 4; ++k) { const GAS unsigned* yr = (const GAS unsigned*)(YS + (size_t)sls_[k] * D) + lane; _Pragma("unroll") for (int j = 0; j < 4; ++j) D_.yw[k][j] = yr[64 * j]; } \
        { const GAS v2u* xr_ = (const GAS v2u*)(R + (size_t)(t_) * D) + lane; _Pragma("unroll") for (int j = 0; j < 4; ++j) D_.xr[j] = xr_[64 * j]; } } while (0)
#define CMB_COMPUTE(D_, t_) do { f32x4 v[4]; \
        _Pragma("unroll") for (int j = 0; j < 4; ++j) { const v2u rw = D_.xr[j]; v[j] = ((f32x4){bflo(rw.x), bfhi(rw.x), bflo(rw.y), bfhi(rw.y)} - D_.st[0]) * D_.st[1] * g0[j] + b0[j]; } \
        _Pragma("unroll") for (int k = 0; k < 4; ++k) { const float gk = D_.gt[k]; \
            _Pragma("unroll") for (int j = 0; j < 4; ++j) { const f32x2 lo = __builtin_amdgcn_cvt_pk_f32_fp8((int)D_.yw[k][j], false), hi = __builtin_amdgcn_cvt_pk_f32_fp8((int)D_.yw[k][j], true); \
                v[j][0] += gk * lo[0]; v[j][1] += gk * lo[1]; v[j][2] += gk * hi[0]; v[j][3] += gk * hi[1]; } } \
        float s = 0.f; \
        _Pragma("unroll") for (int j = 0; j < 4; ++j) s += (v[j][0] + v[j][1]) + (v[j][2] + v[j][3]); \
        const float mean = wave_sum(s) * (1.0f / D); float s2 = 0.f; \
        _Pragma("unroll") for (int j = 0; j < 4; ++j) { v[j] = v[j] - mean; s2 += (v[j][0] * v[j][0] + v[j][1] * v[j][1]) + (v[j][2] * v[j][2] + v[j][3] * v[j][3]); } \
        const float rstd = 1.0f / sqrtf(wave_sum(s2) * (1.0f / D) + LN_EPS); \
        if (layer == 0) { GAS v2u* xb = (GAS v2u*)(OB + (size_t)(t_) * D) + lane; \
            _Pragma("unroll") for (int j = 0; j < 4; ++j) { v[j] = v[j] * rstd * g4[j] + b4[j]; v2u wv; wv.x = cvt_pk_bf16(v[j][0], v[j][1]); wv.y = cvt_pk_bf16(v[j][2], v[j][3]); xb[64 * j] = wv; } } \
        else { GAS f32x4* xo = (GAS f32x4*)(A.out + (size_t)(t_) * D) + lane; \
            _Pragma("unroll") for (int j = 0; j < 4; ++j) { v[j] = v[j] * rstd * g4[j] + b4[j]; xo[64 * j] = v[j]; } } } while (0)
    const int tb = F.own ? 128 * F.vcu + 16 * F.wave : gw, ts = F.own ? 1 : NGW, tn = F.own ? 16 : (gw < T ? (T - 1 - gw) / NGW + 1 : 0);
    if (tn > 0) {
        CMeta m; CData dA, dB;
        CMB_META(m, tb); CMB_DATA(dA, m, tb);
        if (1 < tn) CMB_META(m, tb + ts);
        for (int i = 0; i < tn; i += 2) {
            const int t = tb + ts * i, t1 = t + ts, t2 = t + 2 * ts, t3 = t + 3 * ts;
            if (i + 1 < tn) { CMB_DATA(dB, m, t1); if (i + 2 < tn) CMB_META(m, t2); }
            CMB_COMPUTE(dA, t);
            if (i + 1 < tn) {
                if (i + 2 < tn) { CMB_DATA(dA, m, t2); if (i + 3 < tn) CMB_META(m, t3); }
                CMB_COMPUTE(dB, t1); }
        }
    }
#undef CMB_META
#undef CMB_DATA
#undef CMB_COMPUTE
}

__device__ __forceinline__ void p_conv31(Frame& F, const Args& A) {
    const bf16* U = (const bf16*)(F.ws + WS_U); bf16* V = (bf16*)(F.ws + WS_V);
    LAS unsigned char* L = F.lds;
    constexpr int RED = 62 * 2048, STAT = RED + 8 * 32 * 4;
    static_assert(STAT + 128 <= RING_BYTES, "conv31 LDS");
    LAS float* red = (LAS float*)(L + RED); LAS float* stat = (LAS float*)(L + STAT);
    const int tid = F.tid, lane = F.lane, ch = 2 * tid;
    f32x2 wt[31];
#pragma unroll
    for (int j = 0; j < 31; ++j) wt[j] = *(const GAS f32x2*)(A.in[8] + j * 1024 + ch);
    const f32x2 bdw = *(const GAS f32x2*)(A.in[9] + ch), lg = *(const GAS f32x2*)(A.in[10] + ch), lb = *(const GAS f32x2*)(A.in[11] + ch);
    v4u pre[16];
#define CONV_LOAD(unit_) do { const int bq_ = (unit_) >> 6, tk0_ = ((unit_) & 63) * 32; _Pragma("unroll") for (int i = 0; i < 16; ++i) { const int idx = tid + 512 * i, r = idx >> 7, pc = idx & 127, tok = tk0_ - 30 + r; \
        pre[i] = (v4u){0u, 0u, 0u, 0u}; if (idx < 62 * 128 && tok >= 0) pre[i] = *(const GAS v4u*)(U + ((size_t)bq_ * SEQ + tok) * D + pc * 8); } } while (0)
    const int u0 = F.own ? 4 * F.vcu : F.vcu, ustep = F.own ? 1 : F.G, uend = F.own ? 4 * F.vcu + 4 : T / 32;
    if (u0 < uend) CONV_LOAD(u0);
    for (int unit = u0; unit < uend; unit += ustep) {
        const int bq = unit >> 6, tok0 = (unit & 63) * 32; const size_t row0 = (size_t)bq * SEQ + tok0;
        __syncthreads();
#pragma unroll
        for (int i = 0; i < 16; ++i) { const int idx = tid + 512 * i; if (idx < 62 * 128) *(LAS v4u*)(L + (idx >> 7) * 2048 + (idx & 127) * 16) = pre[i]; }
        __syncthreads();
        if (unit + ustep < uend) CONV_LOAD(unit + ustep);
#pragma nounroll
        for (int half = 0; half < 2; ++half) {
            const LAS unsigned char* Lh = L + half * 16 * 2048 + tid * 4;
            f32x2 acc[16];
#pragma unroll
            for (int t = 0; t < 16; ++t) acc[t] = bdw;
#pragma unroll
            for (int r = 0; r < 46; ++r) { const unsigned uw = *(const LAS unsigned*)(Lh + r * 2048); const f32x2 uu = (f32x2){bflo(uw), bfhi(uw)};
#pragma unroll
                for (int t = 0; t < 16; ++t) { if (r - t >= 0 && r - t <= 30) acc[t] = acc[t] + wt[r - t] * uu; } }
            float v[32];
#pragma unroll
            for (int t = 0; t < 16; ++t) { v[t] = acc[t][0] + acc[t][1]; v[16 + t] = acc[t][0] * acc[t][0] + acc[t][1] * acc[t][1]; }
#pragma unroll
            for (int e = 0; e < 16; ++e) { const bool hi = (lane & 32) != 0; const float send = hi ? v[e] : v[16 + e], keep = hi ? v[16 + e] : v[e]; v[e] = keep + __shfl_xor(send, 32); }
#pragma unroll
            for (int e = 0; e < 8; ++e) { const bool hi = (lane & 16) != 0; const float send = hi ? v[e] : v[8 + e], keep = hi ? v[8 + e] : v[e]; v[e] = keep + __shfl_xor(send, 16); }
#pragma unroll
            for (int e = 0; e < 4; ++e) { const bool hi = (lane & 8) != 0; const float send = hi ? v[e] : v[4 + e], keep = hi ? v[4 + e] : v[e]; v[e] = keep + __shfl_xor(send, 8); }
#pragma unroll
            for (int e = 0; e < 2; ++e) { const bool hi = (lane & 4) != 0; const float send = hi ? v[e] : v[2 + e], keep = hi ? v[2 + e] : v[e]; v[e] = keep + __shfl_xor(send, 4); }
            { const bool hi = (lane & 2) != 0; const float send = hi ? v[0] : v[1], keep = hi ? v[1] : v[0]; v[0] = keep + __shfl_xor(send, 2); }
            v[0] += __shfl_xor(v[0], 1);
            if ((lane & 1) == 0) red[F.wave * 32 + (lane >> 1)] = v[0];
            LBAR();
            if (tid < 32) { float s = 0.f;
#pragma unroll
                for (int ww = 0; ww < 8; ++ww) s += red[ww * 32 + tid];
                const float other = __shfl_xor(s, 16);
                if (tid < 16) { const float mean = s * (1.0f / D); const float var = fmaxf(other * (1.0f / D) - mean * mean, 0.f); stat[tid] = mean; stat[16 + tid] = 1.0f / sqrtf(var + LN_EPS); } }
            LBAR();
#pragma unroll
            for (int t = 0; t < 16; ++t) { const float mean = stat[t], rstd = stat[16 + t]; const float y0 = (acc[t][0] - mean) * rstd * lg[0] + lb[0], y1 = (acc[t][1] - mean) * rstd * lg[1] + lb[1];
                *(GAS unsigned*)(V + (row0 + half * 16 + t) * D + ch) = cvt_pk_bf16(y0 * sigmoidf_(y0), y1 * sigmoidf_(y1)); }
        }
    }
    __syncthreads();
#undef CONV_LOAD
}

#define RUN_GEMM(EpiT, SchedT, S, E) pg8::gemm_phase<EpiT, SchedT, true>(F.lds, S, E)
#ifndef MK_KIND_MASK
#define MK_KIND_MASK 0x7ff
#endif
#define ON(kind) (((MK_KIND_MASK) >> (kind)) & 1)
#ifndef MK_DUP_MASK
#define MK_DUP_MASK 0
#endif
#define DUP(kind) (((MK_DUP_MASK) >> (kind)) & 1)
#define IN(k) (lo <= (k) && (k) < hi)
#define SEAM(k) do { if (IN(k) && IN((k) + 1)) xcd_barrier(bar); } while (0)
#define SEAM_L(k) do { if (IN(k) && IN((k) + 1)) { if (F.own) xcd_local_barrier(bar, (unsigned*)(F.ws + WS_CTL) + CW_LBAR); else xcd_barrier(bar); } } while (0)

template <int LAYER>
__device__ __forceinline__ void run_layer(Frame& F, const Args& args, const XcdBarrier& bar, int lo, int hi) {
    constexpr int pb = 1 + 8 * LAYER;
    const int c_id = (int)blockIdx.x;
    asm volatile("" : "+v"(F.tid));
    LAS int* texp = (LAS int*)(F.lds + TEXP_OFF);
    if constexpr (LAYER == 0) {
        if (ON(1) && IN(1)) { pg8::Order<false> S; S.init(T / 256, NZ / 256, F.G, c_id); S.A = (const char*)(F.ws + WS_ABF); S.Bt = (const char*)(F.ws + WS_WIN); S.bexp = 0; S.texp = nullptr;
            pg8::EpiZ E{(bf16*)(F.ws + WS_Z), NZ}; RUN_GEMM(pg8::EpiZ, pg8::Order<false>, S, E); } SEAM_L(1);
        if (ON(2) && IN(2)) { { p2_mixer_ab(F, args); } if (DUP(2)) { p2_mixer_ab(F, args); } } SEAM_L(2);
    } else {
        if (ON(3) && IN(9)) { pg8::Order<false> S; S.init(T / 256, 2048 / 256, F.G, c_id); S.A = (const char*)(F.ws + WS_ABF); S.Bt = (const char*)(F.ws + WS_PW1); S.bexp = 0; S.texp = nullptr;
            pg8::EpiGlu E{(bf16*)(F.ws + WS_U)}; RUN_GEMM(pg8::EpiGlu, pg8::Order<false>, S, E); if (DUP(3)) { RUN_GEMM(pg8::EpiGlu, pg8::Order<false>, S, E); } } SEAM_L(9);
        if (ON(4) && IN(10)) { { p_conv31(F, args); } if (DUP(4)) { p_conv31(F, args); } } SEAM_L(10);
    }
    if (ON(5) && IN(pb + 2)) { pg8::Order<false> S; S.init(T / 256, D / 256, F.G, c_id); S.A = (const char*)(F.ws + (LAYER == 0 ? WS_HCAT : WS_V)); S.Bt = (const char*)(F.ws + (LAYER == 0 ? WS_WOUT : WS_PW2)); S.bexp = 0; S.texp = nullptr;
        pg8::EpiRes<true> E{(const void*)(F.ws + WS_ABF), (bf16*)(F.ws + WS_R), ALPHA};
        RUN_GEMM(pg8::EpiRes<true>, pg8::Order<false>, S, E); if (DUP(5)) { RUN_GEMM(pg8::EpiRes<true>, pg8::Order<false>, S, E); } } SEAM_L(pb + 2);
    if (ON(6) && IN(pb + 3)) { { p_router(F, args, LAYER); } if (DUP(6)) { p_router(F, args, LAYER); } } SEAM(pb + 3);
    if (ON(7) && IN(pb + 4)) { { p_slots(F, args, LAYER); } if (DUP(7)) { p_slots(F, args, LAYER); } } SEAM(pb + 4);
    asm volatile("" : "+v"(F.tid));
    if (ON(8) && IN(pb + 5)) { const int nMt = load_texp(F); const float* WSC = (const float*)(F.ws + WS_WSC); unsigned* ctl = (unsigned*)(F.ws + WS_CTL);
        const int GD = (LAYER == 0 && F.own && XT_DEFER > 0) ? F.G / 8 : 0, G1 = F.G - GD;
        const pg8::Hand H{ctl + CW_UPCNT + LAYER * UPCNT_LAYER, ctl + CW_UPTOT + LAYER * 64, (unsigned)F.G};
        if (c_id < G1) {
        pg8::Order<true> S; S.init(nMt, 8, G1, c_id); S.tstep = (size_t)256 * 1024; S.A = (const char*)(F.ws + WS_X1B); S.Bt = (const char*)(F.ws + WS_UP) + (size_t)LAYER * 32 * 2048 * 1024; S.bexp = (size_t)2048 * 1024; S.texp = texp;
        load_rowtab(F, S);
        pg8::EpiSwiglu8 E{(unsigned char*)(F.ws + WS_ACT), args.in[16] + (size_t)LAYER * 32 * 2048, texp, 1.0f / WSC[LAYER * 2]};
        pg8::gemm_phase<pg8::EpiSwiglu8, pg8::Order<true>, true, true, true, 1>(F.lds, S, E, (const LAS unsigned short*)(F.lds + ROWTAB_OFF), H);
        __syncthreads(); if (F.tid == 0) __hip_atomic_fetch_add(H.tot, 1u, __ATOMIC_RELAXED, __HIP_MEMORY_SCOPE_AGENT); }
        else { if (F.tid == 0) __hip_atomic_fetch_add(H.tot, 1u, __ATOMIC_RELAXED, __HIP_MEMORY_SCOPE_AGENT);
            convert_queue(F, args, 1, NSMALL + XT_ALL - XT_DEFER, NSMALL + XT_ALL); __syncthreads(); } }
    if (ON(9) && IN(pb + 6)) { const int nMt = load_texp(F); const float* WSC = (const float*)(F.ws + WS_WSC); unsigned* ctl = (unsigned*)(F.ws + WS_CTL);
        pg8::Order<true> S; S.init(nMt, 4, F.G, c_id); S.tstep = (size_t)256 * 1024; S.A = (const char*)(F.ws + WS_ACT); S.Bt = (const char*)(F.ws + WS_DN) + (size_t)LAYER * 32 * 1024 * 1024; S.bexp = (size_t)1024 * 1024; S.texp = texp;
        pg8::EpiBiasG8 E{(unsigned char*)(F.ws + WS_YS), args.in[18] + (size_t)LAYER * 32 * 1024, texp, 0.25f / WSC[LAYER * 2 + 1]};
        const pg8::Hand H{ctl + CW_UPCNT + LAYER * UPCNT_LAYER, ctl + CW_UPTOT + LAYER * 64, (unsigned)F.G};
        pg8::gemm_phase<pg8::EpiBiasG8, pg8::Order<true>, true, true, false, 2>(F.lds, S, E, nullptr, H); } SEAM(pb + 6);
    if (ON(10) && IN(pb + 7)) { { p_combine(F, args, LAYER); } if (DUP(10)) { p_combine(F, args, LAYER); } } if constexpr (LAYER == 0) SEAM_L(pb + 7);
}

__global__ void __launch_bounds__(NWAVES * 64, 2) mk_fwd(Args args) {
    extern __shared__ __attribute__((aligned(16))) unsigned char lds[];
    Frame F;
    F.lds = (LAS unsigned char*)lds;
    F.tid = threadIdx.x; F.lane = (int)__builtin_amdgcn_mbcnt_hi(~0u, __builtin_amdgcn_mbcnt_lo(~0u, 0u));
    F.wave = __builtin_amdgcn_readfirstlane(F.tid >> 6);
    F.G = gridDim.x; { const int bx = blockIdx.x; F.vcu = (F.G % 8 == 0) ? (bx % 8) * (F.G / 8) + bx / 8 : bx; }
    F.ws = args.ws;
    for (int u = F.tid; u < (LDS_BYTES - LDSCTL_OFF) / 4; u += NWAVES * 64) ((LAS unsigned*)(F.lds + LDSCTL_OFF))[u] = 0u;
    __syncthreads();
    unsigned* ctl = (unsigned*)(F.ws + WS_CTL);
    XcdBarrier bar; bar.bar = ctl + CW_BAR; bar.x = 0; bar.st = nullptr;
#if !MK_PER_PHASE
    bar = xcd_barrier_post(ctl + CW_BAR, (volatile LAS unsigned*)(F.lds + MISC_OFF) + 8);
#endif
    const int lo = args.ph_lo, hi = args.ph_hi;
    F.own = false;
    if (F.tid == 0) atomicOr(&ctl[CW_MAPX + 64 * bar.x], 1u << (blockIdx.x & 7));
    if (ON(0) && IN(0)) { p0_prologue(F, args); if (DUP(0)) { p0_prologue(F, args); } } SEAM(0);
    if (IN(0) && IN(1)) { bool ok = (F.G == 256) && (bar.st[0] == 32u) && (bar.st[1] == 8u); unsigned seen = 0u;
#pragma unroll
        for (int j = 0; j < 16; ++j) { const unsigned m = xb_ld(&ctl[CW_MAPX + 64 * j]); if (m != 0u) { ok = ok && (__popc(m) == 1) && ((seen & m) == 0u) && (j < 8 ? true : true); seen |= m; } }
        F.own = ok && (seen == 0xffu); }
    run_layer<0>(F, args, bar, lo, hi);
    run_layer<1>(F, args, bar, lo, hi);
}
#undef IN
#undef SEAM

extern "C" void kernel_launch(void* const* d_in, const int* in_sizes, int n_in, void* d_out, int out_size, void* d_ws, size_t ws_size, hipStream_t stream) {
    static int grid = 0;
    if (grid == 0) {
        if (n_in != 21 || in_sizes[0] != T * D || out_size != T * D || ws_size < WS_END) { fprintf(stderr, "kernel_launch: unexpected shapes (n_in %d, in0 %d, out %d, ws %zu); nothing launched\n", n_in, n_in > 0 ? in_sizes[0] : -1, out_size, ws_size); grid = -1; return; }
        int dev = 0, cus = 0, per_cu = 0;
        if (hipGetDevice(&dev) != hipSuccess || hipDeviceGetAttribute(&cus, hipDeviceAttributeMultiprocessorCount, dev) != hipSuccess) { grid = -1; return; }
        if (hipFuncSetAttribute((const void*)mk_fwd, hipFuncAttributeMaxDynamicSharedMemorySize, LDS_BYTES) != hipSuccess) { fprintf(stderr, "kernel_launch: hipFuncSetAttribute failed\n"); grid = -1; return; }
        if (hipOccupancyMaxActiveBlocksPerMultiprocessor(&per_cu, (const void*)mk_fwd, NWAVES * 64, LDS_BYTES) != hipSuccess || per_cu < 1) { fprintf(stderr, "kernel_launch: occupancy query reports %d workgroups per CU\n", per_cu); }
        (void)hipGetLastError();
        grid = cus;
    }
    if (grid < 0) return;
    if (hipMemsetAsync((char*)d_ws + WS_CTL, 0, CTL_ZERO_BYTES, stream) != hipSuccess) return;
    Args a{};
    for (int i = 0; i < 21; ++i) a.in[i] = (const float*)d_in[i];
    a.out = (float*)d_out; a.ws = (unsigned char*)d_ws;
#if MK_PER_PHASE
    for (int p = 0; p < NPH; ++p) { a.ph_lo = p; a.ph_hi = p + 1; hipLaunchKernelGGL(mk_fwd, dim3(grid), dim3(NWAVES * 64), LDS_BYTES, stream, a); }
#else
    a.ph_lo = 0; a.ph_hi = NPH;
    hipLaunchKernelGGL(mk_fwd, dim3(grid), dim3(NWAVES * 64), LDS_BYTES, stream, a);
#endif
}
```

```cpp
#include <hip/hip_runtime.h>
#include <cstdio>

#ifndef MK_PER_PHASE
#define MK_PER_PHASE 0
#endif
#define GAS __attribute__((address_space(1)))
#define LAS __attribute__((address_space(3)))
typedef unsigned short bf16;
typedef unsigned v4u __attribute__((ext_vector_type(4)));
typedef unsigned v2u __attribute__((ext_vector_type(2)));
typedef float f32x4 __attribute__((ext_vector_type(4)));
typedef float f32x2 __attribute__((ext_vector_type(2)));
typedef short bf16x8 __attribute__((ext_vector_type(8)));
typedef int i32x4 __attribute__((ext_vector_type(4)));
typedef int i32x8 __attribute__((ext_vector_type(8)));
#define LDS_WAIT() asm volatile("s_waitcnt lgkmcnt(0)" ::: "memory")
#define VM_WAIT() asm volatile("s_waitcnt vmcnt(0)" ::: "memory")
#define LBAR() do { asm volatile("s_waitcnt lgkmcnt(0)" ::: "memory"); __builtin_amdgcn_s_barrier(); asm volatile("" ::: "memory"); } while (0)

__device__ __forceinline__ unsigned cvt_pk_bf16(float lo, float hi) { unsigned r; asm volatile("v_cvt_pk_bf16_f32 %0, %1, %2" : "=v"(r) : "v"(lo), "v"(hi)); return r; }
__device__ __forceinline__ unsigned cvt_pk_bf16_nv(float lo, float hi) { unsigned r; asm("v_cvt_pk_bf16_f32 %0, %1, %2" : "=v"(r) : "v"(lo), "v"(hi)); return r; }
__device__ __forceinline__ unsigned pk4_fp8(float a, float b, float c, float d) { unsigned w = 0u; w = (unsigned)__builtin_amdgcn_cvt_pk_fp8_f32(a, b, (int)w, false); w = (unsigned)__builtin_amdgcn_cvt_pk_fp8_f32(c, d, (int)w, true); return w; }
__device__ __forceinline__ __amdgpu_buffer_rsrc_t mk_rsrc(const void* p, unsigned bytes) { return __builtin_amdgcn_make_buffer_rsrc((void*)p, 0, (int)bytes, 0x00020000); }
__device__ __forceinline__ unsigned f2bf(float f) { unsigned u = __builtin_bit_cast(unsigned, f); return (u + 0x7fffu + ((u >> 16) & 1u)) >> 16; }
__device__ __forceinline__ unsigned pk2(float lo, float hi) { return f2bf(lo) | (f2bf(hi) << 16); }
__device__ __forceinline__ float bflo(unsigned w) { return __builtin_bit_cast(float, w << 16); }
__device__ __forceinline__ float bfhi(unsigned w) { return __builtin_bit_cast(float, w & 0xffff0000u); }
__device__ __forceinline__ float bf1(unsigned short b) { return __builtin_bit_cast(float, ((unsigned)b) << 16); }
__device__ __forceinline__ float sigmoidf_(float x) { return __builtin_amdgcn_rcpf(1.0f + __expf(-x)); }

namespace pg8 {
constexpr int BM = 256, BK = 64, HALF = 128, HTB = HALF * BK * 2, STAGE_BYTES = 8 * HTB, NXCD = 8, WGM = 8, KD = 1024;
constexpr int BIAS_OFF = 136192;
__host__ __device__ __forceinline__ int lds_byte(int r, int c) { const int st = (r >> 4) * 2 + (c >> 5), rr = r & 15, cc = c & 31, ob = rr * 64 + cc * 2; return st * 1024 + (ob ^ (((ob >> 9) & 1) << 5)); }
__host__ __device__ __forceinline__ void stage_rc(int b, int& R, int& C) { const int st = b / 1024, sb = b % 1024, swz = sb ^ (((sb >> 9) & 1) << 5); R = (st >> 1) * 16 + swz / 64; C = (st & 1) * 32 + (swz % 64) / 2; }
__host__ __device__ __forceinline__ int perm32(int rho) { const int n = rho >> 4, i = rho & 15; return 8 * (i >> 2) + 4 * n + (i & 3); }
struct Unit { int pm, pn; };

template <bool GROUPED> struct Order {
    int nM, nN, nwg, G, c; const char* A; const char* Bt; size_t bexp, tstep; const LAS int* texp;
    __device__ __forceinline__ void init(int nM_, int nN_, int G_, int c_) { nM = nM_; nN = nN_; nwg = nM * nN; G = G_; c = c_; tstep = (size_t)(BM * KD * 2); }
    __device__ __forceinline__ bool next(int i, Unit& u) const {
        const long L = (long)i * G + c; if (L >= nwg) return false;
        int wgid = (int)L; { const int q = nwg / NXCD, r = nwg % NXCD, xcd = wgid % NXCD, off = wgid / NXCD; wgid = (xcd < r ? xcd * (q + 1) : r * (q + 1) + (xcd - r) * q) + off; }
        const int nig = WGM * nN, gid = wgid / nig, fm = gid * WGM, gsz = (nM - fm) < WGM ? (nM - fm) : WGM;
        u.pm = fm + ((wgid % nig) % gsz); u.pn = (wgid % nig) / gsz; return true;
    }
    __device__ __forceinline__ const char* aptr(const Unit& u) const { return A + (size_t)u.pm * tstep; }
    __device__ __forceinline__ const char* bptr(const Unit& u) const { return Bt + (GROUPED ? (size_t)texp[u.pm] * bexp : (size_t)0) + (size_t)u.pn * tstep; }
};

struct EpiZ {
    static constexpr int PERM = 2, NBIAS = 0;
    bf16* O; int ldc;
    __device__ __forceinline__ void operator()(const f32x4 (&acc)[2][2][4][2], const Unit& u, int wr, int wc, int fr, int fq, const LAS float* lb) const {
        const int row0 = u.pm * BM + wr * 64 + fr, col0 = u.pn * BM + wc * 64 + 16 * fq;
#pragma unroll
        for (int ai = 0; ai < 2; ++ai)
#pragma unroll
            for (int m = 0; m < 4; ++m) { bf16* rowp = O + (size_t)(row0 + ai * HALF + m * 16) * ldc + col0;
#pragma unroll
                for (int bj = 0; bj < 2; ++bj) { const f32x4 v0 = acc[ai][bj][m][0], v1 = acc[ai][bj][m][1];
                    v4u w; w.x = cvt_pk_bf16(v0[0], v0[1]); w.y = cvt_pk_bf16(v0[2], v0[3]); w.z = cvt_pk_bf16(v1[0], v1[1]); w.w = cvt_pk_bf16(v1[2], v1[3]);
                    *(v4u*)(rowp + bj * 8) = w; } }
    }
};
template <bool BASE_BF16> struct EpiRes {
    static constexpr int PERM = 2, NBIAS = 0;
    const void* base; bf16* out; float alpha;
    __device__ __forceinline__ void operator()(const f32x4 (&acc)[2][2][4][2], const Unit& u, int wr, int wc, int fr, int fq, const LAS float* lb) const {
        const int row0 = u.pm * BM + wr * 64 + fr, col0 = u.pn * BM + wc * 64 + 16 * fq;
#pragma unroll
        for (int ai = 0; ai < 2; ++ai) {
            f32x4 b0[4][2], b1[4][2];
#pragma unroll
            for (int m = 0; m < 4; ++m) { const size_t off = (size_t)(row0 + ai * HALF + m * 16) * 1024 + col0;
#pragma unroll
                for (int bj = 0; bj < 2; ++bj) {
                    if constexpr (BASE_BF16) { const v4u bw = *(const v4u*)((const bf16*)base + off + bj * 8); b0[m][bj] = __builtin_bit_cast(f32x4, bw); }
                    else { b0[m][bj] = *(const f32x4*)((const float*)base + off + bj * 8); b1[m][bj] = *(const f32x4*)((const float*)base + off + bj * 8 + 4); } } }
            __builtin_amdgcn_sched_barrier(0);
#pragma unroll
            for (int m = 0; m < 4; ++m) { const size_t off = (size_t)(row0 + ai * HALF + m * 16) * 1024 + col0;
#pragma unroll
                for (int bj = 0; bj < 2; ++bj) { f32x4 c0, c1;
                    if constexpr (BASE_BF16) { const v4u bw = __builtin_bit_cast(v4u, b0[m][bj]); c0 = (f32x4){bflo(bw.x), bfhi(bw.x), bflo(bw.y), bfhi(bw.y)}; c1 = (f32x4){bflo(bw.z), bfhi(bw.z), bflo(bw.w), bfhi(bw.w)}; }
                    else { c0 = b0[m][bj]; c1 = b1[m][bj]; }
                    const f32x4 v0 = c0 * alpha + acc[ai][bj][m][0], v1 = c1 * alpha + acc[ai][bj][m][1];
                    v4u w; w.x = cvt_pk_bf16(v0[0], v0[1]); w.y = cvt_pk_bf16(v0[2], v0[3]); w.z = cvt_pk_bf16(v1[0], v1[1]); w.w = cvt_pk_bf16(v1[2], v1[3]);
                    *(v4u*)(out + off + bj * 8) = w; } }
        }
    }
};
struct EpiSwiglu8 {
    static constexpr int PERM = 1, NBIAS = 256;
    unsigned char* O; const float* bias; const LAS int* texp; float inscale;
    __device__ __forceinline__ const float* bias_src(const Unit& u, int i) const { return bias + (size_t)texp[u.pm] * 2048 + (i >> 7) * 1024 + u.pn * HALF + (i & 127); }
    __device__ __forceinline__ void operator()(const f32x4 (&acc)[2][2][4][2], const Unit& u, int wr, int wc, int fr, int fq, const LAS float* lb) const {
        const int row0 = u.pm * BM + wr * 64 + fr, jc = u.pn * HALF + wc * 32 + 8 * fq;
        const LAS float* bp = lb + wc * 32 + 8 * fq; const float s1 = inscale, s4 = 4.0f * inscale; const __amdgpu_buffer_rsrc_t rs = mk_rsrc(O, 0x7fffff00u);
        f32x4 bg[2], bl[2];
#pragma unroll
        for (int n = 0; n < 2; ++n) { bg[n] = *(const LAS f32x4*)(bp + 4 * n); bl[n] = *(const LAS f32x4*)(bp + 128 + 4 * n) * 4.0f + 4.0f; }
#pragma unroll
        for (int ai = 0; ai < 2; ++ai)
#pragma unroll
            for (int m = 0; m < 4; ++m) { const unsigned ob = (unsigned)(row0 + ai * HALF + m * 16) * 1024u + (unsigned)jc; float r[8];
#pragma unroll
                for (int n = 0; n < 2; ++n) { const f32x4 g4 = acc[ai][0][m][n] * s1 + bg[n], l4 = acc[ai][1][m][n] * s4 + bl[n];
#pragma unroll
                    for (int p = 0; p < 2; ++p) {
                        const f32x2 g2 = (f32x2){fminf(g4[2 * p], 7.0f), fminf(g4[2 * p + 1], 7.0f)}, l2 = (f32x2){__builtin_amdgcn_fmed3f(l4[2 * p], -24.0f, 32.0f), __builtin_amdgcn_fmed3f(l4[2 * p + 1], -24.0f, 32.0f)};
                        const f32x2 t2 = g2 * -2.45546696f; const f32x2 d2 = (f32x2){__builtin_amdgcn_exp2f(t2[0]), __builtin_amdgcn_exp2f(t2[1])} + 1.0f;
                        const f32x2 q2 = (f32x2){__builtin_amdgcn_rcpf(d2[0]), __builtin_amdgcn_rcpf(d2[1])}; const f32x2 r2 = (g2 * l2) * q2;
                        r[4 * n + 2 * p] = r2[0]; r[4 * n + 2 * p + 1] = r2[1]; } }
                v2u w; w.x = pk4_fp8(r[0], r[1], r[2], r[3]); w.y = pk4_fp8(r[4], r[5], r[6], r[7]);
                __builtin_amdgcn_raw_buffer_store_b64(w, rs, (int)ob, 0, 16); }
    }
};
struct EpiBiasG8 {
    static constexpr int PERM = 2, NBIAS = 256;
    unsigned char* O; const float* bias; const LAS int* texp; float inscale;
    __device__ __forceinline__ const float* bias_src(const Unit& u, int i) const { return bias + (size_t)texp[u.pm] * 1024 + u.pn * BM + i; }
    __device__ __forceinline__ void operator()(const f32x4 (&acc)[2][2][4][2], const Unit& u, int wr, int wc, int fr, int fq, const LAS float* lb) const {
        const int row0 = u.pm * BM + wr * 64 + fr, col0 = u.pn * BM + wc * 64 + 16 * fq;
        const LAS float* bp = lb + wc * 64 + 16 * fq; const float s16 = 16.0f * inscale;
        f32x4 bv[2][2];
#pragma unroll
        for (int bj = 0; bj < 2; ++bj)
#pragma unroll
            for (int n = 0; n < 2; ++n) bv[bj][n] = *(const LAS f32x4*)(bp + bj * 8 + 4 * n) * 16.0f;
#pragma unroll
        for (int ai = 0; ai < 2; ++ai)
#pragma unroll
            for (int m = 0; m < 4; ++m) { unsigned char* rowp = O + (size_t)(row0 + ai * HALF + m * 16) * 1024 + col0; v4u w;
                { const f32x4 v0 = acc[ai][0][m][0] * s16 + bv[0][0], v1 = acc[ai][0][m][1] * s16 + bv[0][1]; w.x = pk4_fp8(v0[0], v0[1], v0[2], v0[3]); w.y = pk4_fp8(v1[0], v1[1], v1[2], v1[3]); }
                { const f32x4 v0 = acc[ai][1][m][0] * s16 + bv[1][0], v1 = acc[ai][1][m][1] * s16 + bv[1][1]; w.z = pk4_fp8(v0[0], v0[1], v0[2], v0[3]); w.w = pk4_fp8(v1[0], v1[1], v1[2], v1[3]); }
                *(v4u*)rowp = w; }
    }
};
struct EpiGlu {
    static constexpr int PERM = 1, NBIAS = 0;
    bf16* O;
    __device__ __forceinline__ void operator()(const f32x4 (&acc)[2][2][4][2], const Unit& u, int wr, int wc, int fr, int fq, const LAS float* lb) const {
        const int row0 = u.pm * BM + wr * 64 + fr, jc = u.pn * HALF + wc * 32 + 8 * fq;
#pragma unroll
        for (int ai = 0; ai < 2; ++ai)
#pragma unroll
            for (int m = 0; m < 4; ++m) { bf16* rowp = O + (size_t)(row0 + ai * HALF + m * 16) * 1024 + jc; float r[8];
#pragma unroll
                for (int n = 0; n < 2; ++n) { const f32x4 a4 = acc[ai][0][m][n], g4 = acc[ai][1][m][n];
#pragma unroll
                    for (int p = 0; p < 2; ++p) {
                        const f32x2 t2 = (f32x2){g4[2 * p], g4[2 * p + 1]} * -1.44269504f; const f32x2 d2 = (f32x2){__builtin_amdgcn_exp2f(t2[0]), __builtin_amdgcn_exp2f(t2[1])} + 1.0f;
                        const f32x2 r2 = (f32x2){a4[2 * p], a4[2 * p + 1]} * (f32x2){__builtin_amdgcn_rcpf(d2[0]), __builtin_amdgcn_rcpf(d2[1])};
                        r[4 * n + 2 * p] = r2[0]; r[4 * n + 2 * p + 1] = r2[1]; } }
                v4u w; w.x = cvt_pk_bf16(r[0], r[1]); w.y = cvt_pk_bf16(r[2], r[3]); w.z = cvt_pk_bf16(r[4], r[5]); w.w = cvt_pk_bf16(r[6], r[7]);
                *(v4u*)rowp = w; }
    }
};

__device__ __forceinline__ bf16x8 lo8(i32x8 v) { return __builtin_bit_cast(bf16x8, (i32x4)__builtin_shufflevector(v, v, 0, 1, 2, 3)); }
__device__ __forceinline__ bf16x8 hi8(i32x8 v) { return __builtin_bit_cast(bf16x8, (i32x4)__builtin_shufflevector(v, v, 4, 5, 6, 7)); }
struct Hand { unsigned* cnt; unsigned* tot; unsigned expect; };
template <class Epi, class Sched, bool ALIGN_EPI = true, bool FP8 = false, bool GATHER = false, int HANDOFF = 0  >
__device__ __forceinline__ void gemm_phase(LAS unsigned char* lds, const Sched& S, const Epi& E, const LAS unsigned short* rowtab = nullptr, const Hand hand = Hand{nullptr, nullptr, 0u}) {
    const int tid = threadIdx.x, wid = __builtin_amdgcn_readfirstlane(tid >> 6), lane = tid & 63, wr = wid >> 2, wc = wid & 3, fr = lane & 15, fq = lane >> 4;
    constexpr int ROWB = FP8 ? KD : KD * 2, nt = ROWB / (BK * 2);
    unsigned voffB[2][2], offC[2][2], offN[2][2]; int rA[2], cA2[2];
#pragma unroll
    for (int i = 0; i < 2; ++i) { int R, C; stage_rc(tid * 16 + i * 8192, R, C); const int Rb = (Epi::PERM == 1) ? ((R & ~31) + perm32(R & 31)) : R;
        rA[i] = R; cA2[i] = C * 2;
#pragma unroll
        for (int bj = 0; bj < 2; ++bj) { int grow;
            if constexpr (Epi::PERM == 2) { const int wc_ = R >> 5, rho = R & 31; grow = 64 * wc_ + 16 * ((rho & 15) >> 2) + 8 * bj + 4 * (rho >> 4) + (rho & 3); }
            else grow = bj * HALF + Rb;
            voffB[bj][i] = (unsigned)(grow * ROWB + C * 2); }
#pragma unroll
        for (int h = 0; h < 2; ++h) { offC[h][i] = (unsigned)((h * HALF + R) * ROWB + C * 2); offN[h][i] = offC[h][i]; } }
#define PG8_GOFF(dst, unit_idx) do { if constexpr (GATHER) { _Pragma("unroll") for (int h_ = 0; h_ < 2; ++h_) _Pragma("unroll") for (int i_ = 0; i_ < 2; ++i_) \
        dst[h_][i_] = (unsigned)rowtab[(unit_idx) * 256 + h_ * HALF + rA[i_]] * (unsigned)ROWB + (unsigned)cA2[i_]; } } while (0)
    constexpr size_t kstep = (size_t)(BK * 2);
    constexpr size_t hstep = (size_t)HALF * ROWB;
    const unsigned ldsw = (unsigned)wid * 1024u;
    const int aoff = lds_byte(wr * 64 + fr, fq * 8), boff = lds_byte(wc * 32 + fr, fq * 8);
#define PG8_SA(b, h) (((b) * 2 + (h)) * HTB)
#define PG8_SB(b, h) ((4 + (b) * 2 + (h)) * HTB)
#define PG8_STAGE(bufoff, gbase, voff) do { _Pragma("unroll") for (int _i = 0; _i < 2; ++_i) \
        __builtin_amdgcn_global_load_lds((const unsigned*)((const char*)(gbase) + (voff)[_i]), (LAS unsigned*)(lds + (bufoff) + ldsw + _i * 8192), 16, 0, 0); } while (0)
#define PG8_LDA(dst, b, h) do { _Pragma("unroll") for (int m = 0; m < 4; ++m) { const i32x4 x_ = *(const LAS i32x4*)(lds + PG8_SA(b, h) + aoff + m * 2048), y_ = *(const LAS i32x4*)(lds + PG8_SA(b, h) + aoff + m * 2048 + 1024); dst[m] = __builtin_shufflevector(x_, y_, 0, 1, 2, 3, 4, 5, 6, 7); } } while (0)
#define PG8_LDB(dst, b, h) do { _Pragma("unroll") for (int n = 0; n < 2; ++n) { const i32x4 x_ = *(const LAS i32x4*)(lds + PG8_SB(b, h) + boff + n * 2048), y_ = *(const LAS i32x4*)(lds + PG8_SB(b, h) + boff + n * 2048 + 1024); dst[n] = __builtin_shufflevector(x_, y_, 0, 1, 2, 3, 4, 5, 6, 7); } } while (0)
#define PG8_MMA(ai, bj, At, Bt) do { __builtin_amdgcn_s_setprio(1); _Pragma("unroll") for (int m = 0; m < 4; ++m) _Pragma("unroll") for (int n = 0; n < 2; ++n) { \
        if constexpr (FP8) asm volatile("s_nop 1\n\tv_mfma_scale_f32_16x16x128_f8f6f4 %0, %1, %2, %0, %3, %3 op_sel_hi:[0,0,0]" : "+v"(acc[ai][bj][m][n]) : "v"(Bt[n]), "v"(At[m]), "v"(sc127)); \
        else { acc[ai][bj][m][n] = __builtin_amdgcn_mfma_f32_16x16x32_bf16(lo8(Bt[n]), lo8(At[m]), acc[ai][bj][m][n], 0, 0, 0); acc[ai][bj][m][n] = __builtin_amdgcn_mfma_f32_16x16x32_bf16(hi8(Bt[n]), hi8(At[m]), acc[ai][bj][m][n], 0, 0, 0); } } __builtin_amdgcn_s_setprio(0); } while (0)
#define PG8_WAIT_V(n) asm volatile("s_waitcnt vmcnt(" #n ")" ::: "memory")
#define PG8_WAIT_L(n) asm volatile("s_waitcnt lgkmcnt(" #n ")" ::: "memory")
#define PG8_BAR __builtin_amdgcn_s_barrier()
#define PG8_SCHED __builtin_amdgcn_sched_barrier(0)
#define PG8_SCHED8 do { } while (0)
    Unit cur, nxt; int ui = 0;
    if (!S.next(0, cur)) return;
    int prev_pm = -1; bool all_done = false;
#define PG8_AREADY(u_) do { if constexpr (HANDOFF == 2) { if (wid == 0 && !all_done) { \
            all_done = (unsigned)__builtin_amdgcn_readfirstlane((int)__hip_atomic_load(hand.tot, __ATOMIC_RELAXED, __HIP_MEMORY_SCOPE_AGENT)) >= hand.expect;     \
            if (!all_done) { unsigned spins_ = 0u; \
                while ((unsigned)__builtin_amdgcn_readfirstlane((int)__hip_atomic_load(hand.cnt + 64 * (u_).pm, __ATOMIC_RELAXED, __HIP_MEMORY_SCOPE_AGENT)) < 64u) { __builtin_amdgcn_s_sleep(2); if (++spins_ > (1u << 22)) break; } } } \
        asm volatile("" ::: "memory"); __builtin_amdgcn_s_barrier(); asm volatile("" ::: "memory"); } } while (0)
    f32x4 acc[2][2][4][2];
#pragma unroll
    for (int a = 0; a < 2; ++a)
#pragma unroll
        for (int b = 0; b < 2; ++b)
#pragma unroll
            for (int m = 0; m < 4; ++m)
#pragma unroll
                for (int n = 0; n < 2; ++n) acc[a][b][m][n] = (f32x4){0.f, 0.f, 0.f, 0.f};
    i32x8 At[4], B0[2], B1[2];
    const int sc127 = 127;
    const char* cA = GATHER ? S.A : S.aptr(cur); const char* cB = S.bptr(cur);
    PG8_GOFF(offC, 0);
    PG8_AREADY(cur);
    PG8_STAGE(PG8_SB(0, 0), cB, voffB[0]); PG8_STAGE(PG8_SB(0, 1), cB, voffB[1]); PG8_STAGE(PG8_SA(0, 0), cA, offC[0]); PG8_STAGE(PG8_SA(0, 1), cA, offC[1]);
    if (wr == 1) PG8_BAR;
    PG8_WAIT_V(2); PG8_BAR;
    PG8_STAGE(PG8_SB(1, 0), cB + kstep, voffB[0]); PG8_STAGE(PG8_SA(1, 0), cA + kstep, offC[0]); PG8_STAGE(PG8_SB(1, 1), cB + kstep, voffB[1]);
    PG8_WAIT_V(6); PG8_BAR;
    for (;;) {
        if constexpr (Epi::NBIAS != 0) { if (wid < 4) {
            __builtin_amdgcn_global_load_lds((const unsigned*)E.bias_src(cur, wid * 64 + lane), (LAS unsigned*)(lds + BIAS_OFF + (ui & 1) * 1024 + wid * 256), 4, 0, 0); } }
        const bool has_next = S.next(ui + 1, nxt);
        const char* nA = GATHER ? cA : (has_next ? S.aptr(nxt) : cA); const char* nB = has_next ? S.bptr(nxt) : cB;
        if constexpr (GATHER) { if (has_next) PG8_GOFF(offN, ui + 1); else {
#pragma unroll
            for (int h = 0; h < 2; ++h) { offN[h][0] = offC[h][0]; offN[h][1] = offC[h][1]; } } }
#pragma nounroll
        for (int t = 0; t < nt; t += 2) {
            const bool last = (t == nt - 2);
            if (last && has_next) PG8_AREADY(nxt);
            const char* a1 = cA + (size_t)(t + 1) * kstep;
            const char* a2 = last ? nA : cA + (size_t)(t + 2) * kstep; const char* b2 = last ? nB : cB + (size_t)(t + 2) * kstep;
            const char* a3 = a2 + kstep; const char* b3 = b2 + kstep;
            unsigned o2[2][2];
#pragma unroll
            for (int h = 0; h < 2; ++h) { o2[h][0] = (GATHER && last) ? offN[h][0] : offC[h][0]; o2[h][1] = (GATHER && last) ? offN[h][1] : offC[h][1]; }
            PG8_LDB(B0, 0, 0); PG8_LDB(B1, 0, 1); PG8_SCHED; PG8_LDA(At, 0, 0); PG8_STAGE(PG8_SA(1, 1), a1, offC[1]);
            PG8_WAIT_V(8); PG8_WAIT_L(0); PG8_BAR; PG8_SCHED8; PG8_MMA(0, 0, At, B0); PG8_MMA(0, 1, At, B1); PG8_BAR; PG8_SCHED;
            PG8_LDA(At, 0, 1); PG8_STAGE(PG8_SB(0, 0), b2, voffB[0]); PG8_STAGE(PG8_SB(0, 1), b2, voffB[1]); PG8_STAGE(PG8_SA(0, 0), a2, o2[0]);
            PG8_WAIT_V(8); PG8_WAIT_L(0); PG8_BAR; PG8_SCHED8; PG8_MMA(1, 0, At, B0); PG8_MMA(1, 1, At, B1); PG8_BAR; PG8_SCHED;
            PG8_LDB(B0, 1, 0); PG8_LDB(B1, 1, 1); PG8_SCHED; PG8_LDA(At, 1, 0); PG8_STAGE(PG8_SA(0, 1), a2, o2[1]);
            PG8_WAIT_V(8); PG8_WAIT_L(0); PG8_BAR; PG8_SCHED8; PG8_MMA(0, 0, At, B0); PG8_MMA(0, 1, At, B1); PG8_BAR; PG8_SCHED;
            PG8_LDA(At, 1, 1); PG8_STAGE(PG8_SB(1, 0), b3, voffB[0]); PG8_STAGE(PG8_SB(1, 1), b3, voffB[1]); PG8_STAGE(PG8_SA(1, 0), a3, o2[0]);
            PG8_WAIT_V(8); PG8_WAIT_L(0); PG8_BAR; PG8_SCHED8; PG8_MMA(1, 0, At, B0); PG8_MMA(1, 1, At, B1); PG8_BAR; PG8_SCHED;
        }
        if constexpr (HANDOFF == 1) { if (prev_pm >= 0 && lane == 0) {
            __hip_atomic_fetch_add(hand.cnt + 64 * prev_pm, 1u, __ATOMIC_RELAXED, __HIP_MEMORY_SCOPE_AGENT); } prev_pm = cur.pm; }
        if constexpr (ALIGN_EPI) { if (wr == 0) PG8_BAR; }
        if constexpr (FP8) asm volatile("s_nop 15\n\ts_nop 15" ::: "memory");
        E(acc, cur, wr, wc, fr, fq, (const LAS float*)(lds + BIAS_OFF + (ui & 1) * 1024));
        if (!has_next) break;
#pragma unroll
        for (int a = 0; a < 2; ++a)
#pragma unroll
            for (int b = 0; b < 2; ++b)
#pragma unroll
                for (int m = 0; m < 4; ++m)
#pragma unroll
                    for (int n = 0; n < 2; ++n) acc[a][b][m][n] = (f32x4){0.f, 0.f, 0.f, 0.f};
        cur = nxt; cA = nA; cB = nB; ++ui;
        if constexpr (GATHER) {
#pragma unroll
            for (int h = 0; h < 2; ++h) { offC[h][0] = offN[h][0]; offC[h][1] = offN[h][1]; } }
        if constexpr (ALIGN_EPI) { if (wr == 1) PG8_BAR; }
    }
    PG8_WAIT_V(0);
    if constexpr (HANDOFF == 1) { if (lane == 0) { __hip_atomic_fetch_add(hand.cnt + 64 * prev_pm, 1u, __ATOMIC_RELAXED, __HIP_MEMORY_SCOPE_AGENT); } }
    if constexpr (!ALIGN_EPI) { if (wr == 0) PG8_BAR; }
    PG8_BAR;
#undef PG8_SA
#undef PG8_SB
#undef PG8_STAGE
#undef PG8_LDA
#undef PG8_LDB
#undef PG8_MMA
#undef PG8_WAIT_V
#undef PG8_WAIT_L
#undef PG8_BAR
#undef PG8_SCHED
#undef PG8_SCHED8
#undef PG8_GOFF
#undef PG8_AREADY
}

}

constexpr int NWAVES = 8;
constexpr int T = 32768, D = 1024, SEQ = 2048, NB = 16;
constexpr int NZ = 3072;
constexpr int ZQ = 0, ZK = 256, ZV = 512, ZO = 1024, ZSB = 1536, ZSC = 2048, ZSX = 2560;
constexpr int NE = 32, TOPK = 4;
constexpr int PROWS = 139264;
constexpr float ALPHA = 1.41421356237309515f;
constexpr float LN_EPS = 1e-5f, HEAD_EPS = 1e-6f;
constexpr int NPH = 17;

constexpr size_t MiB = 1u << 20;
constexpr size_t WS_CTL = 0, CTL_ZERO_BYTES = 1 * MiB;
constexpr size_t WS_TOPI = 1 * MiB, WS_TOPG = WS_TOPI + MiB / 2, WS_SLOT = 2 * MiB, WS_CNTT = WS_SLOT + MiB / 2, WS_META = WS_CNTT + MiB / 4, WS_GATES = 3 * MiB;
constexpr size_t WS_RWH = 4 * MiB, WS_RWL = WS_RWH + MiB / 4, WS_RGB = WS_RWL + MiB / 4, WS_STATS = 5 * MiB, WS_WSC = 6 * MiB, WS_ROWTOK = 7 * MiB;
constexpr size_t WS_WIN = 8 * MiB, WS_WOUT = 14 * MiB, WS_PW1 = 16 * MiB, WS_PW2 = 20 * MiB, WS_UP = 22 * MiB, WS_DN = 278 * MiB;
constexpr size_t WS_ABF = 406 * MiB, WS_X1B = 470 * MiB, WS_HCAT = 534 * MiB, WS_R = 598 * MiB;
constexpr size_t WS_ACT = 1254 * MiB, WS_YS = 1526 * MiB, WS_Z = 1798 * MiB, WS_U = 1798 * MiB, WS_V = 1862 * MiB, WS_END = 1990 * MiB;
static_assert((size_t)PROWS * 2048 <= 272 * MiB, "grouped buffers");
constexpr int CW_LBAR = 8192, CW_MAPX = 12288;
constexpr int CW_BAR = 4096, CW_QUEUE = 64, Q_CHUNK = 8, CW_UPCNT = 32768, UPCNT_LAYER = 544 * 64, CW_UPTOT = 110592;

constexpr int RING_BYTES = 131072;
constexpr int LDSCTL_OFF = 139264, MISC_OFF = LDSCTL_OFF + 320;
constexpr int TEXP_OFF = 132096;
constexpr int ROWTAB_OFF = 147456;
constexpr int LDS_BYTES = 147456 + 20 * 512;
static_assert(TEXP_OFF + 4096 <= LDSCTL_OFF && MISC_OFF + 128 <= LDS_BYTES, "LDS map");

#define XB_TMO      128
#define XB_XCNT(j)  (256  + 64 * (j))
#define XB_XSUB(j)  (1280 + 64 * (j))
#define XB_XGEN(j)  (2304 + 64 * (j))
#define XB_TOP      3328
#define XB_TOPGEN   3392
#define XCD_BAR_WORDS 3456
#define XB_SPIN_CAP (1u << 18)
__device__ __forceinline__ unsigned xb_ld(unsigned* p)              { return __hip_atomic_load(p, __ATOMIC_RELAXED, __HIP_MEMORY_SCOPE_AGENT); }
__device__ __forceinline__ unsigned xb_add(unsigned* p, unsigned v) { return __hip_atomic_fetch_add(p, v, __ATOMIC_RELAXED, __HIP_MEMORY_SCOPE_AGENT); }
__device__ __forceinline__ unsigned xb_xcc_id() { return (unsigned)__builtin_amdgcn_s_getreg((3 << 11) | 20) & 0xFu; }
#define XB_SPIN(cond, bar) do { unsigned _sp = 0; while (cond) { __builtin_amdgcn_s_sleep(1); \
    if ((++_sp & 255u) == 0u) { if (xb_ld(&(bar)[XB_TMO])) break; if (_sp > XB_SPIN_CAP) { atomicAdd(&(bar)[XB_TMO], 1u); break; } } } } while (0)
struct XcdBarrier { unsigned* bar; unsigned x; volatile LAS unsigned* st; };
__device__ __forceinline__ XcdBarrier xcd_barrier_post(unsigned* bar, volatile LAS unsigned* st) {
    XcdBarrier b; b.bar = bar; b.x = xb_xcc_id(); b.st = st;
    if (threadIdx.x == 0) (void)xb_add(&bar[XB_XCNT(b.x)], 1u);
    return b;
}
__device__ __forceinline__ void xcd_barrier_complete(unsigned* bar, unsigned x, unsigned& nloc, unsigned& nx) {
    const unsigned G = gridDim.x * gridDim.y * gridDim.z;
    unsigned sum, cnt, mine, sp = 0u;
    for (;;) {
        sum = 0u; cnt = 0u; mine = 0u;
#pragma unroll
        for (unsigned j = 0; j < 16; ++j) { const unsigned c = xb_ld(&bar[XB_XCNT(j)]); sum += c; cnt += (c > 0u) ? 1u : 0u; mine = (j == x) ? c : mine; }
        if (sum == G) break;
        __builtin_amdgcn_s_sleep(1);
        if ((++sp & 255u) == 0u) { if (xb_ld(&bar[XB_TMO])) break; if (sp > XB_SPIN_CAP) { atomicAdd(&bar[XB_TMO], 1u); break; } }
    }
    nloc = mine > 0u ? mine : 1u; nx = cnt > 0u ? cnt : 1u;
}
__device__ __forceinline__ void xcd_barrier(const XcdBarrier& b) {
    asm volatile("s_waitcnt vmcnt(0)" ::: "memory");
    __syncthreads();
    if (threadIdx.x == 0) {
        unsigned* bar = b.bar;
        __builtin_amdgcn_s_waitcnt(0);
        unsigned nloc = b.st[0], nx = b.st[1];
        if (nloc == 0u) { xcd_barrier_complete(bar, b.x, nloc, nx); b.st[0] = nloc; b.st[1] = nx; }
        const unsigned old = xb_add(&bar[XB_XSUB(b.x)], 1u);
        const unsigned gen = old / nloc;
        if (old + 1u == (gen + 1u) * nloc) {
            __builtin_amdgcn_fence(__ATOMIC_RELEASE, "agent");
            asm volatile("s_waitcnt vmcnt(0)" ::: "memory");
            const unsigned og = xb_add(&bar[XB_TOP], 1u);
            const unsigned tg = og / nx;
            if (og + 1u == (tg + 1u) * nx) xb_add(&bar[XB_TOPGEN], 1u);
            else XB_SPIN(xb_ld(&bar[XB_TOPGEN]) == tg, bar);
            __builtin_amdgcn_fence(__ATOMIC_ACQUIRE, "agent");
            xb_add(&bar[XB_XGEN(b.x)], 1u);
            asm volatile("s_waitcnt vmcnt(0)" ::: "memory");
        } else {
            XB_SPIN(xb_ld(&bar[XB_XGEN(b.x)]) == gen, bar);
            __builtin_amdgcn_fence(__ATOMIC_ACQUIRE, "agent");
            asm volatile("s_waitcnt vmcnt(0)" ::: "memory");
        }
    }
    __syncthreads();
}

__device__ __forceinline__ void xcd_local_barrier(const XcdBarrier& b, unsigned* lb) {
    asm volatile("s_waitcnt vmcnt(0)" ::: "memory");
    __syncthreads();
    if (threadIdx.x == 0) {
        __builtin_amdgcn_s_waitcnt(0);
        const unsigned nloc = b.st[0];
        const unsigned old = xb_add(&lb[64 * b.x], 1u), gen = old / nloc;
        if (old + 1u == (gen + 1u) * nloc) (void)xb_add(&lb[1024 + 64 * b.x], 1u);
        else XB_SPIN(xb_ld(&lb[1024 + 64 * b.x]) == gen, b.bar);
        __builtin_amdgcn_fence(__ATOMIC_ACQUIRE, "agent");
        asm volatile("s_waitcnt vmcnt(0)" ::: "memory");
    }
    __syncthreads();
}

struct Args { const float* in[21]; float* out; unsigned char* ws; int ph_lo, ph_hi; };
struct Frame {
    LAS unsigned char* lds;
    int tid, lane, wave, vcu, G;
    bool own;
    unsigned char* ws;
};
__device__ __forceinline__ float wave_sum(float v) {
#pragma unroll
    for (int o = 1; o < 64; o <<= 1) v += __shfl_xor(v, o);
    return v;
}
__device__ __forceinline__ float wave_max(float v) {
#pragma unroll
    for (int o = 1; o < 64; o <<= 1) v = fmaxf(v, __shfl_xor(v, o));
    return v;
}

struct TrItem { const float* src; bf16* dst; int ld; float scale; int fp8; };
__device__ __forceinline__ void tr_load(const TrItem& I, int lane, f32x4 (&tv)[8]) {
#pragma unroll
    for (int i = 0; i < 8; ++i) tv[i] = *(const GAS f32x4*)(I.src + (size_t)((lane >> 3) + 8 * i) * I.ld + 4 * (lane & 7));
}
__device__ __forceinline__ void tr_store(const TrItem& I, const f32x4 (&tv)[8], LAS float* scr, int lane) {
#pragma unroll
    for (int i = 0; i < 8; ++i) { LAS float* p = scr + ((lane >> 3) + 8 * i) * 33 + 4 * (lane & 7); p[0] = tv[i][0]; p[1] = tv[i][1]; p[2] = tv[i][2]; p[3] = tv[i][3]; }
    LDS_WAIT(); asm volatile("" ::: "memory");
    const int c = lane & 7; const float scale = I.scale;
#pragma unroll
    for (int j = 0; j < 4; ++j) { const int n = (lane >> 3) + 8 * j; const LAS float* s = scr + (8 * c) * 33 + n;
        if (I.fp8) { v2u o; o.x = pk4_fp8(s[0 * 33] * scale, s[1 * 33] * scale, s[2 * 33] * scale, s[3 * 33] * scale); o.y = pk4_fp8(s[4 * 33] * scale, s[5 * 33] * scale, s[6 * 33] * scale, s[7 * 33] * scale);
            *(GAS v2u*)((unsigned char*)I.dst + (size_t)n * 1024 + 8 * c) = o; }
        else { v4u o; o.x = cvt_pk_bf16(s[0 * 33] * scale, s[1 * 33] * scale); o.y = cvt_pk_bf16(s[2 * 33] * scale, s[3 * 33] * scale); o.z = cvt_pk_bf16(s[4 * 33] * scale, s[5 * 33] * scale); o.w = cvt_pk_bf16(s[6 * 33] * scale, s[7 * 33] * scale);
            *(GAS v4u*)(I.dst + (size_t)n * 1024 + 8 * c) = o; } }
    LDS_WAIT(); asm volatile("" ::: "memory");
}
__device__ __forceinline__ int glu_src_col(int d0) { const int pn = d0 >> 8, j0 = d0 & 255; return j0 < 128 ? 128 * pn + j0 : 1024 + 128 * pn + (j0 - 128); }

constexpr int I_IN = 16 * 96, I_OUT = 16 * 32, I_PW1 = 16 * 64, I_PW2 = 16 * 32, I_UP = 64 * 1024, I_DN = 64 * 512;
constexpr int I_EARLY = I_IN + I_OUT, NITEMS = I_IN + I_OUT + I_PW1 + I_PW2 + I_UP + I_DN;
#ifndef MK_P0_ITEMS
#define MK_P0_ITEMS 0
#endif
constexpr int I_P0 = I_EARLY + MK_P0_ITEMS;
__device__ __forceinline__ TrItem tr_decode(Frame& F, const Args& A, int it, const float (&wsc)[4]) {
    bf16* WIN = (bf16*)(F.ws + WS_WIN); bf16* WOUT = (bf16*)(F.ws + WS_WOUT); bf16* PW1 = (bf16*)(F.ws + WS_PW1); bf16* PW2 = (bf16*)(F.ws + WS_PW2);
    bf16* UP = (bf16*)(F.ws + WS_UP); bf16* DN = (bf16*)(F.ws + WS_DN);
    TrItem I; I.scale = 1.0f; I.fp8 = 0; int r = it;
    if (r < I_IN) { const int kb = r / 96, nb = r % 96, d0 = 32 * nb, sc0 = d0 + (d0 >= 1536 ? 8 : 0); I.scale = (d0 >= 256 && d0 < 512) ? 0.125f : 1.0f;
        I.src = A.in[1] + (size_t)kb * 64 * 3080 + sc0; I.ld = 3080; I.dst = WIN + (size_t)d0 * 1024 + kb * 64; return I; } r -= I_IN;
    if (r < I_OUT) { const int kb = r >> 5, nb = r & 31; I.src = A.in[6] + (size_t)kb * 64 * 1024 + 32 * nb; I.ld = 1024; I.dst = WOUT + (size_t)(32 * nb) * 1024 + kb * 64; return I; } r -= I_OUT;
    if (r < I_PW1) { const int kb = r >> 6, nb = r & 63, d0 = 32 * nb; I.src = A.in[7] + (size_t)kb * 64 * 2048 + glu_src_col(d0); I.ld = 2048; I.dst = PW1 + (size_t)d0 * 1024 + kb * 64; return I; } r -= I_PW1;
    if (r < I_PW2) { const int kb = r >> 5, nb = r & 31; I.src = A.in[12] + (size_t)kb * 64 * 1024 + 32 * nb; I.ld = 1024; I.dst = PW2 + (size_t)(32 * nb) * 1024 + kb * 64; return I; } r -= I_PW2;
    if (r < I_UP) { const int le = r >> 10, rr = r & 1023, kb = rr >> 6, nb = rr & 63, d0 = 32 * nb;
        I.src = A.in[15] + (size_t)le * 1024 * 2048 + (size_t)kb * 64 * 2048 + glu_src_col(d0); I.ld = 2048;
        I.fp8 = 1; I.scale = (le >> 5) ? wsc[2] : wsc[0]; I.dst = (bf16*)((unsigned char*)UP + (size_t)le * 2048 * 1024 + (size_t)d0 * 1024 + kb * 64); return I; } r -= I_UP;
    { const int le = r >> 9, rr = r & 511, kb = rr >> 5, nb = rr & 31;
        I.src = A.in[17] + (size_t)le * 1024 * 1024 + (size_t)kb * 64 * 1024 + 32 * nb; I.ld = 1024;
        I.fp8 = 1; I.scale = (le >> 5) ? wsc[3] : wsc[1]; I.dst = (bf16*)((unsigned char*)DN + (size_t)le * 1024 * 1024 + (size_t)(32 * nb) * 1024 + kb * 64); return I; }
}
__device__ __forceinline__ void convert_items(Frame& F, const Args& A, int first, int last, int w0, int nw, const float (&wsc)[4]) {
    LAS float* scr = (LAS float*)(F.lds + F.wave * 17408); LAS float* scr2 = scr + 2176;
    int it = first + w0; if (it >= last) return;
    f32x4 ta[8], tb[8];
    TrItem a = tr_decode(F, A, it, wsc), b = a; tr_load(a, F.lane, ta);
    for (;;) {
        const int itb = it + nw; const bool hb = itb < last;
        b = tr_decode(F, A, hb ? itb : it, wsc); tr_load(b, F.lane, tb);
        tr_store(a, ta, scr, F.lane);
        if (!hb) break;
        const int ita = itb + nw; const bool ha = ita < last;
        a = tr_decode(F, A, ha ? ita : itb, wsc); tr_load(a, F.lane, ta);
        tr_store(b, tb, scr2, F.lane);
        if (!ha) break;
        it = ita;
    }
}

constexpr int XT_UP = 64 * 128, XT_DN = 64 * 64, XT_ALL = XT_UP + XT_DN;
struct XTask { const float* lsrc; unsigned char* dst; int N; float scale; };
__device__ __forceinline__ int xt_task(int q) { return q < 4096 ? q : (q < 6144 ? XT_UP + (q - 4096) : (q < 10240 ? 4096 + (q - 6144) : q)); }
__device__ __forceinline__ XTask xt_setup(Frame& F, const Args& A, int t, float sc_up0, float sc_dn0, float sc_up1, float sc_dn1) {
    XTask X; const float* src; const int r2 = F.lane >> 5, c = F.lane & 31;
    if (t < XT_UP) { const int le = t >> 7, r = t & 127, ks = r >> 4, nb = r & 15, c0 = nb * 128; X.N = 2048; X.scale = (le >> 5) ? sc_up1 : sc_up0;
        const int d0 = (c0 < 1024) ? 2 * c0 : 2 * (c0 - 1024) + 128;
        src = A.in[15] + (size_t)le * 1024 * 2048 + (size_t)(ks * 128) * 2048 + c0;
        X.dst = (unsigned char*)(F.ws + WS_UP) + (size_t)le * 2048 * 1024 + (size_t)d0 * 1024 + ks * 128; }
    else { const int tt = t - XT_UP, le = tt >> 6, r = tt & 63, ks = r >> 3, nb = r & 7; X.N = 1024; X.scale = (le >> 5) ? sc_dn1 : sc_dn0;
        src = A.in[17] + (size_t)le * 1024 * 1024 + (size_t)(ks * 128) * 1024 + nb * 128;
        X.dst = (unsigned char*)(F.ws + WS_DN) + (size_t)le * 1024 * 1024 + (size_t)(nb * 128) * 1024 + ks * 128; }
    X.lsrc = src + (size_t)(64 * r2) * X.N + 4 * c;
    return X;
}

__device__ __forceinline__ float sample_scale(const float* w, int lane) {
    float a = 0.f;
#pragma unroll 4
    for (int i = 0; i < 16; ++i) { const f32x4 v = *(const GAS f32x4*)(w + 4 * lane + 256 * i); a = fmaxf(a, fmaxf(fmaxf(fabsf(v[0]), fabsf(v[1])), fmaxf(fabsf(v[2]), fabsf(v[3])))); }
    a = wave_max(a); return (a > 0.f) ? ldexpf(1.0f, 4 - ilogbf(a)) : 1.0f;
}
constexpr int NSMALL = (I_PW1 + I_PW2) / Q_CHUNK;
#ifndef MK_XT_DEFER
#define MK_XT_DEFER 4800
#endif
constexpr int XT_DEFER = MK_XT_DEFER;
static_assert(XT_DEFER >= 0 && XT_DEFER <= 6144, "only layer-1 tasks can be deferred");
static_assert(MK_P0_ITEMS == 0 && (I_PW1 + I_PW2) % Q_CHUNK == 0, "queue layout");
__device__ __forceinline__ void convert_queue(Frame& F, const Args& A, int qword, int qbase, int QEND) {
    unsigned* qhead = (unsigned*)(F.ws + WS_CTL) + CW_QUEUE + 16 * qword;
    float wsc[4];
#pragma unroll
    for (int i = 0; i < 4; ++i) wsc[i] = ((const float*)(F.ws + WS_WSC))[i];
    int pos;
    for (;;) { unsigned pos_ = 0u; if (F.lane == 0) pos_ = __hip_atomic_fetch_add(qhead, 1u, __ATOMIC_RELAXED, __HIP_MEMORY_SCOPE_AGENT);
        pos = qbase + (int)__builtin_amdgcn_readfirstlane(pos_); if (pos >= NSMALL || pos >= QEND) break;
        convert_items(F, A, I_EARLY + pos * Q_CHUNK, I_EARLY + (pos + 1) * Q_CHUNK, 0, 1, wsc); }
    if (pos >= QEND) return;
    const int lane = F.lane, r2 = lane >> 5, c = lane & 31;
    LAS unsigned char* tile = F.lds + F.wave * 17408;
    f32x4 va[16], vb[16];
#define XT_LOAD(v_, X_, st_) do { _Pragma("unroll") for (int i_ = 0; i_ < 16; ++i_) v_[i_] = __builtin_nontemporal_load((const GAS f32x4*)(X_.lsrc + (size_t)((st_) * 16 + i_) * X_.N)); } while (0)
#define XT_PUT(v_, X_, st_) do { const float sc_ = X_.scale; _Pragma("unroll") for (int j_ = 0; j_ < 4; ++j_) { v4u o_; \
        o_.x = pk4_fp8(v_[0][j_] * sc_, v_[1][j_] * sc_, v_[2][j_] * sc_, v_[3][j_] * sc_); o_.y = pk4_fp8(v_[4][j_] * sc_, v_[5][j_] * sc_, v_[6][j_] * sc_, v_[7][j_] * sc_); \
        o_.z = pk4_fp8(v_[8][j_] * sc_, v_[9][j_] * sc_, v_[10][j_] * sc_, v_[11][j_] * sc_); o_.w = pk4_fp8(v_[12][j_] * sc_, v_[13][j_] * sc_, v_[14][j_] * sc_, v_[15][j_] * sc_); \
        *(LAS v4u*)(tile + (4 * c + j_) * 128 + (((4 * r2 + (st_)) ^ (c & 7)) << 4)) = o_; } } while (0)
    XTask cur = xt_setup(F, A, xt_task(pos - NSMALL), wsc[0], wsc[1], wsc[2], wsc[3]);
    XT_LOAD(va, cur, 0); XT_LOAD(vb, cur, 1);
    for (;;) {
        unsigned np_ = (unsigned)QEND; if (lane == 0) np_ = (unsigned)qbase + __hip_atomic_fetch_add(qhead, 1u, __ATOMIC_RELAXED, __HIP_MEMORY_SCOPE_AGENT);
        XT_PUT(va, cur, 0); XT_LOAD(va, cur, 2); XT_PUT(vb, cur, 1); XT_LOAD(vb, cur, 3); XT_PUT(va, cur, 2); XT_PUT(vb, cur, 3);
        const int npos = (int)__builtin_amdgcn_readfirstlane(np_); const bool has_next = npos < QEND;
        XTask nxt = cur;
        if (has_next) { nxt = xt_setup(F, A, xt_task(npos - NSMALL), wsc[0], wsc[1], wsc[2], wsc[3]); XT_LOAD(va, nxt, 0); XT_LOAD(vb, nxt, 1); }
        LDS_WAIT(); asm volatile("" ::: "memory");
#pragma unroll
        for (int i = 0; i < 16; ++i) { const int n = 8 * i + (lane >> 3), ch = lane & 7;
            const v4u w_ = *(const LAS v4u*)(tile + n * 128 + ((ch ^ ((n >> 2) & 7)) << 4));
            __builtin_nontemporal_store(w_, (GAS v4u*)(cur.dst + (size_t)n * 1024 + ch * 16)); }
        LDS_WAIT(); asm volatile("" ::: "memory");
        if (!has_next) break;
        cur = nxt; pos = npos;
    }
#undef XT_LOAD
#undef XT_PUT
}
__device__ __forceinline__ void p0_prologue(Frame& F, const Args& A) {
    const int gw = F.vcu * NWAVES + F.wave, NGW = F.G * NWAVES;
    for (int le = gw; le < 64; le += NGW) { const int l = le >> 5, e = le & 31; const float* rw = A.in[13] + (size_t)l * 1024 * 32; const float* lg = A.in[19] + (size_t)(l * 2) * D; const float* lb = A.in[20] + (size_t)(l * 2) * D;
        bf16* RWH = (bf16*)(F.ws + WS_RWH) + (size_t)le * 1024; bf16* RWL = (bf16*)(F.ws + WS_RWL) + (size_t)le * 1024; float sG = 0.f, sB = 0.f;
        for (int i = 0; i < 16; ++i) { const int d = F.lane + 64 * i; const float w0 = rw[d * 32 + e]; const float wv = lg[d] * w0; const unsigned hi = f2bf(wv); const unsigned lo = f2bf(wv - bf1((unsigned short)hi));
            RWH[d] = (unsigned short)hi; RWL[d] = (unsigned short)lo; sG += wv; sB += lb[d] * w0; }
        sG = wave_sum(sG); sB = wave_sum(sB);
        if (F.lane == 0) { float* RGB = (float*)(F.ws + WS_RGB); RGB[l * 64 + e] = sG; RGB[l * 64 + 32 + e] = sB + A.in[14][l * 32 + e]; } }
    static_assert(MK_P0_ITEMS <= I_PW1 + I_PW2 + 32 * 1024, "P0 may only convert layer-0 up-projection weights among the expert weights");
    if (gw >= 64 && gw < 68) { const int l = (gw - 64) >> 1, dn = (gw - 64) & 1; const float sc = sample_scale(dn ? A.in[17] + (size_t)l * 32 * 1024 * 1024 : A.in[15] + (size_t)l * 32 * 1024 * 2048, F.lane);
        if (F.lane == 0) ((float*)(F.ws + WS_WSC))[l * 2 + dn] = sc; }
    { const float w0s = sample_scale(A.in[15], F.lane); const float wsc[4] = {w0s, 0.f, 0.f, 0.f};
      convert_items(F, A, 0, I_P0, gw, NGW, wsc); }
    __syncthreads();
    LAS float* Wg = (LAS float*)F.lds;
    for (int idx = F.tid; idx < 8192; idx += NWAVES * 64) { const int k = idx >> 3, g = idx & 7; Wg[g * 1024 + k] = A.in[1][(size_t)k * 3080 + 1536 + g]; }
    __syncthreads();
    bf16* XB = (bf16*)(F.ws + WS_ABF); float* GATES = (float*)(F.ws + WS_GATES);
    const float bias_l = F.lane < 4 ? A.in[2][F.lane & 3] : A.in[3][F.lane & 3];
    f32x4 vn[4];
    if (gw < T) { const GAS f32x4* xr = (const GAS f32x4*)(A.in[0] + (size_t)gw * D) + F.lane;
#pragma unroll
        for (int j = 0; j < 4; ++j) vn[j] = xr[64 * j]; }
    for (int m = gw; m < T; m += NGW) {
        f32x4 v[4];
#pragma unroll
        for (int j = 0; j < 4; ++j) v[j] = vn[j];
        if (m + NGW < T) { const GAS f32x4* xr = (const GAS f32x4*)(A.in[0] + (size_t)(m + NGW) * D) + F.lane;
#pragma unroll
            for (int j = 0; j < 4; ++j) vn[j] = xr[64 * j]; }
        GAS v2u* o8 = (GAS v2u*)(XB + (size_t)m * D) + F.lane;
#pragma unroll
        for (int j = 0; j < 4; ++j) { v2u w; w.x = cvt_pk_bf16(v[j][0], v[j][1]); w.y = cvt_pk_bf16(v[j][2], v[j][3]); o8[64 * j] = w; }
        float mine = 0.f;
#pragma unroll
        for (int g = 0; g < 8; ++g) { float s = 0.f;
#pragma unroll
            for (int j = 0; j < 4; ++j) { const f32x4 w = *(const LAS f32x4*)(Wg + g * 1024 + 4 * F.lane + 256 * j); s += (v[j][0] * w[0] + v[j][1] * w[1]) + (v[j][2] * w[2] + v[j][3] * w[3]); }
            s = wave_sum(s); mine = (F.lane == g) ? s : mine; }
        if (F.lane < 8) { float val = mine + bias_l; if (F.lane >= 4) val = fminf(val, 0.f) - log1pf(__expf(-fabsf(val))); GATES[(size_t)m * 8 + F.lane] = val; }
    }
}

#define DPPF(old_, src_, ctrl_, rmask_) __builtin_bit_cast(float, __builtin_amdgcn_update_dpp(__builtin_bit_cast(int, (float)(old_)), __builtin_bit_cast(int, (float)(src_)), (ctrl_), (rmask_), 0xf, false))
__device__ __forceinline__ float row16_sum(float x) { x += DPPF(0.f, x, 0x128, 0xf); x += DPPF(0.f, x, 0x124, 0xf); x += DPPF(0.f, x, 0x122, 0xf); x += DPPF(0.f, x, 0x121, 0xf); return x; }
__device__ __forceinline__ float scan_add64(float x) { x += DPPF(0.f, x, 0x111, 0xf); x += DPPF(0.f, x, 0x112, 0xf); x += DPPF(0.f, x, 0x114, 0xf); x += DPPF(0.f, x, 0x118, 0xf);
    x += DPPF(0.f, x, 0x142, 0xa); x += DPPF(0.f, x, 0x143, 0xc); return x; }
__device__ __forceinline__ float scan_max64(float x) { const float ni = -INFINITY;
    x = fmaxf(x, DPPF(ni, x, 0x111, 0xf)); x = fmaxf(x, DPPF(ni, x, 0x112, 0xf)); x = fmaxf(x, DPPF(ni, x, 0x114, 0xf)); x = fmaxf(x, DPPF(ni, x, 0x118, 0xf));
    x = fmaxf(x, DPPF(ni, x, 0x142, 0xa)); x = fmaxf(x, DPPF(ni, x, 0x143, 0xc)); return x; }
__device__ __forceinline__ float lane63(float x) { return __builtin_bit_cast(float, __builtin_amdgcn_readlane(__builtin_bit_cast(int, x), 63)); }
typedef short v4i16 __attribute__((ext_vector_type(4)));
__device__ __forceinline__ bf16x8 tr_frag(const LAS unsigned char* base, int pitch, int k0, int col0, int fr) {
    const LAS unsigned char* a = base + (k0 + (fr >> 2)) * pitch + (col0 + 4 * (fr & 3)) * 2;
    const v4i16 lo = __builtin_amdgcn_ds_read_tr16_b64_v4i16((LAS v4i16*)a), hi = __builtin_amdgcn_ds_read_tr16_b64_v4i16((LAS v4i16*)(a + 4 * pitch));
    return __builtin_shufflevector(lo, hi, 0, 1, 2, 3, 4, 5, 6, 7);
}
__device__ __forceinline__ int swz16(int r, int c) { return r * 144 + ((((c >> 3) ^ ((r >> 3) & 7))) << 4) + (c & 7) * 2; }
__device__ __forceinline__ void mlstm_item(Frame& F, const Args& A, int item2) {
    const int item = item2 >> 1, T0 = 32 * (item2 & 1);
    const int b = item >> 2, h = item & 3, tid = F.tid, lane = F.lane, w = F.wave;
    LAS unsigned char* L = F.lds;
    constexpr int P = 144, PO = 272;
    constexpr int QS = 0, KS = QS + 64 * P, VT = KS + 64 * P, KW = VT + 64 * PO, CT = KW + 64 * P, SS = CT + 64 * PO, OS = SS + 64 * P, HS = OS + 64 * PO, FA = HS + 64 * PO;
    LAS float* fa = (LAS float*)(L + FA);
    constexpr int BV = 0, UV = 64, MT = 128, WI = 192, WL = 256, EI = 320, NP = 384, QNP = 448, RS = 960, HSUM = 1216, HSQ = 1344, SCAL = 1472;
    static_assert(FA + 1480 * 4 <= RING_BYTES, "mlstm LDS");
    const bf16* Z = (const bf16*)(F.ws + WS_Z); const float* GATES = (const float*)(F.ws + WS_GATES); bf16* HCAT = (bf16*)(F.ws + WS_HCAT);
    int fr_ = lane & 15, fq_ = lane >> 4; const int fr = lane & 15;
    for (int i = tid; i < 64 * PO / 4; i += 512) ((LAS unsigned*)(L + CT))[i] = 0u;
    if (tid < 64) fa[NP + tid] = 0.f;
    f32x4 accC[4];
#pragma unroll
    for (int j = 0; j < 4; ++j) accC[j] = (f32x4){0.f, 0.f, 0.f, 0.f};
    float m_prev = 0.f;
    float gain[2];
#pragma unroll
    for (int j = 0; j < 2; ++j) gain[j] = A.in[5][h * 128 + 16 * ((w >> 1) * 2 + j) + fr];
    int srow_ = tid >> 3, spc_ = tid & 7;
    int vrow0_ = tid >> 4, vpc_ = tid & 15;
    const int srow = tid >> 3, spc = tid & 7, vrow0 = tid >> 4, vpc = tid & 15;
    struct StageRegs { v4u q, k, v[2], o; float ig, lf; };
    StageRegs sA, sB; sA.ig = sA.lf = sB.ig = sB.lf = 0.f; sA.q = sB.q = (v4u){0u, 0u, 0u, 0u};
    const size_t zb = (size_t)(b * SEQ) * NZ;
#define MLSTM_LOAD(RS, c) do { const size_t t0 = (size_t)(c) * 64; \
        if (tid < 256) RS.q = *(const GAS v4u*)(Z + zb + (t0 + T0 + srow) * NZ + ZQ + h * 64 + spc * 8); \
        RS.k = *(const GAS v4u*)(Z + zb + (t0 + srow) * NZ + ZK + h * 64 + spc * 8); \
        _Pragma("unroll") for (int i = 0; i < 2; ++i) RS.v[i] = *(const GAS v4u*)(Z + zb + (t0 + vrow0 + 32 * i) * NZ + ZV + h * 128 + vpc * 8); \
        RS.o = *(const GAS v4u*)(Z + zb + (t0 + T0 + vrow0) * NZ + ZO + h * 128 + vpc * 8); \
        if (tid < 64) { RS.ig = GATES[((size_t)(b * SEQ) + t0 + tid) * 8 + h]; RS.lf = GATES[((size_t)(b * SEQ) + t0 + tid) * 8 + 4 + h]; } } while (0)
#define MLSTM_SCALARS(RS) do { if (w == 0) { \
            const float bcum = scan_add64(RS.lf); \
            const float g_ = lane63(bcum); const float u_ = RS.ig - bcum; const float cm = scan_max64(u_); \
            const float a_ = g_ + u_, amax = lane63(scan_max64(a_)); const float m_new = fmaxf(g_ + m_prev, amax); const float mt_ = bcum + fmaxf(m_prev, cm); \
            fa[BV + lane] = bcum; fa[UV + lane] = u_; fa[MT + lane] = mt_; fa[WI + lane] = __expf(bcum + m_prev - mt_); fa[WL + lane] = __expf(a_ - m_new); fa[EI + lane] = __expf(-mt_); \
            if (lane == 0) fa[SCAL] = __expf(g_ + m_prev - m_new); \
            m_prev = m_new; } } while (0)
    MLSTM_LOAD(sA, 0); MLSTM_LOAD(sB, 1);
    MLSTM_SCALARS(sA);
    __syncthreads();
    auto chunk = [&](StageRegs& RSC, StageRegs& RSN, const int cc) __attribute__((always_inline)) {
        asm volatile("" : "+v"(fr_), "+v"(fq_), "+v"(srow_), "+v"(spc_), "+v"(vrow0_), "+v"(vpc_));
        const int fr = fr_, fq = fq_, srow = srow_, spc = spc_, vrow0 = vrow0_, vpc = vpc_;
        if (tid < 256) *(LAS v4u*)(L + QS + srow * P + spc * 16) = RSC.q;
        *(LAS v4u*)(L + KS + srow * P + spc * 16) = RSC.k;
        *(LAS v4u*)(L + OS + vrow0 * PO + vpc * 16) = RSC.o;
#pragma unroll
        for (int i = 0; i < 2; ++i) *(LAS v4u*)(L + VT + (vrow0 + 32 * i) * PO + vpc * 16) = RSC.v[i];
        if (cc + 2 < 32) MLSTM_LOAD(RSC, cc + 2);
        LBAR();
        { const v4u kk = *(const LAS v4u*)(L + KS + srow * P + spc * 16); const float wl = fa[WL + srow]; v4u kw;
          kw.x = cvt_pk_bf16(bflo(kk.x) * wl, bfhi(kk.x) * wl); kw.y = cvt_pk_bf16(bflo(kk.y) * wl, bfhi(kk.y) * wl); kw.z = cvt_pk_bf16(bflo(kk.z) * wl, bfhi(kk.z) * wl); kw.w = cvt_pk_bf16(bflo(kk.w) * wl, bfhi(kk.w) * wl);
          *(LAS v4u*)(L + KW + srow * P + spc * 16) = kw; }
        { const int tr = w >> 2, tc = w & 3; f32x4 acc = (f32x4){0.f, 0.f, 0.f, 0.f};
#pragma unroll
          for (int ks = 0; ks < 2; ++ks) { const bf16x8 qa = *(const LAS bf16x8*)(L + QS + (16 * tr + fr) * P + ks * 64 + fq * 16); const bf16x8 kb = *(const LAS bf16x8*)(L + KS + (16 * tc + fr) * P + ks * 64 + fq * 16);
              acc = __builtin_amdgcn_mfma_f32_16x16x32_bf16(qa, kb, acc, 0, 0, 0); }
          const int s = 16 * tc + fr; const float us = fa[UV + s]; float rs[4];
#pragma unroll
          for (int r = 0; r < 4; ++r) { const int tl = 16 * tr + 4 * fq + r, t = T0 + tl; const float wgt = (s <= t) ? __expf(fa[BV + t] - fa[MT + t] + us) : 0.f; const float val = acc[r] * wgt;
              *(LAS unsigned short*)(L + SS + tl * P + s * 2) = (unsigned short)f2bf(val); rs[r] = val; }
#pragma unroll
          for (int r = 0; r < 4; ++r) rs[r] = row16_sum(rs[r]);
          if (fr == 0) {
#pragma unroll
              for (int r = 0; r < 4; ++r) fa[RS + tc * 64 + 16 * tr + 4 * fq + r] = rs[r]; } }
        if (tid < 256) { const int t = tid & 31, p = tid >> 5; const v4u qq = *(const LAS v4u*)(L + QS + t * P + p * 16); const unsigned ww[4] = {qq.x, qq.y, qq.z, qq.w}; float s = 0.f;
#pragma unroll
          for (int e = 0; e < 8; ++e) s += ((e & 1) ? bfhi(ww[e >> 1]) : bflo(ww[e >> 1])) * fa[NP + 8 * p + e];
          fa[QNP + p * 64 + t] = s; }
        LBAR();
        const int tr4 = w & 1, hf = w >> 1;
        f32x4 hv[2];
        { f32x4 ai_[2], as_[2];
#pragma unroll
          for (int j = 0; j < 2; ++j) { ai_[j] = (f32x4){0.f, 0.f, 0.f, 0.f}; as_[j] = (f32x4){0.f, 0.f, 0.f, 0.f}; }
#pragma unroll
          for (int ks = 0; ks < 2; ++ks) { const bf16x8 qa = *(const LAS bf16x8*)(L + QS + (16 * tr4 + fr) * P + ks * 64 + fq * 16); const bf16x8 sa = *(const LAS bf16x8*)(L + SS + (16 * tr4 + fr) * P + ks * 64 + fq * 16);
#pragma unroll
            for (int j = 0; j < 2; ++j) { const bf16x8 cb = tr_frag(L + CT, PO, ks * 32 + 8 * fq, 16 * (hf * 2 + j), fr); const bf16x8 vb = tr_frag(L + VT, PO, ks * 32 + 8 * fq, 16 * (hf * 2 + j), fr);
                ai_[j] = __builtin_amdgcn_mfma_f32_16x16x32_bf16(qa, cb, ai_[j], 0, 0, 0); as_[j] = __builtin_amdgcn_mfma_f32_16x16x32_bf16(sa, vb, as_[j], 0, 0, 0); } }
          float s1[4], s2[4];
#pragma unroll
          for (int r = 0; r < 4; ++r) { const int tl = 16 * tr4 + 4 * fq + r, t = T0 + tl; float qn = 0.f;
#pragma unroll
            for (int p = 0; p < 8; ++p) qn += fa[QNP + p * 64 + tl];
            const float wi = fa[WI + t]; const float den = wi * qn + ((fa[RS + tl] + fa[RS + 64 + tl]) + (fa[RS + 128 + tl] + fa[RS + 192 + tl]));
            const float inv = 1.0f / fmaxf(fabsf(den), fa[EI + t]); float a1 = 0.f, a2 = 0.f;
#pragma unroll
            for (int j = 0; j < 2; ++j) { const float x = (wi * ai_[j][r] + as_[j][r]) * inv; hv[j][r] = x; a1 += x; a2 += x * x; }
            s1[r] = a1; s2[r] = a2; }
#pragma unroll
          for (int r = 0; r < 4; ++r) { float x = s1[r], y = s2[r];
            s1[r] = row16_sum(x); s2[r] = row16_sum(y); }
          if (fr == 0) {
#pragma unroll
            for (int r = 0; r < 4; ++r) { fa[HSUM + hf * 32 + 16 * tr4 + 4 * fq + r] = s1[r]; fa[HSQ + hf * 32 + 16 * tr4 + 4 * fq + r] = s2[r]; } } }
        LBAR();
#pragma unroll
        for (int r = 0; r < 4; ++r) { const int tl = 16 * tr4 + 4 * fq + r; const float mean = ((fa[HSUM + tl] + fa[HSUM + 32 + tl]) + (fa[HSUM + 64 + tl] + fa[HSUM + 96 + tl])) * (1.0f / 128.0f);
            const float var = fmaxf(((fa[HSQ + tl] + fa[HSQ + 32 + tl]) + (fa[HSQ + 64 + tl] + fa[HSQ + 96 + tl])) * (1.0f / 128.0f) - mean * mean, 0.f);
            const float rstd = 1.0f / sqrtf(var + HEAD_EPS);
#pragma unroll
            for (int j = 0; j < 2; ++j) { const int dv = 16 * (hf * 2 + j) + fr; const float og = bf1(*(const LAS unsigned short*)(L + OS + tl * PO + dv * 2));
                *(LAS unsigned short*)(L + HS + tl * PO + dv * 2) = (unsigned short)f2bf((hv[j][r] - mean) * rstd * gain[j] * sigmoidf_(og)); } }
        const float decay = fa[SCAL];
#pragma unroll
        for (int j = 0; j < 4; ++j) accC[j] = accC[j] * decay;
#pragma unroll
        for (int ks = 0; ks < 2; ++ks) { const bf16x8 va = tr_frag(L + VT, PO, ks * 32 + 8 * fq, 16 * w, fr);
#pragma unroll
            for (int j = 0; j < 4; ++j) { const bf16x8 kb = tr_frag(L + KW, P, ks * 32 + 8 * fq, 16 * j, fr);
                accC[j] = __builtin_amdgcn_mfma_f32_16x16x32_bf16(va, kb, accC[j], 0, 0, 0); } }
        { const int dk = tid & 63; float s = 0.f;
#pragma unroll
          for (int e = 0; e < 8; ++e) s += fa[WL + 8 * w + e] * bf1(*(const LAS unsigned short*)(L + KS + (8 * w + e) * P + dk * 2));
          fa[QNP + w * 64 + dk] = s; }
        LBAR();
        float nnew = 0.f;
        if (tid < 64) { float s = 0.f;
#pragma unroll
            for (int p = 0; p < 8; ++p) s += fa[QNP + p * 64 + tid];
            nnew = decay * fa[NP + tid] + s; }
#pragma unroll
        for (int j = 0; j < 4; ++j) { v2u cw; cw.x = cvt_pk_bf16(accC[j][0], accC[j][1]); cw.y = cvt_pk_bf16(accC[j][2], accC[j][3]);
            *(LAS v2u*)(L + CT + (16 * j + fr) * PO + (16 * w + 4 * fq) * 2) = cw; }
        if (tid < 64) fa[NP + tid] = nnew;
        { const v4u hh = *(const LAS v4u*)(L + HS + vrow0 * PO + vpc * 16);
          *(GAS v4u*)(HCAT + ((size_t)(b * SEQ) + (size_t)(cc) * 64 + T0 + vrow0) * D + h * 128 + vpc * 8) = hh; }
        if (cc + 1 < 32) MLSTM_SCALARS(RSN);
    };
#pragma nounroll
    for (int c = 0; c < 32; c += 2) { chunk(sA, sB, c); chunk(sB, sA, c + 1); }
#undef MLSTM_LOAD
#undef MLSTM_SCALARS
    __syncthreads();
}
__device__ __forceinline__ void sconv_units(Frame& F, const Args& A, int first, int stride) {
    const bf16* Z = (const bf16*)(F.ws + WS_Z); bf16* HCAT = (bf16*)(F.ws + WS_HCAT);
    const int c0 = F.lane * 8;
    float w0[8], w1[8], w2[8];
#pragma unroll
    for (int e = 0; e < 8; ++e) { w0[e] = A.in[4][c0 + e]; w1[e] = A.in[4][512 + c0 + e]; w2[e] = A.in[4][1024 + c0 + e]; }
    for (int wu = first; wu < T / 32; wu += stride) {
        const int t0 = wu * 32; float p2[8], p1[8];
#pragma unroll
        for (int e = 0; e < 8; ++e) { p2[e] = 0.f; p1[e] = 0.f; }
        if ((t0 & (SEQ - 1)) != 0) {
#pragma unroll
            for (int back = 2; back >= 1; --back) { const v4u a = *(const GAS v4u*)(Z + (size_t)(t0 - back) * NZ + ZSC + c0), x = *(const GAS v4u*)(Z + (size_t)(t0 - back) * NZ + ZSX + c0);
                const unsigned aw[4] = {a.x, a.y, a.z, a.w}, xw[4] = {x.x, x.y, x.z, x.w};
#pragma unroll
                for (int e = 0; e < 8; ++e) { const float pv = ((e & 1) ? bfhi(aw[e >> 1]) : bflo(aw[e >> 1])) * ((e & 1) ? bfhi(xw[e >> 1]) : bflo(xw[e >> 1])); if (back == 2) p2[e] = pv; else p1[e] = pv; } } }
#pragma nounroll
        for (int i0 = 0; i0 < 32; i0 += 4) {
            v4u bq[4], a[4], x[4];
#pragma unroll
            for (int i = 0; i < 4; ++i) { const size_t t = (size_t)(t0 + i0 + i); bq[i] = *(const GAS v4u*)(Z + t * NZ + ZSB + c0); a[i] = *(const GAS v4u*)(Z + t * NZ + ZSC + c0); x[i] = *(const GAS v4u*)(Z + t * NZ + ZSX + c0); }
#pragma unroll
            for (int i = 0; i < 4; ++i) { const size_t t = (size_t)(t0 + i0 + i);
                const unsigned bw[4] = {bq[i].x, bq[i].y, bq[i].z, bq[i].w}, aw[4] = {a[i].x, a[i].y, a[i].z, a[i].w}, xw[4] = {x[i].x, x[i].y, x[i].z, x[i].w}; float y[8];
#pragma unroll
                for (int e = 0; e < 8; ++e) { const float pv = ((e & 1) ? bfhi(aw[e >> 1]) : bflo(aw[e >> 1])) * ((e & 1) ? bfhi(xw[e >> 1]) : bflo(xw[e >> 1]));
                    y[e] = ((e & 1) ? bfhi(bw[e >> 1]) : bflo(bw[e >> 1])) * (w0[e] * p2[e] + w1[e] * p1[e] + w2[e] * pv); p2[e] = p1[e]; p1[e] = pv; }
                v4u o; o.x = cvt_pk_bf16(y[0], y[1]); o.y = cvt_pk_bf16(y[2], y[3]); o.z = cvt_pk_bf16(y[4], y[5]); o.w = cvt_pk_bf16(y[6], y[7]);
                *(GAS v4u*)(HCAT + t * D + 512 + c0) = o; } }
    }
}
__device__ __forceinline__ void p2_mixer_ab(Frame& F, const Args& A) {
    const int nm = F.G < 128 ? F.G : 128; const int bx = (int)blockIdx.x;
    if (F.own) {
        const int x = bx & 7, j = (bx & 127) >> 3;
        if (bx < 128) mlstm_item(F, A, ((((2 * x + (j >> 3)) * 4 + ((j >> 1) & 3)) << 1) | (j & 1)));
        else sconv_units(F, A, 128 * x + j * NWAVES + F.wave, T / 32);
    } else {
    if (bx < nm) { for (int item2 = bx; item2 < 128; item2 += nm) mlstm_item(F, A, item2); }
    if (F.G > nm) { if (bx >= nm) sconv_units(F, A, (bx - nm) * NWAVES + F.wave, (F.G - nm) * NWAVES); }
    else sconv_units(F, A, bx * NWAVES + F.wave, F.G * NWAVES);
    }
    convert_queue(F, A, 0, 0, NSMALL + XT_ALL - (F.own ? XT_DEFER : 0));
}

__device__ __forceinline__ void p_router(Frame& F, const Args& A, int layer) {
    LAS unsigned char* L = F.lds;
    constexpr int PW = 2064, WHO = 0, WLO = 32 * PW, CNTO = 64 * PW;
    static_assert(CNTO + 128 <= LDSCTL_OFF, "router LDS");
    LAS int* cnt = (LAS int*)(L + CNTO);
    const bf16* RWH = (const bf16*)(F.ws + WS_RWH) + (size_t)layer * 32 * 1024; const bf16* RWL = (const bf16*)(F.ws + WS_RWL) + (size_t)layer * 32 * 1024; const float* RGB = (const float*)(F.ws + WS_RGB) + layer * 64;
    __syncthreads();
    for (int i = 0; i < 8; ++i) { const int idx = F.tid + 512 * i, e = idx >> 7, pc = idx & 127;
        *(LAS v4u*)(L + WHO + e * PW + pc * 16) = *(const GAS v4u*)(RWH + e * 1024 + pc * 8); *(LAS v4u*)(L + WLO + e * PW + pc * 16) = *(const GAS v4u*)(RWL + e * 1024 + pc * 8); }
    const int lane = F.lane, n = lane & 15, q = lane >> 4;
    const bf16* R = (const bf16*)(F.ws + WS_R); int* TOPI = (int*)(F.ws + WS_TOPI); float* TOPG = (float*)(F.ws + WS_TOPG); int* CNTT = (int*)(F.ws + WS_CNTT); float* STATS = (float*)(F.ws + WS_STATS);
    for (int tile = F.vcu; tile < T / 128; tile += F.G) {
        const size_t t = (size_t)tile * 128 + F.wave * 16 + n;
        const bf16* rowp = R + t * D + 8 * q;
        v4u h0[8], h1[8];
#pragma unroll
        for (int s = 0; s < 8; ++s) { h0[s] = *(const GAS v4u*)(rowp + 32 * s); h1[s] = *(const GAS v4u*)(rowp + 32 * (8 + s)); }
        __syncthreads();
        if (F.tid < 32) cnt[F.tid] = 0;
        __syncthreads();
        f32x4 acc[2]; acc[0] = (f32x4){0.f, 0.f, 0.f, 0.f}; acc[1] = (f32x4){0.f, 0.f, 0.f, 0.f};
        float s1 = 0.f, s2 = 0.f;
#define RT_STEPS(HB_, s0_) do { _Pragma("unroll") for (int s_ = 0; s_ < 8; ++s_) { const int s = (s0_) + s_; const v4u h = HB_[s_]; \
            const float x0 = bflo(h.x), x1 = bfhi(h.x), x2 = bflo(h.y), x3 = bfhi(h.y), x4 = bflo(h.z), x5 = bfhi(h.z), x6 = bflo(h.w), x7 = bfhi(h.w); \
            s1 += ((x0 + x1) + (x2 + x3)) + ((x4 + x5) + (x6 + x7)); \
            s2 += ((x0 * x0 + x1 * x1) + (x2 * x2 + x3 * x3)) + ((x4 * x4 + x5 * x5) + (x6 * x6 + x7 * x7)); \
            const bf16x8 bh = __builtin_bit_cast(bf16x8, h); \
            _Pragma("unroll") for (int et = 0; et < 2; ++et) { const bf16x8 wh = *(const LAS bf16x8*)(L + WHO + (16 * et + n) * PW + s * 64 + q * 16), wl = *(const LAS bf16x8*)(L + WLO + (16 * et + n) * PW + s * 64 + q * 16); \
                acc[et] = __builtin_amdgcn_mfma_f32_16x16x32_bf16(wh, bh, acc[et], 0, 0, 0); acc[et] = __builtin_amdgcn_mfma_f32_16x16x32_bf16(wl, bh, acc[et], 0, 0, 0); } \
            } } while (0)
        RT_STEPS(h0, 0);
#pragma unroll
        for (int s = 0; s < 8; ++s) h0[s] = *(const GAS v4u*)(rowp + 32 * (16 + s));
        RT_STEPS(h1, 8);
#pragma unroll
        for (int s = 0; s < 8; ++s) h1[s] = *(const GAS v4u*)(rowp + 32 * (24 + s));
        RT_STEPS(h0, 16); RT_STEPS(h1, 24);
#undef RT_STEPS
        float Gv[8], Bv[8];
#pragma unroll
        for (int m = 0; m < 8; ++m) { const int e = 16 * (m >> 2) + 4 * q + (m & 3); Gv[m] = RGB[e]; Bv[m] = RGB[32 + e]; }
        s1 += __shfl_xor(s1, 16); s1 += __shfl_xor(s1, 32); s2 += __shfl_xor(s2, 16); s2 += __shfl_xor(s2, 32);
        const float mean = s1 * (1.0f / D), var = fmaxf(s2 * (1.0f / D) - mean * mean, 0.f), rstd = 1.0f / sqrtf(var + LN_EPS);
        float val[8];
#pragma unroll
        for (int m = 0; m < 8; ++m) val[m] = rstd * (acc[m >> 2][m & 3] - mean * Gv[m]) + Bv[m];
        float tv[4]; int ti[4];
#pragma unroll
        for (int k = 0; k < 4; ++k) { float bv = val[0]; int bi = 4 * q;
#pragma unroll
            for (int m = 1; m < 8; ++m) { const int e = 16 * (m >> 2) + 4 * q + (m & 3); if (val[m] > bv) { bv = val[m]; bi = e; } }
#pragma unroll
            for (int o = 16; o < 64; o <<= 1) { const float ov = __shfl_xor(bv, o); const int oi = __shfl_xor(bi, o); const bool take = (ov > bv) || (ov == bv && oi < bi); bv = take ? ov : bv; bi = take ? oi : bi; }
            tv[k] = bv; ti[k] = bi;
#pragma unroll
            for (int m = 0; m < 8; ++m) { const int e = 16 * (m >> 2) + 4 * q + (m & 3); if (e == bi) val[m] = -INFINITY; } }
        const float e1 = __expf(tv[1] - tv[0]), e2 = __expf(tv[2] - tv[0]), e3 = __expf(tv[3] - tv[0]); const float inv = 1.0f / (1.0f + e1 + e2 + e3);
        if (q == 0) { *(GAS i32x4*)(TOPI + t * 4) = (i32x4){ti[0], ti[1], ti[2], ti[3]}; *(GAS f32x4*)(TOPG + t * 4) = (f32x4){inv, e1 * inv, e2 * inv, e3 * inv}; *(GAS f32x2*)(STATS + t * 2) = (f32x2){mean, rstd};
            __hip_atomic_fetch_add(&cnt[ti[0]], 1, __ATOMIC_RELAXED, __HIP_MEMORY_SCOPE_WORKGROUP); __hip_atomic_fetch_add(&cnt[ti[1]], 1, __ATOMIC_RELAXED, __HIP_MEMORY_SCOPE_WORKGROUP);
            __hip_atomic_fetch_add(&cnt[ti[2]], 1, __ATOMIC_RELAXED, __HIP_MEMORY_SCOPE_WORKGROUP); __hip_atomic_fetch_add(&cnt[ti[3]], 1, __ATOMIC_RELAXED, __HIP_MEMORY_SCOPE_WORKGROUP); }
        __syncthreads();
        if (F.tid < 32) CNTT[tile * 32 + F.tid] = cnt[F.tid];
    }
    __syncthreads();
}

__device__ __forceinline__ void p_slots(Frame& F, const Args& A, int layer) {
    LAS int* li = (LAS int*)F.lds;
    LAS int* redA = li;
    LAS int* redP = li + 512;
    LAS int* tot = li + 1024;
    LAS int* pre = li + 1056;
    LAS int* base = li + 1088;
    LAS int* wcn = li + 1152;
    const int* CNTT = (const int*)(F.ws + WS_CNTT); const int* TOPI = (const int*)(F.ws + WS_TOPI); int* SLOT = (int*)(F.ws + WS_SLOT); int* META = (int*)(F.ws + WS_META);
    const bf16* R = (const bf16*)(F.ws + WS_R); const float* STATS = (const float*)(F.ws + WS_STATS); unsigned char* X1B = (unsigned char*)(F.ws + WS_X1B); int* ROWTOK = (int*)(F.ws + WS_ROWTOK);
    const float* lg = A.in[19] + (size_t)(layer * 2) * D; const float* lb = A.in[20] + (size_t)(layer * 2) * D;
    f32x4 g4[4], b4[4];
#pragma unroll
    for (int j = 0; j < 4; ++j) { g4[j] = *(const GAS f32x4*)(lg + 4 * F.lane + 256 * j); b4[j] = *(const GAS f32x4*)(lb + 4 * F.lane + 256 * j); }
    const int tid = F.tid, lane = F.lane, e_ = tid & 31, part = tid >> 5;
    int cv[16];
#pragma unroll
    for (int k = 0; k < 16; ++k) cv[k] = CNTT[(part + 16 * k) * 32 + e_];
    { int sa = 0;
#pragma unroll
      for (int k = 0; k < 16; ++k) sa += cv[k];
      redA[part * 32 + e_] = sa; }
    __syncthreads();
    if (tid < 32) { int s = 0; for (int p = 0; p < 16; ++p) s += redA[p * 32 + tid]; tot[tid] = s; }
    __syncthreads();
    if (tid == 0) { int bsum = 0; for (int e = 0; e < 32; ++e) { base[e] = bsum; bsum += (tot[e] + 255) & ~255; } base[32] = bsum; }
    __syncthreads();
    for (int tile = F.vcu; tile < T / 128; tile += F.G) {
        v2u rw[16][4];
#pragma unroll
        for (int i = 0; i < 16; ++i) { const GAS v2u* rr = (const GAS v2u*)(R + ((size_t)tile * 128 + F.wave * 16 + i) * D) + lane;
#pragma unroll
            for (int j = 0; j < 4; ++j) rw[i][j] = rr[64 * j]; }
        const float mean_l = STATS[((size_t)tile * 128 + F.wave * 16 + (lane & 15)) * 2], rstd_l = STATS[((size_t)tile * 128 + F.wave * 16 + (lane & 15)) * 2 + 1];
        { int sp = 0;
#pragma unroll
          for (int k = 0; k < 16; ++k) sp += (part + 16 * k < tile) ? cv[k] : 0;
          redP[part * 32 + e_] = sp; }
        __syncthreads();
        if (tid < 32) { int s = 0; for (int p = 0; p < 16; ++p) s += redP[p * 32 + tid]; pre[tid] = s; }
        const int tok = tile * 128 + (tid >> 2); const int e = TOPI[(size_t)tile * 512 + tid];
        int rank = 0;
        for (int ee = 0; ee < 32; ++ee) { const unsigned long long mask = __ballot(e == ee); if (e == ee) rank = __builtin_amdgcn_mbcnt_hi((unsigned)(mask >> 32), __builtin_amdgcn_mbcnt_lo((unsigned)mask, 0u)); if (lane == 0) wcn[F.wave * 32 + ee] = __popcll(mask); }
        __syncthreads();
        for (int ww = 0; ww < F.wave; ++ww) rank += wcn[ww * 32 + e];
        const int slot = base[e] + pre[e] + rank;
        SLOT[(size_t)tile * 512 + tid] = slot; ROWTOK[slot] = tok;
#pragma unroll
        for (int i = 0; i < 16; ++i) { const size_t tk = (size_t)tile * 128 + F.wave * 16 + i;
            const float mean = __builtin_bit_cast(float, __builtin_amdgcn_readlane(__builtin_bit_cast(int, mean_l), i)), rstd = __builtin_bit_cast(float, __builtin_amdgcn_readlane(__builtin_bit_cast(int, rstd_l), i));
            GAS unsigned* dst = (GAS unsigned*)(X1B + tk * D) + lane;
#pragma unroll
            for (int j = 0; j < 4; ++j) { const v2u r2 = rw[i][j]; const f32x4 y = ((f32x4){bflo(r2.x), bfhi(r2.x), bflo(r2.y), bfhi(r2.y)} - mean) * rstd * g4[j] + b4[j]; dst[64 * j] = pk4_fp8(y[0], y[1], y[2], y[3]); } }
        __syncthreads();
    }
    for (int e = F.vcu; e < 32; e += F.G) { const int r0 = base[e] + tot[e], r1 = base[e + 1]; for (int i = r0 + tid; i < r1; i += 512) ROWTOK[i] = 0; }
    if (F.vcu == 0) { const int nMt = base[32] >> 8; if (tid == 0) META[0] = nMt;
        for (int gm = tid; gm < nMt; gm += 512) { int e = 0; for (int q = 0; q < 32; ++q) if (base[q] <= gm * 256 && gm * 256 < base[q + 1]) e = q; META[16 + gm] = e; } }
    __syncthreads();
}
__device__ __forceinline__ int load_texp(Frame& F) {
    const int* META = (const int*)(F.ws + WS_META); LAS int* texp = (LAS int*)(F.lds + TEXP_OFF);
    const int nMt = __builtin_amdgcn_readfirstlane(*(const GAS int*)META);
    for (int i = F.tid; i < 1024; i += 512) texp[i] = (i < nMt) ? *(const GAS int*)(META + 16 + i) : 0;
    __syncthreads();
    return nMt;
}
template <class Sched> __device__ __forceinline__ void load_rowtab(Frame& F, const Sched& S) {
    const int* ROWTOK = (const int*)(F.ws + WS_ROWTOK); LAS unsigned short* tab = (LAS unsigned short*)(F.lds + ROWTAB_OFF);
    const int half = F.tid >> 8, r = F.tid & 255; int val[10];
#pragma unroll
    for (int j = 0; j < 10; ++j) { pg8::Unit u; const bool ok = S.next(2 * j + half, u); val[j] = ok ? *(const GAS int*)(ROWTOK + u.pm * 256 + r) : 0; }
#pragma unroll
    for (int j = 0; j < 10; ++j) tab[(2 * j + half) * 256 + r] = (unsigned short)val[j];
    __syncthreads();
}

__device__ __forceinline__ void p_combine(Frame& F, const Args& A, int layer) {
    const bf16* R = (const bf16*)(F.ws + WS_R); const float* STATS = (const float*)(F.ws + WS_STATS); const unsigned char* YS = (const unsigned char*)(F.ws + WS_YS); const int* SLOT = (const int*)(F.ws + WS_SLOT); const float* TOPG = (const float*)(F.ws + WS_TOPG);
    bf16* OB = (bf16*)(F.ws + WS_ABF);
    const float* lg = A.in[19] + (size_t)(layer * 2 + 1) * D; const float* lb = A.in[20] + (size_t)(layer * 2 + 1) * D;
    const float* lg0 = A.in[19] + (size_t)(layer * 2) * D; const float* lb0 = A.in[20] + (size_t)(layer * 2) * D;
    const int lane = F.lane; f32x4 g4[4], b4[4], g0[4], b0[4];
#pragma unroll
    for (int j = 0; j < 4; ++j) { g4[j] = *(const GAS f32x4*)(lg + 4 * lane + 256 * j); b4[j] = *(const GAS f32x4*)(lb + 4 * lane + 256 * j); g0[j] = *(const GAS f32x4*)(lg0 + 4 * lane + 256 * j) * ALPHA; b0[j] = *(const GAS f32x4*)(lb0 + 4 * lane + 256 * j) * ALPHA; }
    const int gw = F.vcu * NWAVES + F.wave, NGW = F.G * NWAVES;
    struct CMeta { i32x4 sl; f32x4 gt; f32x2 st; };
    struct CData { unsigned yw[4][4]; v2u xr[4]; f32x4 gt; f32x2 st; };
#define CMB_META(M_, t_) do { M_.st = *(const GAS f32x2*)(STATS + (size_t)(t_) * 2); M_.sl = *(const GAS i32x4*)(SLOT + (size_t)(t_) * 4); M_.gt = *(const GAS f32x4*)(TOPG + (size_t)(t_) * 4); } while (0)
#define CMB_DATA(D_, M_, t_) do { const int sls_[4] = {M_.sl[0], M_.sl[1], M_.sl[2], M_.sl[3]}; D_.gt = M_.gt * (1.0f / 16.0f); D_.st = M_.st;     \
        _Pragma("unroll") for (int k = 0; k < 4; ++k) { const GAS unsigned* yr = (const GAS unsigned*)(YS + (size_t)sls_[k] * D) + lane; _Pragma("unroll") for (int j = 0; j < 4; ++j) D_.yw[k][j] = yr[64 * j]; } \
        { const GAS v2u* xr_ = (const GAS v2u*)(R + (size_t)(t_) * D) + lane; _Pragma("unroll") for (int j = 0; j < 4; ++j) D_.xr[j] = xr_[64 * j]; } } while (0)
#define CMB_COMPUTE(D_, t_) do { f32x4 v[4]; \
        _Pragma("unroll") for (int j = 0; j < 4; ++j) { const v2u rw = D_.xr[j]; v[j] = ((f32x4){bflo(rw.x), bfhi(rw.x), bflo(rw.y), bfhi(rw.y)} - D_.st[0]) * D_.st[1] * g0[j] + b0[j]; } \
        _Pragma("unroll") for (int k = 0; k < 4; ++k) { const float gk = D_.gt[k]; \
            _Pragma("unroll") for (int j = 0; j < 4; ++j) { const f32x2 lo = __builtin_amdgcn_cvt_pk_f32_fp8((int)D_.yw[k][j], false), hi = __builtin_amdgcn_cvt_pk_f32_fp8((int)D_.yw[k][j], true); \
                v[j][0] += gk * lo[0]; v[j][1] += gk * lo[1]; v[j][2] += gk * hi[0]; v[j][3] += gk * hi[1]; } } \
        float s = 0.f; \
        _Pragma("unroll") for (int j = 0; j < 4; ++j) s += (v[j][0] + v[j][1]) + (v[j][2] + v[j][3]); \
        const float mean = wave_sum(s) * (1.0f / D); float s2 = 0.f; \
        _Pragma("unroll") for (int j = 0; j < 4; ++j) { v[j] = v[j] - mean; s2 += (v[j][0] * v[j][0] + v[j][1] * v[j][1]) + (v[j][2] * v[j][2] + v[j][3] * v[j][3]); } \
        const float rstd = 1.0f / sqrtf(wave_sum(s2) * (1.0f / D) + LN_EPS); \
        if (layer == 0) { GAS v2u* xb = (GAS v2u*)(OB + (size_t)(t_) * D) + lane; \
            _Pragma("unroll") for (int j = 0; j < 4; ++j) { v[j] = v[j] * rstd * g4[j] + b4[j]; v2u wv; wv.x = cvt_pk_bf16(v[j][0], v[j][1]); wv.y = cvt_pk_bf16(v[j][2], v[j][3]); xb[64 * j] = wv; } } \
        else { GAS f32x4* xo = (GAS f32x4*)(A.out + (size_t)(t_) * D) + lane; \
            _Pragma("unroll") for (int j = 0; j < 4; ++j) { v[j] = v[j] * rstd * g4[j] + b4[j]; xo[64 * j] = v[j]; } } } while (0)
    const int tb = F.own ? 128 * F.vcu + 16 * F.wave : gw, ts = F.own ? 1 : NGW, tn = F.own ? 16 : (gw < T ? (T - 1 - gw) / NGW + 1 : 0);
    if (tn > 0) {
        CMeta m; CData dA, dB;
        CMB_META(m, tb); CMB_DATA(dA, m, tb);
        if (1 < tn) CMB_META(m, tb + ts);
        for (int i = 0; i < tn; i += 2) {
            const int t = tb + ts * i, t1 = t + ts, t2 = t + 2 * ts, t3 = t + 3 * ts;
            if (i + 1 < tn) { CMB_DATA(dB, m, t1); if (i + 2 < tn) CMB_META(m, t2); }
            CMB_COMPUTE(dA, t);
            if (i + 1 < tn) {
                if (i + 2 < tn) { CMB_DATA(dA, m, t2); if (i + 3 < tn) CMB_META(m, t3); }
                CMB_COMPUTE(dB, t1); }
        }
    }
#undef CMB_META
#undef CMB_DATA
#undef CMB_COMPUTE
}

__device__ __forceinline__ void p_conv31(Frame& F, const Args& A) {
    const bf16* U = (const bf16*)(F.ws + WS_U); bf16* V = (bf16*)(F.ws + WS_V);
    LAS unsigned char* L = F.lds;
    constexpr int RED = 62 * 2048, STAT = RED + 8 * 32 * 4;
    static_assert(STAT + 128 <= RING_BYTES, "conv31 LDS");
    LAS float* red = (LAS float*)(L + RED); LAS float* stat = (LAS float*)(L + STAT);
    const int tid = F.tid, lane = F.lane, ch = 2 * tid;
    f32x2 wt[31];
#pragma unroll
    for (int j = 0; j < 31; ++j) wt[j] = *(const GAS f32x2*)(A.in[8] + j * 1024 + ch);
    const f32x2 bdw = *(const GAS f32x2*)(A.in[9] + ch), lg = *(const GAS f32x2*)(A.in[10] + ch), lb = *(const GAS f32x2*)(A.in[11] + ch);
    v4u pre[16];
#define CONV_LOAD(unit_) do { const int bq_ = (unit_) >> 6, tk0_ = ((unit_) & 63) * 32; _Pragma("unroll") for (int i = 0; i < 16; ++i) { const int idx = tid + 512 * i, r = idx >> 7, pc = idx & 127, tok = tk0_ - 30 + r; \
        pre[i] = (v4u){0u, 0u, 0u, 0u}; if (idx < 62 * 128 && tok >= 0) pre[i] = *(const GAS v4u*)(U + ((size_t)bq_ * SEQ + tok) * D + pc * 8); } } while (0)
    const int u0 = F.own ? 4 * F.vcu : F.vcu, ustep = F.own ? 1 : F.G, uend = F.own ? 4 * F.vcu + 4 : T / 32;
    if (u0 < uend) CONV_LOAD(u0);
    for (int unit = u0; unit < uend; unit += ustep) {
        const int bq = unit >> 6, tok0 = (unit & 63) * 32; const size_t row0 = (size_t)bq * SEQ + tok0;
        __syncthreads();
#pragma unroll
        for (int i = 0; i < 16; ++i) { const int idx = tid + 512 * i; if (idx < 62 * 128) *(LAS v4u*)(L + (idx >> 7) * 2048 + (idx & 127) * 16) = pre[i]; }
        __syncthreads();
        if (unit + ustep < uend) CONV_LOAD(unit + ustep);
#pragma nounroll
        for (int half = 0; half < 2; ++half) {
            const LAS unsigned char* Lh = L + half * 16 * 2048 + tid * 4;
            f32x2 acc[16];
#pragma unroll
            for (int t = 0; t < 16; ++t) acc[t] = bdw;
#pragma unroll
            for (int r = 0; r < 46; ++r) { const unsigned uw = *(const LAS unsigned*)(Lh + r * 2048); const f32x2 uu = (f32x2){bflo(uw), bfhi(uw)};
#pragma unroll
                for (int t = 0; t < 16; ++t) { if (r - t >= 0 && r - t <= 30) acc[t] = acc[t] + wt[r - t] * uu; } }
            float v[32];
#pragma unroll
            for (int t = 0; t < 16; ++t) { v[t] = acc[t][0] + acc[t][1]; v[16 + t] = acc[t][0] * acc[t][0] + acc[t][1] * acc[t][1]; }
#pragma unroll
            for (int e = 0; e < 16; ++e) { const bool hi = (lane & 32) != 0; const float send = hi ? v[e] : v[16 + e], keep = hi ? v[16 + e] : v[e]; v[e] = keep + __shfl_xor(send, 32); }
#pragma unroll
            for (int e = 0; e < 8; ++e) { const bool hi = (lane & 16) != 0; const float send = hi ? v[e] : v[8 + e], keep = hi ? v[8 + e] : v[e]; v[e] = keep + __shfl_xor(send, 16); }
#pragma unroll
            for (int e = 0; e < 4; ++e) { const bool hi = (lane & 8) != 0; const float send = hi ? v[e] : v[4 + e], keep = hi ? v[4 + e] : v[e]; v[e] = keep + __shfl_xor(send, 8); }
#pragma unroll
            for (int e = 0; e < 2; ++e) { const bool hi = (lane & 4) != 0; const float send = hi ? v[e] : v[2 + e], keep = hi ? v[2 + e] : v[e]; v[e] = keep + __shfl_xor(send, 4); }
            { const bool hi = (lane & 2) != 0; const float send = hi ? v[0] : v[1], keep = hi ? v[1] : v[0]; v[0] = keep + __shfl_xor(send, 2); }
            v[0] += __shfl_xor(v[0], 1);
            if ((lane & 1) == 0) red[F.wave * 32 + (lane >> 1)] = v[0];
            LBAR();
            if (tid < 32) { float s = 0.f;
#pragma unroll
                for (int ww = 0; ww < 8; ++ww) s += red[ww * 32 + tid];
                const float other = __shfl_xor(s, 16);
                if (tid < 16) { const float mean = s * (1.0f / D); const float var = fmaxf(other * (1.0f / D) - mean * mean, 0.f); stat[tid] = mean; stat[16 + tid] = 1.0f / sqrtf(var + LN_EPS); } }
            LBAR();
#pragma unroll
            for (int t = 0; t < 16; ++t) { const float mean = stat[t], rstd = stat[16 + t]; const float y0 = (acc[t][0] - mean) * rstd * lg[0] + lb[0], y1 = (acc[t][1] - mean) * rstd * lg[1] + lb[1];
                *(GAS unsigned*)(V + (row0 + half * 16 + t) * D + ch) = cvt_pk_bf16(y0 * sigmoidf_(y0), y1 * sigmoidf_(y1)); }
        }
    }
    __syncthreads();
#undef CONV_LOAD
}

#define RUN_GEMM(EpiT, SchedT, S, E) pg8::gemm_phase<EpiT, SchedT, true>(F.lds, S, E)
#ifndef MK_KIND_MASK
#define MK_KIND_MASK 0x7ff
#endif
#define ON(kind) (((MK_KIND_MASK) >> (kind)) & 1)
#ifndef MK_DUP_MASK
#define MK_DUP_MASK 0
#endif
#define DUP(kind) (((MK_DUP_MASK) >> (kind)) & 1)
#define IN(k) (lo <= (k) && (k) < hi)
#define SEAM(k) do { if (IN(k) && IN((k) + 1)) xcd_barrier(bar); } while (0)
#define SEAM_L(k) do { if (IN(k) && IN((k) + 1)) { if (F.own) xcd_local_barrier(bar, (unsigned*)(F.ws + WS_CTL) + CW_LBAR); else xcd_barrier(bar); } } while (0)

template <int LAYER>
__device__ __forceinline__ void run_layer(Frame& F, const Args& args, const XcdBarrier& bar, int lo, int hi) {
    constexpr int pb = 1 + 8 * LAYER;
    const int c_id = (int)blockIdx.x;
    asm volatile("" : "+v"(F.tid));
    LAS int* texp = (LAS int*)(F.lds + TEXP_OFF);
    if constexpr (LAYER == 0) {
        if (ON(1) && IN(1)) { pg8::Order<false> S; S.init(T / 256, NZ / 256, F.G, c_id); S.A = (const char*)(F.ws + WS_ABF); S.Bt = (const char*)(F.ws + WS_WIN); S.bexp = 0; S.texp = nullptr;
            pg8::EpiZ E{(bf16*)(F.ws + WS_Z), NZ}; RUN_GEMM(pg8::EpiZ, pg8::Order<false>, S, E); } SEAM_L(1);
        if (ON(2) && IN(2)) { { p2_mixer_ab(F, args); } if (DUP(2)) { p2_mixer_ab(F, args); } } SEAM_L(2);
    } else {
        if (ON(3) && IN(9)) { pg8::Order<false> S; S.init(T / 256, 2048 / 256, F.G, c_id); S.A = (const char*)(F.ws + WS_ABF); S.Bt = (const char*)(F.ws + WS_PW1); S.bexp = 0; S.texp = nullptr;
            pg8::EpiGlu E{(bf16*)(F.ws + WS_U)}; RUN_GEMM(pg8::EpiGlu, pg8::Order<false>, S, E); if (DUP(3)) { RUN_GEMM(pg8::EpiGlu, pg8::Order<false>, S, E); } } SEAM_L(9);
        if (ON(4) && IN(10)) { { p_conv31(F, args); } if (DUP(4)) { p_conv31(F, args); } } SEAM_L(10);
    }
    if (ON(5) && IN(pb + 2)) { pg8::Order<false> S; S.init(T / 256, D / 256, F.G, c_id); S.A = (const char*)(F.ws + (LAYER == 0 ? WS_HCAT : WS_V)); S.Bt = (const char*)(F.ws + (LAYER == 0 ? WS_WOUT : WS_PW2)); S.bexp = 0; S.texp = nullptr;
        pg8::EpiRes<true> E{(const void*)(F.ws + WS_ABF), (bf16*)(F.ws + WS_R), ALPHA};
        RUN_GEMM(pg8::EpiRes<true>, pg8::Order<false>, S, E); if (DUP(5)) { RUN_GEMM(pg8::EpiRes<true>, pg8::Order<false>, S, E); } } SEAM_L(pb + 2);
    if (ON(6) && IN(pb + 3)) { { p_router(F, args, LAYER); } if (DUP(6)) { p_router(F, args, LAYER); } } SEAM(pb + 3);
    if (ON(7) && IN(pb + 4)) { { p_slots(F, args, LAYER); } if (DUP(7)) { p_slots(F, args, LAYER); } } SEAM(pb + 4);
    asm volatile("" : "+v"(F.tid));
    if (ON(8) && IN(pb + 5)) { const int nMt = load_texp(F); const float* WSC = (const float*)(F.ws + WS_WSC); unsigned* ctl = (unsigned*)(F.ws + WS_CTL);
        const int GD = (LAYER == 0 && F.own && XT_DEFER > 0) ? F.G / 8 : 0, G1 = F.G - GD;
        const pg8::Hand H{ctl + CW_UPCNT + LAYER * UPCNT_LAYER, ctl + CW_UPTOT + LAYER * 64, (unsigned)F.G};
        if (c_id < G1) {
        pg8::Order<true> S; S.init(nMt, 8, G1, c_id); S.tstep = (size_t)256 * 1024; S.A = (const char*)(F.ws + WS_X1B); S.Bt = (const char*)(F.ws + WS_UP) + (size_t)LAYER * 32 * 2048 * 1024; S.bexp = (size_t)2048 * 1024; S.texp = texp;
        load_rowtab(F, S);
        pg8::EpiSwiglu8 E{(unsigned char*)(F.ws + WS_ACT), args.in[16] + (size_t)LAYER * 32 * 2048, texp, 1.0f / WSC[LAYER * 2]};
        pg8::gemm_phase<pg8::EpiSwiglu8, pg8::Order<true>, true, true, true, 1>(F.lds, S, E, (const LAS unsigned short*)(F.lds + ROWTAB_OFF), H);
        __syncthreads(); if (F.tid == 0) __hip_atomic_fetch_add(H.tot, 1u, __ATOMIC_RELAXED, __HIP_MEMORY_SCOPE_AGENT); }
        else { if (F.tid == 0) __hip_atomic_fetch_add(H.tot, 1u, __ATOMIC_RELAXED, __HIP_MEMORY_SCOPE_AGENT);
            convert_queue(F, args, 1, NSMALL + XT_ALL - XT_DEFER, NSMALL + XT_ALL); __syncthreads(); } }
    if (ON(9) && IN(pb + 6)) { const int nMt = load_texp(F); const float* WSC = (const float*)(F.ws + WS_WSC); unsigned* ctl = (unsigned*)(F.ws + WS_CTL);
        pg8::Order<true> S; S.init(nMt, 4, F.G, c_id); S.tstep = (size_t)256 * 1024; S.A = (const char*)(F.ws + WS_ACT); S.Bt = (const char*)(F.ws + WS_DN) + (size_t)LAYER * 32 * 1024 * 1024; S.bexp = (size_t)1024 * 1024; S.texp = texp;
        pg8::EpiBiasG8 E{(unsigned char*)(F.ws + WS_YS), args.in[18] + (size_t)LAYER * 32 * 1024, texp, 0.25f / WSC[LAYER * 2 + 1]};
        const pg8::Hand H{ctl + CW_UPCNT + LAYER * UPCNT_LAYER, ctl + CW_UPTOT + LAYER * 64, (unsigned)F.G};
        pg8::gemm_phase<pg8::EpiBiasG8, pg8::Order<true>, true, true, false, 2>(F.lds, S, E, nullptr, H); } SEAM(pb + 6);
    if (ON(10) && IN(pb + 7)) { { p_combine(F, args, LAYER); } if (DUP(10)) { p_combine(F, args, LAYER); } } if constexpr (LAYER == 0) SEAM_L(pb + 7);
}

__global__ void __launch_bounds__(NWAVES * 64, 2) mk_fwd(Args args) {
    extern __shared__ __attribute__((aligned(16))) unsigned char lds[];
    Frame F;
    F.lds = (LAS unsigned char*)lds;
    F.tid = threadIdx.x; F.lane = (int)__builtin_amdgcn_mbcnt_hi(~0u, __builtin_amdgcn_mbcnt_lo(~0u, 0u));
    F.wave = __builtin_amdgcn_readfirstlane(F.tid >> 6);
    F.G = gridDim.x; { const int bx = blockIdx.x; F.vcu = (F.G % 8 == 0) ? (bx % 8) * (F.G / 8) + bx / 8 : bx; }
    F.ws = args.ws;
    for (int u = F.tid; u < (LDS_BYTES - LDSCTL_OFF) / 4; u += NWAVES * 64) ((LAS unsigned*)(F.lds + LDSCTL_OFF))[u] = 0u;
    __syncthreads();
    unsigned* ctl = (unsigned*)(F.ws + WS_CTL);
    XcdBarrier bar; bar.bar = ctl + CW_BAR; bar.x = 0; bar.st = nullptr;
#if !MK_PER_PHASE
    bar = xcd_barrier_post(ctl + CW_BAR, (volatile LAS unsigned*)(F.lds + MISC_OFF) + 8);
#endif
    const int lo = args.ph_lo, hi = args.ph_hi;
    F.own = false;
    if (F.tid == 0) atomicOr(&ctl[CW_MAPX + 64 * bar.x], 1u << (blockIdx.x & 7));
    if (ON(0) && IN(0)) { p0_prologue(F, args); if (DUP(0)) { p0_prologue(F, args); } } SEAM(0);
    if (IN(0) && IN(1)) { bool ok = (F.G == 256) && (bar.st[0] == 32u) && (bar.st[1] == 8u); unsigned seen = 0u;
#pragma unroll
        for (int j = 0; j < 16; ++j) { const unsigned m = xb_ld(&ctl[CW_MAPX + 64 * j]); if (m != 0u) { ok = ok && (__popc(m) == 1) && ((seen & m) == 0u) && (j < 8 ? true : true); seen |= m; } }
        F.own = ok && (seen == 0xffu); }
    run_layer<0>(F, args, bar, lo, hi);
    run_layer<1>(F, args, bar, lo, hi);
}
#undef IN
#undef SEAM

extern "C" void kernel_launch(void* const* d_in, const int* in_sizes, int n_in, void* d_out, int out_size, void* d_ws, size_t ws_size, hipStream_t stream) {
    static int grid = 0;
    if (grid == 0) {
        if (n_in != 21 || in_sizes[0] != T * D || out_size != T * D || ws_size < WS_END) { fprintf(stderr, "kernel_launch: unexpected shapes (n_in %d, in0 %d, out %d, ws %zu); nothing launched\n", n_in, n_in > 0 ? in_sizes[0] : -1, out_size, ws_size); grid = -1; return; }
        int dev = 0, cus = 0, per_cu = 0;
        if (hipGetDevice(&dev) != hipSuccess || hipDeviceGetAttribute(&cus, hipDeviceAttributeMultiprocessorCount, dev) != hipSuccess) { grid = -1; return; }
        if (hipFuncSetAttribute((const void*)mk_fwd, hipFuncAttributeMaxDynamicSharedMemorySize, LDS_BYTES) != hipSuccess) { fprintf(stderr, "kernel_launch: hipFuncSetAttribute failed\n"); grid = -1; return; }
        if (hipOccupancyMaxActiveBlocksPerMultiprocessor(&per_cu, (const void*)mk_fwd, NWAVES * 64, LDS_BYTES) != hipSuccess || per_cu < 1) { fprintf(stderr, "kernel_launch: occupancy query reports %d workgroups per CU\n", per_cu); }
        (void)hipGetLastError();
        grid = cus;
    }
    if (grid < 0) return;
    if (hipMemsetAsync((char*)d_ws + WS_CTL, 0, CTL_ZERO_BYTES, stream) != hipSuccess) return;
    Args a{};
    for (int i = 0; i < 21; ++i) a.in[i] = (const float*)d_in[i];
    a.out = (float*)d_out; a.ws = (unsigned char*)d_ws;
#if MK_PER_PHASE
    for (int p = 0; p < NPH; ++p) { a.ph_lo = p; a.ph_hi = p + 1; hipLaunchKernelGGL(mk_fwd, dim3(grid), dim3(NWAVES * 64), LDS_BYTES, stream, a); }
#else
    a.ph_lo = 0; a.ph_hi = NPH;
    hipLaunchKernelGGL(mk_fwd, dim3(grid), dim3(NWAVES * 64), LDS_BYTES, stream, a);
#endif
}
```

```cpp
#include <hip/hip_runtime.h>
#include <cstdio>

#ifndef MK_PER_PHASE
#define MK_PER_PHASE 0
#endif
#define GAS __attribute__((address_space(1)))
#define LAS __attribute__((address_space(3)))
typedef unsigned short bf16;
typedef unsigned v4u __attribute__((ext_vector_type(4)));
typedef unsigned v2u __attribute__((ext_vector_type(2)));
typedef float f32x4 __attribute__((ext_vector_type(4)));
typedef float f32x2 __attribute__((ext_vector_type(2)));
typedef short bf16x8 __attribute__((ext_vector_type(8)));
typedef int i32x4 __attribute__((ext_vector_type(4)));
typedef int i32x8 __attribute__((ext_vector_type(8)));
#define LDS_WAIT() asm volatile("s_waitcnt lgkmcnt(0)" ::: "memory")
#define VM_WAIT() asm volatile("s_waitcnt vmcnt(0)" ::: "memory")
#define LBAR() do { asm volatile("s_waitcnt lgkmcnt(0)" ::: "memory"); __builtin_amdgcn_s_barrier(); asm volatile("" ::: "memory"); } while (0)

__device__ __forceinline__ unsigned cvt_pk_bf16(float lo, float hi) { unsigned r; asm volatile("v_cvt_pk_bf16_f32 %0, %1, %2" : "=v"(r) : "v"(lo), "v"(hi)); return r; }
__device__ __forceinline__ unsigned cvt_pk_bf16_nv(float lo, float hi) { unsigned r; asm("v_cvt_pk_bf16_f32 %0, %1, %2" : "=v"(r) : "v"(lo), "v"(hi)); return r; }
__device__ __forceinline__ unsigned pk4_fp8(float a, float b, float c, float d) { unsigned w = 0u; w = (unsigned)__builtin_amdgcn_cvt_pk_fp8_f32(a, b, (int)w, false); w = (unsigned)__builtin_amdgcn_cvt_pk_fp8_f32(c, d, (int)w, true); return w; }
__device__ __forceinline__ __amdgpu_buffer_rsrc_t mk_rsrc(const void* p, unsigned bytes) { return __builtin_amdgcn_make_buffer_rsrc((void*)p, 0, (int)bytes, 0x00020000); }
__device__ __forceinline__ unsigned f2bf(float f) { unsigned u = __builtin_bit_cast(unsigned, f); return (u + 0x7fffu + ((u >> 16) & 1u)) >> 16; }
__device__ __forceinline__ unsigned pk2(float lo, float hi) { return f2bf(lo) | (f2bf(hi) << 16); }
__device__ __forceinline__ float bflo(unsigned w) { return __builtin_bit_cast(float, w << 16); }
__device__ __forceinline__ float bfhi(unsigned w) { return __builtin_bit_cast(float, w & 0xffff0000u); }
__device__ __forceinline__ float bf1(unsigned short b) { return __builtin_bit_cast(float, ((unsigned)b) << 16); }
__device__ __forceinline__ float sigmoidf_(float x) { return __builtin_amdgcn_rcpf(1.0f + __expf(-x)); }

namespace pg8 {
constexpr int BM = 256, BK = 64, HALF = 128, HTB = HALF * BK * 2, STAGE_BYTES = 8 * HTB, NXCD = 8, WGM = 8, KD = 1024;
constexpr int BIAS_OFF = 136192;
__host__ __device__ __forceinline__ int lds_byte(int r, int c) { const int st = (r >> 4) * 2 + (c >> 5), rr = r & 15, cc = c & 31, ob = rr * 64 + cc * 2; return st * 1024 + (ob ^ (((ob >> 9) & 1) << 5)); }
__host__ __device__ __forceinline__ void stage_rc(int b, int& R, int& C) { const int st = b / 1024, sb = b % 1024, swz = sb ^ (((sb >> 9) & 1) << 5); R = (st >> 1) * 16 + swz / 64; C = (st & 1) * 32 + (swz % 64) / 2; }
__host__ __device__ __forceinline__ int perm32(int rho) { const int n = rho >> 4, i = rho & 15; return 8 * (i >> 2) + 4 * n + (i & 3); }
struct Unit { int pm, pn; };

template <bool GROUPED> struct Order {
    int nM, nN, nwg, G, c; const char* A; const char* Bt; size_t bexp, tstep; const LAS int* texp;
    __device__ __forceinline__ void init(int nM_, int nN_, int G_, int c_) { nM = nM_; nN = nN_; nwg = nM * nN; G = G_; c = c_; tstep = (size_t)(BM * KD * 2); }
    __device__ __forceinline__ bool next(int i, Unit& u) const {
        const long L = (long)i * G + c; if (L >= nwg) return false;
        int wgid = (int)L; { const int q = nwg / NXCD, r = nwg % NXCD, xcd = wgid % NXCD, off = wgid / NXCD; wgid = (xcd < r ? xcd * (q + 1) : r * (q + 1) + (xcd - r) * q) + off; }
        const int nig = WGM * nN, gid = wgid / nig, fm = gid * WGM, gsz = (nM - fm) < WGM ? (nM - fm) : WGM;
        u.pm = fm + ((wgid % nig) % gsz); u.pn = (wgid % nig) / gsz; return true;
    }
    __device__ __forceinline__ const char* aptr(const Unit& u) const { return A + (size_t)u.pm * tstep; }
    __device__ __forceinline__ const char* bptr(const Unit& u) const { return Bt + (GROUPED ? (size_t)texp[u.pm] * bexp : (size_t)0) + (size_t)u.pn * tstep; }
};

struct EpiZ {
    static constexpr int PERM = 2, NBIAS = 0;
    bf16* O; int ldc;
    __device__ __forceinline__ void operator()(const f32x4 (&acc)[2][2][4][2], const Unit& u, int wr, int wc, int fr, int fq, const LAS float* lb) const {
        const int row0 = u.pm * BM + wr * 64 + fr, col0 = u.pn * BM + wc * 64 + 16 * fq;
#pragma unroll
        for (int ai = 0; ai < 2; ++ai)
#pragma unroll
            for (int m = 0; m < 4; ++m) { bf16* rowp = O + (size_t)(row0 + ai * HALF + m * 16) * ldc + col0;
#pragma unroll
                for (int bj = 0; bj < 2; ++bj) { const f32x4 v0 = acc[ai][bj][m][0], v1 = acc[ai][bj][m][1];
                    v4u w; w.x = cvt_pk_bf16(v0[0], v0[1]); w.y = cvt_pk_bf16(v0[2], v0[3]); w.z = cvt_pk_bf16(v1[0], v1[1]); w.w = cvt_pk_bf16(v1[2], v1[3]);
                    *(v4u*)(rowp + bj * 8) = w; } }
    }
};
template <bool BASE_BF16> struct EpiRes {
    static constexpr int PERM = 2, NBIAS = 0;
    const void* base; bf16* out; float alpha;
    __device__ __forceinline__ void operator()(const f32x4 (&acc)[2][2][4][2], const Unit& u, int wr, int wc, int fr, int fq, const LAS float* lb) const {
        const int row0 = u.pm * BM + wr * 64 + fr, col0 = u.pn * BM + wc * 64 + 16 * fq;
#pragma unroll
        for (int ai = 0; ai < 2; ++ai) {
            f32x4 b0[4][2], b1[4][2];
#pragma unroll
            for (int m = 0; m < 4; ++m) { const size_t off = (size_t)(row0 + ai * HALF + m * 16) * 1024 + col0;
#pragma unroll
                for (int bj = 0; bj < 2; ++bj) {
                    if constexpr (BASE_BF16) { const v4u bw = *(const v4u*)((const bf16*)base + off + bj * 8); b0[m][bj] = __builtin_bit_cast(f32x4, bw); }
                    else { b0[m][bj] = *(const f32x4*)((const float*)base + off + bj * 8); b1[m][bj] = *(const f32x4*)((const float*)base + off + bj * 8 + 4); } } }
            __builtin_amdgcn_sched_barrier(0);
#pragma unroll
            for (int m = 0; m < 4; ++m) { const size_t off = (size_t)(row0 + ai * HALF + m * 16) * 1024 + col0;
#pragma unroll
                for (int bj = 0; bj < 2; ++bj) { f32x4 c0, c1;
                    if constexpr (BASE_BF16) { const v4u bw = __builtin_bit_cast(v4u, b0[m][bj]); c0 = (f32x4){bflo(bw.x), bfhi(bw.x), bflo(bw.y), bfhi(bw.y)}; c1 = (f32x4){bflo(bw.z), bfhi(bw.z), bflo(bw.w), bfhi(bw.w)}; }
                    else { c0 = b0[m][bj]; c1 = b1[m][bj]; }
                    const f32x4 v0 = c0 * alpha + acc[ai][bj][m][0], v1 = c1 * alpha + acc[ai][bj][m][1];
                    v4u w; w.x = cvt_pk_bf16(v0[0], v0[1]); w.y = cvt_pk_bf16(v0[2], v0[3]); w.z = cvt_pk_bf16(v1[0], v1[1]); w.w = cvt_pk_bf16(v1[2], v1[3]);
                    *(v4u*)(out + off + bj * 8) = w; } }
        }
    }
};
struct EpiSwiglu8 {
    static constexpr int PERM = 1, NBIAS = 256;
    unsigned char* O; const float* bias; const LAS int* texp; float inscale;
    __device__ __forceinline__ const float* bias_src(const Unit& u, int i) const { return bias + (size_t)texp[u.pm] * 2048 + (i >> 7) * 1024 + u.pn * HALF + (i & 127); }
    __device__ __forceinline__ void operator()(const f32x4 (&acc)[2][2][4][2], const Unit& u, int wr, int wc, int fr, int fq, const LAS float* lb) const {
        const int row0 = u.pm * BM + wr * 64 + fr, jc = u.pn * HALF + wc * 32 + 8 * fq;
        const LAS float* bp = lb + wc * 32 + 8 * fq; const float s1 = inscale, s4 = 4.0f * inscale; const __amdgpu_buffer_rsrc_t rs = mk_rsrc(O, 0x7fffff00u);
        f32x4 bg[2], bl[2];
#pragma unroll
        for (int n = 0; n < 2; ++n) { bg[n] = *(const LAS f32x4*)(bp + 4 * n); bl[n] = *(const LAS f32x4*)(bp + 128 + 4 * n) * 4.0f + 4.0f; }
#pragma unroll
        for (int ai = 0; ai < 2; ++ai)
#pragma unroll
            for (int m = 0; m < 4; ++m) { const unsigned ob = (unsigned)(row0 + ai * HALF + m * 16) * 1024u + (unsigned)jc; float r[8];
#pragma unroll
                for (int n = 0; n < 2; ++n) { const f32x4 g4 = acc[ai][0][m][n] * s1 + bg[n], l4 = acc[ai][1][m][n] * s4 + bl[n];
#pragma unroll
                    for (int p = 0; p < 2; ++p) {
                        const f32x2 g2 = (f32x2){fminf(g4[2 * p], 7.0f), fminf(g4[2 * p + 1], 7.0f)}, l2 = (f32x2){__builtin_amdgcn_fmed3f(l4[2 * p], -24.0f, 32.0f), __builtin_amdgcn_fmed3f(l4[2 * p + 1], -24.0f, 32.0f)};
                        const f32x2 t2 = g2 * -2.45546696f; const f32x2 d2 = (f32x2){__builtin_amdgcn_exp2f(t2[0]), __builtin_amdgcn_exp2f(t2[1])} + 1.0f;
                        const f32x2 q2 = (f32x2){__builtin_amdgcn_rcpf(d2[0]), __builtin_amdgcn_rcpf(d2[1])}; const f32x2 r2 = (g2 * l2) * q2;
                        r[4 * n + 2 * p] = r2[0]; r[4 * n + 2 * p + 1] = r2[1]; } }
                v2u w; w.x = pk4_fp8(r[0], r[1], r[2], r[3]); w.y = pk4_fp8(r[4], r[5], r[6], r[7]);
                __builtin_amdgcn_raw_buffer_store_b64(w, rs, (int)ob, 0, 16); }
    }
};
struct EpiBiasG8 {
    static constexpr int PERM = 2, NBIAS = 256;
    unsigned char* O; const float* bias; const LAS int* texp; float inscale;
    __device__ __forceinline__ const float* bias_src(const Unit& u, int i) const { return bias + (size_t)texp[u.pm] * 1024 + u.pn * BM + i; }
    __device__ __forceinline__ void operator()(const f32x4 (&acc)[2][2][4][2], const Unit& u, int wr, int wc, int fr, int fq, const LAS float* lb) const {
        const int row0 = u.pm * BM + wr * 64 + fr, col0 = u.pn * BM + wc * 64 + 16 * fq;
        const LAS float* bp = lb + wc * 64 + 16 * fq; const float s16 = 16.0f * inscale;
        f32x4 bv[2][2];
#pragma unroll
        for (int bj = 0; bj < 2; ++bj)
#pragma unroll
            for (int n = 0; n < 2; ++n) bv[bj][n] = *(const LAS f32x4*)(bp + bj * 8 + 4 * n) * 16.0f;
#pragma unroll
        for (int ai = 0; ai < 2; ++ai)
#pragma unroll
            for (int m = 0; m < 4; ++m) { unsigned char* rowp = O + (size_t)(row0 + ai * HALF + m * 16) * 1024 + col0; v4u w;
                { const f32x4 v0 = acc[ai][0][m][0] * s16 + bv[0][0], v1 = acc[ai][0][m][1] * s16 + bv[0][1]; w.x = pk4_fp8(v0[0], v0[1], v0[2], v0[3]); w.y = pk4_fp8(v1[0], v1[1], v1[2], v1[3]); }
                { const f32x4 v0 = acc[ai][1][m][0] * s16 + bv[1][0], v1 = acc[ai][1][m][1] * s16 + bv[1][1]; w.z = pk4_fp8(v0[0], v0[1], v0[2], v0[3]); w.w = pk4_fp8(v1[0], v1[1], v1[2], v1[3]); }
                *(v4u*)rowp = w; }
    }
};
struct EpiGlu {
    static constexpr int PERM = 1, NBIAS = 0;
    bf16* O;
    __device__ __forceinline__ void operator()(const f32x4 (&acc)[2][2][4][2], const Unit& u, int wr, int wc, int fr, int fq, const LAS float* lb) const {
        const int row0 = u.pm * BM + wr * 64 + fr, jc = u.pn * HALF + wc * 32 + 8 * fq;
#pragma unroll
        for (int ai = 0; ai < 2; ++ai)
#pragma unroll
            for (int m = 0; m < 4; ++m) { bf16* rowp = O + (size_t)(row0 + ai * HALF + m * 16) * 1024 + jc; float r[8];
#pragma unroll
                for (int n = 0; n < 2; ++n) { const f32x4 a4 = acc[ai][0][m][n], g4 = acc[ai][1][m][n];
#pragma unroll
                    for (int p = 0; p < 2; ++p) {
                        const f32x2 t2 = (f32x2){g4[2 * p], g4[2 * p + 1]} * -1.44269504f; const f32x2 d2 = (f32x2){__builtin_amdgcn_exp2f(t2[0]), __builtin_amdgcn_exp2f(t2[1])} + 1.0f;
                        const f32x2 r2 = (f32x2){a4[2 * p], a4[2 * p + 1]} * (f32x2){__builtin_amdgcn_rcpf(d2[0]), __builtin_amdgcn_rcpf(d2[1])};
                        r[4 * n + 2 * p] = r2[0]; r[4 * n + 2 * p + 1] = r2[1]; } }
                v4u w; w.x = cvt_pk_bf16(r[0], r[1]); w.y = cvt_pk_bf16(r[2], r[3]); w.z = cvt_pk_bf16(r[4], r[5]); w.w = cvt_pk_bf16(r[6], r[7]);
                *(v4u*)rowp = w; }
    }
};

__device__ __forceinline__ bf16x8 lo8(i32x8 v) { return __builtin_bit_cast(bf16x8, (i32x4)__builtin_shufflevector(v, v, 0, 1, 2, 3)); }
__device__ __forceinline__ bf16x8 hi8(i32x8 v) { return __builtin_bit_cast(bf16x8, (i32x4)__builtin_shufflevector(v, v, 4, 5, 6, 7)); }
struct Hand { unsigned* cnt; unsigned* tot; unsigned expect; };
template <class Epi, class Sched, bool ALIGN_EPI = true, bool FP8 = false, bool GATHER = false, int HANDOFF = 0  >
__device__ __forceinline__ void gemm_phase(LAS unsigned char* lds, const Sched& S, const Epi& E, const LAS unsigned short* rowtab = nullptr, const Hand hand = Hand{nullptr, nullptr, 0u}) {
    const int tid = threadIdx.x, wid = __builtin_amdgcn_readfirstlane(tid >> 6), lane = tid & 63, wr = wid >> 2, wc = wid & 3, fr = lane & 15, fq = lane >> 4;
    constexpr int ROWB = FP8 ? KD : KD * 2, nt = ROWB / (BK * 2);
    unsigned voffB[2][2], offC[2][2], offN[2][2]; int rA[2], cA2[2];
#pragma unroll
    for (int i = 0; i < 2; ++i) { int R, C; stage_rc(tid * 16 + i * 8192, R, C); const int Rb = (Epi::PERM == 1) ? ((R & ~31) + perm32(R & 31)) : R;
        rA[i] = R; cA2[i] = C * 2;
#pragma unroll
        for (int bj = 0; bj < 2; ++bj) { int grow;
            if constexpr (Epi::PERM == 2) { const int wc_ = R >> 5, rho = R & 31; grow = 64 * wc_ + 16 * ((rho & 15) >> 2) + 8 * bj + 4 * (rho >> 4) + (rho & 3); }
            else grow = bj * HALF + Rb;
            voffB[bj][i] = (unsigned)(grow * ROWB + C * 2); }
#pragma unroll
        for (int h = 0; h < 2; ++h) { offC[h][i] = (unsigned)((h * HALF + R) * ROWB + C * 2); offN[h][i] = offC[h][i]; } }
#define PG8_GOFF(dst, unit_idx) do { if constexpr (GATHER) { _Pragma("unroll") for (int h_ = 0; h_ < 2; ++h_) _Pragma("unroll") for (int i_ = 0; i_ < 2; ++i_) \
        dst[h_][i_] = (unsigned)rowtab[(unit_idx) * 256 + h_ * HALF + rA[i_]] * (unsigned)ROWB + (unsigned)cA2[i_]; } } while (0)
    constexpr size_t kstep = (size_t)(BK * 2);
    constexpr size_t hstep = (size_t)HALF * ROWB;
    const unsigned ldsw = (unsigned)wid * 1024u;
    const int aoff = lds_byte(wr * 64 + fr, fq * 8), boff = lds_byte(wc * 32 + fr, fq * 8);
#define PG8_SA(b, h) (((b) * 2 + (h)) * HTB)
#define PG8_SB(b, h) ((4 + (b) * 2 + (h)) * HTB)
#define PG8_STAGE(bufoff, gbase, voff) do { _Pragma("unroll") for (int _i = 0; _i < 2; ++_i) \
        __builtin_amdgcn_global_load_lds((const unsigned*)((const char*)(gbase) + (voff)[_i]), (LAS unsigned*)(lds + (bufoff) + ldsw + _i * 8192), 16, 0, 0); } while (0)
#define PG8_LDA(dst, b, h) do { _Pragma("unroll") for (int m = 0; m < 4; ++m) { const i32x4 x_ = *(const LAS i32x4*)(lds + PG8_SA(b, h) + aoff + m * 2048), y_ = *(const LAS i32x4*)(lds + PG8_SA(b, h) + aoff + m * 2048 + 1024); dst[m] = __builtin_shufflevector(x_, y_, 0, 1, 2, 3, 4, 5, 6, 7); } } while (0)
#define PG8_LDB(dst, b, h) do { _Pragma("unroll") for (int n = 0; n < 2; ++n) { const i32x4 x_ = *(const LAS i32x4*)(lds + PG8_SB(b, h) + boff + n * 2048), y_ = *(const LAS i32x4*)(lds + PG8_SB(b, h) + boff + n * 2048 + 1024); dst[n] = __builtin_shufflevector(x_, y_, 0, 1, 2, 3, 4, 5, 6, 7); } } while (0)
#define PG8_MMA(ai, bj, At, Bt) do { __builtin_amdgcn_s_setprio(1); _Pragma("unroll") for (int m = 0; m < 4; ++m) _Pragma("unroll") for (int n = 0; n < 2; ++n) { \
        if constexpr (FP8) asm volatile("s_nop 1\n\tv_mfma_scale_f32_16x16x128_f8f6f4 %0, %1, %2, %0, %3, %3 op_sel_hi:[0,0,0]" : "+v"(acc[ai][bj][m][n]) : "v"(Bt[n]), "v"(At[m]), "v"(sc127)); \
        else { acc[ai][bj][m][n] = __builtin_amdgcn_mfma_f32_16x16x32_bf16(lo8(Bt[n]), lo8(At[m]), acc[ai][bj][m][n], 0, 0, 0); acc[ai][bj][m][n] = __builtin_amdgcn_mfma_f32_16x16x32_bf16(hi8(Bt[n]), hi8(At[m]), acc[ai][bj][m][n], 0, 0, 0); } } __builtin_amdgcn_s_setprio(0); } while (0)
#define PG8_WAIT_V(n) asm volatile("s_waitcnt vmcnt(" #n ")" ::: "memory")
#define PG8_WAIT_L(n) asm volatile("s_waitcnt lgkmcnt(" #n ")" ::: "memory")
#define PG8_BAR __builtin_amdgcn_s_barrier()
#define PG8_SCHED __builtin_amdgcn_sched_barrier(0)
#define PG8_SCHED8 do { } while (0)
    Unit cur, nxt; int ui = 0;
    if (!S.next(0, cur)) return;
    int prev_pm = -1; bool all_done = false;
#define PG8_AREADY(u_) do { if constexpr (HANDOFF == 2) { if (wid == 0 && !all_done) { \
            all_done = (unsigned)__builtin_amdgcn_readfirstlane((int)__hip_atomic_load(hand.tot, __ATOMIC_RELAXED, __HIP_MEMORY_SCOPE_AGENT)) >= hand.expect;     \
            if (!all_done) { unsigned spins_ = 0u; \
                while ((unsigned)__builtin_amdgcn_readfirstlane((int)__hip_atomic_load(hand.cnt + 64 * (u_).pm, __ATOMIC_RELAXED, __HIP_MEMORY_SCOPE_AGENT)) < 64u) { __builtin_amdgcn_s_sleep(2); if (++spins_ > (1u << 22)) break; } } } \
        asm volatile("" ::: "memory"); __builtin_amdgcn_s_barrier(); asm volatile("" ::: "memory"); } } while (0)
    f32x4 acc[2][2][4][2];
    typedef _Float16 h4_t __attribute__((ext_vector_type(4)));
#define PG8_ZERO() do { h4_t zh_ = (h4_t){0, 0, 0, 0}; asm volatile("s_nop 7" : "+v"(zh_));     \
        _Pragma("unroll") for (int a = 0; a < 2; ++a) _Pragma("unroll") for (int b = 0; b < 2; ++b) _Pragma("unroll") for (int m = 0; m < 4; ++m) _Pragma("unroll") for (int n = 0; n < 2; ++n) \
        asm volatile("v_mfma_f32_4x4x4_16b_f16 %0, %1, %1, 0" : "=v"(acc[a][b][m][n]) : "v"(zh_)); } while (0)
    PG8_ZERO();
    i32x8 At[4], B0[2], B1[2];
    const int sc127 = 127;
    const char* cA = GATHER ? S.A : S.aptr(cur); const char* cB = S.bptr(cur);
    PG8_GOFF(offC, 0);
    PG8_AREADY(cur);
    PG8_STAGE(PG8_SB(0, 0), cB, voffB[0]); PG8_STAGE(PG8_SB(0, 1), cB, voffB[1]); PG8_STAGE(PG8_SA(0, 0), cA, offC[0]); PG8_STAGE(PG8_SA(0, 1), cA, offC[1]);
    if (wr == 1) PG8_BAR;
    PG8_WAIT_V(2); PG8_BAR;
    PG8_STAGE(PG8_SB(1, 0), cB + kstep, voffB[0]); PG8_STAGE(PG8_SA(1, 0), cA + kstep, offC[0]); PG8_STAGE(PG8_SB(1, 1), cB + kstep, voffB[1]);
    PG8_WAIT_V(6); PG8_BAR;
    for (;;) {
        if constexpr (Epi::NBIAS != 0) { if (wid < 4) {
            __builtin_amdgcn_global_load_lds((const unsigned*)E.bias_src(cur, wid * 64 + lane), (LAS unsigned*)(lds + BIAS_OFF + (ui & 1) * 1024 + wid * 256), 4, 0, 0); } }
        const bool has_next = S.next(ui + 1, nxt);
        const char* nA = GATHER ? cA : (has_next ? S.aptr(nxt) : cA); const char* nB = has_next ? S.bptr(nxt) : cB;
        if constexpr (GATHER) { if (has_next) PG8_GOFF(offN, ui + 1); else {
#pragma unroll
            for (int h = 0; h < 2; ++h) { offN[h][0] = offC[h][0]; offN[h][1] = offC[h][1]; } } }
#pragma nounroll
        for (int t = 0; t < nt; t += 2) {
            const bool last = (t == nt - 2);
            if (last && has_next) PG8_AREADY(nxt);
            const char* a1 = cA + (size_t)(t + 1) * kstep;
            const char* a2 = last ? nA : cA + (size_t)(t + 2) * kstep; const char* b2 = last ? nB : cB + (size_t)(t + 2) * kstep;
            const char* a3 = a2 + kstep; const char* b3 = b2 + kstep;
            unsigned o2[2][2];
#pragma unroll
            for (int h = 0; h < 2; ++h) { o2[h][0] = (GATHER && last) ? offN[h][0] : offC[h][0]; o2[h][1] = (GATHER && last) ? offN[h][1] : offC[h][1]; }
            PG8_LDB(B0, 0, 0); PG8_LDB(B1, 0, 1); PG8_SCHED; PG8_LDA(At, 0, 0); PG8_STAGE(PG8_SA(1, 1), a1, offC[1]);
            PG8_WAIT_V(8); PG8_WAIT_L(0); PG8_BAR; PG8_SCHED8; PG8_MMA(0, 0, At, B0); PG8_MMA(0, 1, At, B1); PG8_BAR; PG8_SCHED;
            PG8_LDA(At, 0, 1); PG8_STAGE(PG8_SB(0, 0), b2, voffB[0]); PG8_STAGE(PG8_SB(0, 1), b2, voffB[1]); PG8_STAGE(PG8_SA(0, 0), a2, o2[0]);
            PG8_WAIT_V(8); PG8_WAIT_L(0); PG8_BAR; PG8_SCHED8; PG8_MMA(1, 0, At, B0); PG8_MMA(1, 1, At, B1); PG8_BAR; PG8_SCHED;
            PG8_LDB(B0, 1, 0); PG8_LDB(B1, 1, 1); PG8_SCHED; PG8_LDA(At, 1, 0); PG8_STAGE(PG8_SA(0, 1), a2, o2[1]);
            PG8_WAIT_V(8); PG8_WAIT_L(0); PG8_BAR; PG8_SCHED8; PG8_MMA(0, 0, At, B0); PG8_MMA(0, 1, At, B1); PG8_BAR; PG8_SCHED;
            PG8_LDA(At, 1, 1); PG8_STAGE(PG8_SB(1, 0), b3, voffB[0]); PG8_STAGE(PG8_SB(1, 1), b3, voffB[1]); PG8_STAGE(PG8_SA(1, 0), a3, o2[0]);
            PG8_WAIT_V(8); PG8_WAIT_L(0); PG8_BAR; PG8_SCHED8; PG8_MMA(1, 0, At, B0); PG8_MMA(1, 1, At, B1); PG8_BAR; PG8_SCHED;
        }
        if constexpr (HANDOFF == 1) { if (prev_pm >= 0 && lane == 0) {
            __hip_atomic_fetch_add(hand.cnt + 64 * prev_pm, 1u, __ATOMIC_RELAXED, __HIP_MEMORY_SCOPE_AGENT); } prev_pm = cur.pm; }
        if constexpr (ALIGN_EPI) { if (wr == 0) PG8_BAR; }
        if constexpr (FP8) asm volatile("s_nop 15\n\ts_nop 15" ::: "memory");
        E(acc, cur, wr, wc, fr, fq, (const LAS float*)(lds + BIAS_OFF + (ui & 1) * 1024));
        if (!has_next) break;
        PG8_ZERO();
        cur = nxt; cA = nA; cB = nB; ++ui;
        if constexpr (GATHER) {
#pragma unroll
            for (int h = 0; h < 2; ++h) { offC[h][0] = offN[h][0]; offC[h][1] = offN[h][1]; } }
        if constexpr (ALIGN_EPI) { if (wr == 1) PG8_BAR; }
    }
    PG8_WAIT_V(0);
    if constexpr (HANDOFF == 1) { if (lane == 0) { __hip_atomic_fetch_add(hand.cnt + 64 * prev_pm, 1u, __ATOMIC_RELAXED, __HIP_MEMORY_SCOPE_AGENT); } }
    if constexpr (!ALIGN_EPI) { if (wr == 0) PG8_BAR; }
    PG8_BAR;
#undef PG8_SA
#undef PG8_SB
#undef PG8_STAGE
#undef PG8_LDA
#undef PG8_LDB
#undef PG8_MMA
#undef PG8_ZERO
#undef PG8_WAIT_V
#undef PG8_WAIT_L
#undef PG8_BAR
#undef PG8_SCHED
#undef PG8_SCHED8
#undef PG8_GOFF
#undef PG8_AREADY
}

}

constexpr int NWAVES = 8;
constexpr int T = 32768, D = 1024, SEQ = 2048, NB = 16;
constexpr int NZ = 3072;
constexpr int ZQ = 0, ZK = 256, ZV = 512, ZO = 1024, ZSB = 1536, ZSC = 2048, ZSX = 2560;
constexpr int NE = 32, TOPK = 4;
constexpr int PROWS = 139264;
constexpr float ALPHA = 1.41421356237309515f;
constexpr float LN_EPS = 1e-5f, HEAD_EPS = 1e-6f;
constexpr int NPH = 17;

constexpr size_t MiB = 1u << 20;
constexpr size_t WS_CTL = 0, CTL_ZERO_BYTES = 1 * MiB;
constexpr size_t WS_TOPI = 1 * MiB, WS_TOPG = WS_TOPI + MiB / 2, WS_SLOT = 2 * MiB, WS_CNTT = WS_SLOT + MiB / 2, WS_META = WS_CNTT + MiB / 4, WS_GATES = 3 * MiB;
constexpr size_t WS_RWH = 4 * MiB, WS_RWL = WS_RWH + MiB / 4, WS_RGB = WS_RWL + MiB / 4, WS_STATS = 5 * MiB, WS_WSC = 6 * MiB, WS_ROWTOK = 7 * MiB;
constexpr size_t WS_WIN = 8 * MiB, WS_WOUT = 14 * MiB, WS_PW1 = 16 * MiB, WS_PW2 = 20 * MiB, WS_UP = 22 * MiB, WS_DN = 278 * MiB;
constexpr size_t WS_ABF = 406 * MiB, WS_X1B = 470 * MiB, WS_HCAT = 534 * MiB, WS_R = 598 * MiB;
constexpr size_t WS_ACT = 1254 * MiB, WS_YS = 1526 * MiB, WS_Z = 1798 * MiB, WS_U = 1798 * MiB, WS_V = 1862 * MiB, WS_END = 1990 * MiB;
static_assert((size_t)PROWS * 2048 <= 272 * MiB, "grouped buffers");
constexpr int CW_LBAR = 8192, CW_MAPX = 12288;
constexpr int CW_BAR = 4096, CW_QUEUE = 64, Q_CHUNK = 8, CW_UPCNT = 32768, UPCNT_LAYER = 544 * 64, CW_UPTOT = 110592;

constexpr int RING_BYTES = 131072;
constexpr int LDSCTL_OFF = 139264, MISC_OFF = LDSCTL_OFF + 320;
constexpr int TEXP_OFF = 132096;
constexpr int ROWTAB_OFF = 147456;
constexpr int LDS_BYTES = 147456 + 20 * 512;
static_assert(TEXP_OFF + 4096 <= LDSCTL_OFF && MISC_OFF + 128 <= LDS_BYTES, "LDS map");

#define XB_TMO      128
#define XB_XCNT(j)  (256  + 64 * (j))
#define XB_XSUB(j)  (1280 + 64 * (j))
#define XB_XGEN(j)  (2304 + 64 * (j))
#define XB_TOP      3328
#define XB_TOPGEN   3392
#define XCD_BAR_WORDS 3456
#define XB_SPIN_CAP (1u << 18)
__device__ __forceinline__ unsigned xb_ld(unsigned* p)              { return __hip_atomic_load(p, __ATOMIC_RELAXED, __HIP_MEMORY_SCOPE_AGENT); }
__device__ __forceinline__ unsigned xb_add(unsigned* p, unsigned v) { return __hip_atomic_fetch_add(p, v, __ATOMIC_RELAXED, __HIP_MEMORY_SCOPE_AGENT); }
__device__ __forceinline__ unsigned xb_xcc_id() { return (unsigned)__builtin_amdgcn_s_getreg((3 << 11) | 20) & 0xFu; }
#define XB_SPIN(cond, bar) do { unsigned _sp = 0; while (cond) { __builtin_amdgcn_s_sleep(1); \
    if ((++_sp & 255u) == 0u) { if (xb_ld(&(bar)[XB_TMO])) break; if (_sp > XB_SPIN_CAP) { atomicAdd(&(bar)[XB_TMO], 1u); break; } } } } while (0)
struct XcdBarrier { unsigned* bar; unsigned x; volatile LAS unsigned* st; };
__device__ __forceinline__ XcdBarrier xcd_barrier_post(unsigned* bar, volatile LAS unsigned* st) {
    XcdBarrier b; b.bar = bar; b.x = xb_xcc_id(); b.st = st;
    if (threadIdx.x == 0) (void)xb_add(&bar[XB_XCNT(b.x)], 1u);
    return b;
}
__device__ __forceinline__ void xcd_barrier_complete(unsigned* bar, unsigned x, unsigned& nloc, unsigned& nx) {
    const unsigned G = gridDim.x * gridDim.y * gridDim.z;
    unsigned sum, cnt, mine, sp = 0u;
    for (;;) {
        sum = 0u; cnt = 0u; mine = 0u;
#pragma unroll
        for (unsigned j = 0; j < 16; ++j) { const unsigned c = xb_ld(&bar[XB_XCNT(j)]); sum += c; cnt += (c > 0u) ? 1u : 0u; mine = (j == x) ? c : mine; }
        if (sum == G) break;
        __builtin_amdgcn_s_sleep(1);
        if ((++sp & 255u) == 0u) { if (xb_ld(&bar[XB_TMO])) break; if (sp > XB_SPIN_CAP) { atomicAdd(&bar[XB_TMO], 1u); break; } }
    }
    nloc = mine > 0u ? mine : 1u; nx = cnt > 0u ? cnt : 1u;
}
__device__ __forceinline__ void xcd_barrier(const XcdBarrier& b) {
    asm volatile("s_waitcnt vmcnt(0)" ::: "memory");
    __syncthreads();
    if (threadIdx.x == 0) {
        unsigned* bar = b.bar;
        __builtin_amdgcn_s_waitcnt(0);
        unsigned nloc = b.st[0], nx = b.st[1];
        if (nloc == 0u) { xcd_barrier_complete(bar, b.x, nloc, nx); b.st[0] = nloc; b.st[1] = nx; }
        const unsigned old = xb_add(&bar[XB_XSUB(b.x)], 1u);
        const unsigned gen = old / nloc;
        if (old + 1u == (gen + 1u) * nloc) {
            __builtin_amdgcn_fence(__ATOMIC_RELEASE, "agent");
            asm volatile("s_waitcnt vmcnt(0)" ::: "memory");
            const unsigned og = xb_add(&bar[XB_TOP], 1u);
            const unsigned tg = og / nx;
            if (og + 1u == (tg + 1u) * nx) xb_add(&bar[XB_TOPGEN], 1u);
            else XB_SPIN(xb_ld(&bar[XB_TOPGEN]) == tg, bar);
            __builtin_amdgcn_fence(__ATOMIC_ACQUIRE, "agent");
            xb_add(&bar[XB_XGEN(b.x)], 1u);
            asm volatile("s_waitcnt vmcnt(0)" ::: "memory");
        } else {
            XB_SPIN(xb_ld(&bar[XB_XGEN(b.x)]) == gen, bar);
            __builtin_amdgcn_fence(__ATOMIC_ACQUIRE, "agent");
            asm volatile("s_waitcnt vmcnt(0)" ::: "memory");
        }
    }
    __syncthreads();
}

__device__ __forceinline__ void xcd_local_barrier(const XcdBarrier& b, unsigned* lb) {
    asm volatile("s_waitcnt vmcnt(0)" ::: "memory");
    __syncthreads();
    if (threadIdx.x == 0) {
        __builtin_amdgcn_s_waitcnt(0);
        const unsigned nloc = b.st[0];
        const unsigned old = xb_add(&lb[64 * b.x], 1u), gen = old / nloc;
        if (old + 1u == (gen + 1u) * nloc) (void)xb_add(&lb[1024 + 64 * b.x], 1u);
        else XB_SPIN(xb_ld(&lb[1024 + 64 * b.x]) == gen, b.bar);
        __builtin_amdgcn_fence(__ATOMIC_ACQUIRE, "agent");
        asm volatile("s_waitcnt vmcnt(0)" ::: "memory");
    }
    __syncthreads();
}

struct Args { const float* in[21]; float* out; unsigned char* ws; int ph_lo, ph_hi; };
struct Frame {
    LAS unsigned char* lds;
    int tid, lane, wave, vcu, G;
    bool own;
    unsigned char* ws;
};
__device__ __forceinline__ float wave_sum(float v) {
#pragma unroll
    for (int o = 1; o < 64; o <<= 1) v += __shfl_xor(v, o);
    return v;
}
__device__ __forceinline__ float wave_max(float v) {
#pragma unroll
    for (int o = 1; o < 64; o <<= 1) v = fmaxf(v, __shfl_xor(v, o));
    return v;
}

struct TrItem { const float* src; bf16* dst; int ld; float scale; int fp8; };
__device__ __forceinline__ void tr_load(const TrItem& I, int lane, f32x4 (&tv)[8]) {
#pragma unroll
    for (int i = 0; i < 8; ++i) tv[i] = *(const GAS f32x4*)(I.src + (size_t)((lane >> 3) + 8 * i) * I.ld + 4 * (lane & 7));
}
__device__ __forceinline__ void tr_store(const TrItem& I, const f32x4 (&tv)[8], LAS float* scr, int lane) {
#pragma unroll
    for (int i = 0; i < 8; ++i) { LAS float* p = scr + ((lane >> 3) + 8 * i) * 33 + 4 * (lane & 7); p[0] = tv[i][0]; p[1] = tv[i][1]; p[2] = tv[i][2]; p[3] = tv[i][3]; }
    LDS_WAIT(); asm volatile("" ::: "memory");
    const int c = lane & 7; const float scale = I.scale;
#pragma unroll
    for (int j = 0; j < 4; ++j) { const int n = (lane >> 3) + 8 * j; const LAS float* s = scr + (8 * c) * 33 + n;
        if (I.fp8) { v2u o; o.x = pk4_fp8(s[0 * 33] * scale, s[1 * 33] * scale, s[2 * 33] * scale, s[3 * 33] * scale); o.y = pk4_fp8(s[4 * 33] * scale, s[5 * 33] * scale, s[6 * 33] * scale, s[7 * 33] * scale);
            *(GAS v2u*)((unsigned char*)I.dst + (size_t)n * 1024 + 8 * c) = o; }
        else { v4u o; o.x = cvt_pk_bf16(s[0 * 33] * scale, s[1 * 33] * scale); o.y = cvt_pk_bf16(s[2 * 33] * scale, s[3 * 33] * scale); o.z = cvt_pk_bf16(s[4 * 33] * scale, s[5 * 33] * scale); o.w = cvt_pk_bf16(s[6 * 33] * scale, s[7 * 33] * scale);
            *(GAS v4u*)(I.dst + (size_t)n * 1024 + 8 * c) = o; } }
    LDS_WAIT(); asm volatile("" ::: "memory");
}
__device__ __forceinline__ int glu_src_col(int d0) { const int pn = d0 >> 8, j0 = d0 & 255; return j0 < 128 ? 128 * pn + j0 : 1024 + 128 * pn + (j0 - 128); }

constexpr int I_IN = 16 * 96, I_OUT = 16 * 32, I_PW1 = 16 * 64, I_PW2 = 16 * 32, I_UP = 64 * 1024, I_DN = 64 * 512;
constexpr int I_EARLY = I_IN + I_OUT, NITEMS = I_IN + I_OUT + I_PW1 + I_PW2 + I_UP + I_DN;
#ifndef MK_P0_ITEMS
#define MK_P0_ITEMS 0
#endif
constexpr int I_P0 = I_EARLY + MK_P0_ITEMS;
__device__ __forceinline__ TrItem tr_decode(Frame& F, const Args& A, int it, const float (&wsc)[4]) {
    bf16* WIN = (bf16*)(F.ws + WS_WIN); bf16* WOUT = (bf16*)(F.ws + WS_WOUT); bf16* PW1 = (bf16*)(F.ws + WS_PW1); bf16* PW2 = (bf16*)(F.ws + WS_PW2);
    bf16* UP = (bf16*)(F.ws + WS_UP); bf16* DN = (bf16*)(F.ws + WS_DN);
    TrItem I; I.scale = 1.0f; I.fp8 = 0; int r = it;
    if (r < I_IN) { const int kb = r / 96, nb = r % 96, d0 = 32 * nb, sc0 = d0 + (d0 >= 1536 ? 8 : 0); I.scale = (d0 >= 256 && d0 < 512) ? 0.125f : 1.0f;
        I.src = A.in[1] + (size_t)kb * 64 * 3080 + sc0; I.ld = 3080; I.dst = WIN + (size_t)d0 * 1024 + kb * 64; return I; } r -= I_IN;
    if (r < I_OUT) { const int kb = r >> 5, nb = r & 31; I.src = A.in[6] + (size_t)kb * 64 * 1024 + 32 * nb; I.ld = 1024; I.dst = WOUT + (size_t)(32 * nb) * 1024 + kb * 64; return I; } r -= I_OUT;
    if (r < I_PW1) { const int kb = r >> 6, nb = r & 63, d0 = 32 * nb; I.src = A.in[7] + (size_t)kb * 64 * 2048 + glu_src_col(d0); I.ld = 2048; I.dst = PW1 + (size_t)d0 * 1024 + kb * 64; return I; } r -= I_PW1;
    if (r < I_PW2) { const int kb = r >> 5, nb = r & 31; I.src = A.in[12] + (size_t)kb * 64 * 1024 + 32 * nb; I.ld = 1024; I.dst = PW2 + (size_t)(32 * nb) * 1024 + kb * 64; return I; } r -= I_PW2;
    if (r < I_UP) { const int le = r >> 10, rr = r & 1023, kb = rr >> 6, nb = rr & 63, d0 = 32 * nb;
        I.src = A.in[15] + (size_t)le * 1024 * 2048 + (size_t)kb * 64 * 2048 + glu_src_col(d0); I.ld = 2048;
        I.fp8 = 1; I.scale = (le >> 5) ? wsc[2] : wsc[0]; I.dst = (bf16*)((unsigned char*)UP + (size_t)le * 2048 * 1024 + (size_t)d0 * 1024 + kb * 64); return I; } r -= I_UP;
    { const int le = r >> 9, rr = r & 511, kb = rr >> 5, nb = rr & 31;
        I.src = A.in[17] + (size_t)le * 1024 * 1024 + (size_t)kb * 64 * 1024 + 32 * nb; I.ld = 1024;
        I.fp8 = 1; I.scale = (le >> 5) ? wsc[3] : wsc[1]; I.dst = (bf16*)((unsigned char*)DN + (size_t)le * 1024 * 1024 + (size_t)(32 * nb) * 1024 + kb * 64); return I; }
}
__device__ __forceinline__ void convert_items(Frame& F, const Args& A, int first, int last, int w0, int nw, const float (&wsc)[4]) {
    LAS float* scr = (LAS float*)(F.lds + F.wave * 17408); LAS float* scr2 = scr + 2176;
    int it = first + w0; if (it >= last) return;
    f32x4 ta[8], tb[8];
    TrItem a = tr_decode(F, A, it, wsc), b = a; tr_load(a, F.lane, ta);
    for (;;) {
        const int itb = it + nw; const bool hb = itb < last;
        b = tr_decode(F, A, hb ? itb : it, wsc); tr_load(b, F.lane, tb);
        tr_store(a, ta, scr, F.lane);
        if (!hb) break;
        const int ita = itb + nw; const bool ha = ita < last;
        a = tr_decode(F, A, ha ? ita : itb, wsc); tr_load(a, F.lane, ta);
        tr_store(b, tb, scr2, F.lane);
        if (!ha) break;
        it = ita;
    }
}

constexpr int XT_UP = 64 * 128, XT_DN = 64 * 64, XT_ALL = XT_UP + XT_DN;
struct XTask { const float* lsrc; unsigned char* dst; int N; float scale; };
__device__ __forceinline__ int xt_task(int q) { return q < 4096 ? q : (q < 6144 ? XT_UP + (q - 4096) : (q < 10240 ? 4096 + (q - 6144) : q)); }
__device__ __forceinline__ XTask xt_setup(Frame& F, const Args& A, int t, float sc_up0, float sc_dn0, float sc_up1, float sc_dn1) {
    XTask X; const float* src; const int r2 = F.lane >> 5, c = F.lane & 31;
    if (t < XT_UP) { const int le = t >> 7, r = t & 127, ks = r >> 4, nb = r & 15, c0 = nb * 128; X.N = 2048; X.scale = (le >> 5) ? sc_up1 : sc_up0;
        const int d0 = (c0 < 1024) ? 2 * c0 : 2 * (c0 - 1024) + 128;
        src = A.in[15] + (size_t)le * 1024 * 2048 + (size_t)(ks * 128) * 2048 + c0;
        X.dst = (unsigned char*)(F.ws + WS_UP) + (size_t)le * 2048 * 1024 + (size_t)d0 * 1024 + ks * 128; }
    else { const int tt = t - XT_UP, le = tt >> 6, r = tt & 63, ks = r >> 3, nb = r & 7; X.N = 1024; X.scale = (le >> 5) ? sc_dn1 : sc_dn0;
        src = A.in[17] + (size_t)le * 1024 * 1024 + (size_t)(ks * 128) * 1024 + nb * 128;
        X.dst = (unsigned char*)(F.ws + WS_DN) + (size_t)le * 1024 * 1024 + (size_t)(nb * 128) * 1024 + ks * 128; }
    X.lsrc = src + (size_t)(64 * r2) * X.N + 4 * c;
    return X;
}

__device__ __forceinline__ float sample_scale(const float* w, int lane) {
    float a = 0.f;
#pragma unroll 4
    for (int i = 0; i < 16; ++i) { const f32x4 v = *(const GAS f32x4*)(w + 4 * lane + 256 * i); a = fmaxf(a, fmaxf(fmaxf(fabsf(v[0]), fabsf(v[1])), fmaxf(fabsf(v[2]), fabsf(v[3])))); }
    a = wave_max(a); return (a > 0.f) ? ldexpf(1.0f, 4 - ilogbf(a)) : 1.0f;
}
constexpr int NSMALL = (I_PW1 + I_PW2) / Q_CHUNK;
#ifndef MK_XT_DEFER
#define MK_XT_DEFER 4800
#endif
constexpr int XT_DEFER = MK_XT_DEFER;
static_assert(XT_DEFER >= 0 && XT_DEFER <= 6144, "only layer-1 tasks can be deferred");
static_assert(MK_P0_ITEMS == 0 && (I_PW1 + I_PW2) % Q_CHUNK == 0, "queue layout");
__device__ __forceinline__ void convert_queue(Frame& F, const Args& A, int qword, int qbase, int QEND) {
    unsigned* qhead = (unsigned*)(F.ws + WS_CTL) + CW_QUEUE + 16 * qword;
    float wsc[4];
#pragma unroll
    for (int i = 0; i < 4; ++i) wsc[i] = ((const float*)(F.ws + WS_WSC))[i];
    int pos;
    for (;;) { unsigned pos_ = 0u; if (F.lane == 0) pos_ = __hip_atomic_fetch_add(qhead, 1u, __ATOMIC_RELAXED, __HIP_MEMORY_SCOPE_AGENT);
        pos = qbase + (int)__builtin_amdgcn_readfirstlane(pos_); if (pos >= NSMALL || pos >= QEND) break;
        convert_items(F, A, I_EARLY + pos * Q_CHUNK, I_EARLY + (pos + 1) * Q_CHUNK, 0, 1, wsc); }
    if (pos >= QEND) return;
    const int lane = F.lane, r2 = lane >> 5, c = lane & 31;
    LAS unsigned char* tile = F.lds + F.wave * 17408;
    f32x4 va[16], vb[16];
#define XT_LOAD(v_, X_, st_) do { _Pragma("unroll") for (int i_ = 0; i_ < 16; ++i_) v_[i_] = __builtin_nontemporal_load((const GAS f32x4*)(X_.lsrc + (size_t)((st_) * 16 + i_) * X_.N)); } while (0)
#define XT_PUT(v_, X_, st_) do { const float sc_ = X_.scale; _Pragma("unroll") for (int j_ = 0; j_ < 4; ++j_) { v4u o_; \
        o_.x = pk4_fp8(v_[0][j_] * sc_, v_[1][j_] * sc_, v_[2][j_] * sc_, v_[3][j_] * sc_); o_.y = pk4_fp8(v_[4][j_] * sc_, v_[5][j_] * sc_, v_[6][j_] * sc_, v_[7][j_] * sc_); \
        o_.z = pk4_fp8(v_[8][j_] * sc_, v_[9][j_] * sc_, v_[10][j_] * sc_, v_[11][j_] * sc_); o_.w = pk4_fp8(v_[12][j_] * sc_, v_[13][j_] * sc_, v_[14][j_] * sc_, v_[15][j_] * sc_); \
        *(LAS v4u*)(tile + (4 * c + j_) * 128 + (((4 * r2 + (st_)) ^ (c & 7)) << 4)) = o_; } } while (0)
    XTask cur = xt_setup(F, A, xt_task(pos - NSMALL), wsc[0], wsc[1], wsc[2], wsc[3]);
    XT_LOAD(va, cur, 0); XT_LOAD(vb, cur, 1);
    for (;;) {
        unsigned np_ = (unsigned)QEND; if (lane == 0) np_ = (unsigned)qbase + __hip_atomic_fetch_add(qhead, 1u, __ATOMIC_RELAXED, __HIP_MEMORY_SCOPE_AGENT);
        XT_PUT(va, cur, 0); XT_LOAD(va, cur, 2); XT_PUT(vb, cur, 1); XT_LOAD(vb, cur, 3); XT_PUT(va, cur, 2); XT_PUT(vb, cur, 3);
        const int npos = (int)__builtin_amdgcn_readfirstlane(np_); const bool has_next = npos < QEND;
        XTask nxt = cur;
        if (has_next) { nxt = xt_setup(F, A, xt_task(npos - NSMALL), wsc[0], wsc[1], wsc[2], wsc[3]); XT_LOAD(va, nxt, 0); XT_LOAD(vb, nxt, 1); }
        LDS_WAIT(); asm volatile("" ::: "memory");
#pragma unroll
        for (int i = 0; i < 16; ++i) { const int n = 8 * i + (lane >> 3), ch = lane & 7;
            const v4u w_ = *(const LAS v4u*)(tile + n * 128 + ((ch ^ ((n >> 2) & 7)) << 4));
            __builtin_nontemporal_store(w_, (GAS v4u*)(cur.dst + (size_t)n * 1024 + ch * 16)); }
        LDS_WAIT(); asm volatile("" ::: "memory");
        if (!has_next) break;
        cur = nxt; pos = npos;
    }
#undef XT_LOAD
#undef XT_PUT
}
__device__ __forceinline__ void p0_prologue(Frame& F, const Args& A) {
    const int gw = F.vcu * NWAVES + F.wave, NGW = F.G * NWAVES;
    for (int le = gw; le < 64; le += NGW) { const int l = le >> 5, e = le & 31; const float* rw = A.in[13] + (size_t)l * 1024 * 32; const float* lg = A.in[19] + (size_t)(l * 2) * D; const float* lb = A.in[20] + (size_t)(l * 2) * D;
        bf16* RWH = (bf16*)(F.ws + WS_RWH) + (size_t)le * 1024; bf16* RWL = (bf16*)(F.ws + WS_RWL) + (size_t)le * 1024; float sG = 0.f, sB = 0.f;
        for (int i = 0; i < 16; ++i) { const int d = F.lane + 64 * i; const float w0 = rw[d * 32 + e]; const float wv = lg[d] * w0; const unsigned hi = f2bf(wv); const unsigned lo = f2bf(wv - bf1((unsigned short)hi));
            RWH[d] = (unsigned short)hi; RWL[d] = (unsigned short)lo; sG += wv; sB += lb[d] * w0; }
        sG = wave_sum(sG); sB = wave_sum(sB);
        if (F.lane == 0) { float* RGB = (float*)(F.ws + WS_RGB); RGB[l * 64 + e] = sG; RGB[l * 64 + 32 + e] = sB + A.in[14][l * 32 + e]; } }
    static_assert(MK_P0_ITEMS <= I_PW1 + I_PW2 + 32 * 1024, "P0 may only convert layer-0 up-projection weights among the expert weights");
    if (gw >= 64 && gw < 68) { const int l = (gw - 64) >> 1, dn = (gw - 64) & 1; const float sc = sample_scale(dn ? A.in[17] + (size_t)l * 32 * 1024 * 1024 : A.in[15] + (size_t)l * 32 * 1024 * 2048, F.lane);
        if (F.lane == 0) ((float*)(F.ws + WS_WSC))[l * 2 + dn] = sc; }
    { const float w0s = sample_scale(A.in[15], F.lane); const float wsc[4] = {w0s, 0.f, 0.f, 0.f};
      convert_items(F, A, 0, I_P0, gw, NGW, wsc); }
    __syncthreads();
    LAS float* Wg = (LAS float*)F.lds;
    for (int idx = F.tid; idx < 8192; idx += NWAVES * 64) { const int k = idx >> 3, g = idx & 7; Wg[g * 1024 + k] = A.in[1][(size_t)k * 3080 + 1536 + g]; }
    __syncthreads();
    bf16* XB = (bf16*)(F.ws + WS_ABF); float* GATES = (float*)(F.ws + WS_GATES);
    const float bias_l = F.lane < 4 ? A.in[2][F.lane & 3] : A.in[3][F.lane & 3];
    f32x4 vn[4];
    if (gw < T) { const GAS f32x4* xr = (const GAS f32x4*)(A.in[0] + (size_t)gw * D) + F.lane;
#pragma unroll
        for (int j = 0; j < 4; ++j) vn[j] = xr[64 * j]; }
    for (int m = gw; m < T; m += NGW) {
        f32x4 v[4];
#pragma unroll
        for (int j = 0; j < 4; ++j) v[j] = vn[j];
        if (m + NGW < T) { const GAS f32x4* xr = (const GAS f32x4*)(A.in[0] + (size_t)(m + NGW) * D) + F.lane;
#pragma unroll
            for (int j = 0; j < 4; ++j) vn[j] = xr[64 * j]; }
        GAS v2u* o8 = (GAS v2u*)(XB + (size_t)m * D) + F.lane;
#pragma unroll
        for (int j = 0; j < 4; ++j) { v2u w; w.x = cvt_pk_bf16(v[j][0], v[j][1]); w.y = cvt_pk_bf16(v[j][2], v[j][3]); o8[64 * j] = w; }
        float mine = 0.f;
#pragma unroll
        for (int g = 0; g < 8; ++g) { float s = 0.f;
#pragma unroll
            for (int j = 0; j < 4; ++j) { const f32x4 w = *(const LAS f32x4*)(Wg + g * 1024 + 4 * F.lane + 256 * j); s += (v[j][0] * w[0] + v[j][1] * w[1]) + (v[j][2] * w[2] + v[j][3] * w[3]); }
            s = wave_sum(s); mine = (F.lane == g) ? s : mine; }
        if (F.lane < 8) { float val = mine + bias_l; if (F.lane >= 4) val = fminf(val, 0.f) - log1pf(__expf(-fabsf(val))); GATES[(size_t)m * 8 + F.lane] = val; }
    }
}

#define DPPF(old_, src_, ctrl_, rmask_) __builtin_bit_cast(float, __builtin_amdgcn_update_dpp(__builtin_bit_cast(int, (float)(old_)), __builtin_bit_cast(int, (float)(src_)), (ctrl_), (rmask_), 0xf, false))
__device__ __forceinline__ float row16_sum(float x) { x += DPPF(0.f, x, 0x128, 0xf); x += DPPF(0.f, x, 0x124, 0xf); x += DPPF(0.f, x, 0x122, 0xf); x += DPPF(0.f, x, 0x121, 0xf); return x; }
__device__ __forceinline__ float scan_add64(float x) { x += DPPF(0.f, x, 0x111, 0xf); x += DPPF(0.f, x, 0x112, 0xf); x += DPPF(0.f, x, 0x114, 0xf); x += DPPF(0.f, x, 0x118, 0xf);
    x += DPPF(0.f, x, 0x142, 0xa); x += DPPF(0.f, x, 0x143, 0xc); return x; }
__device__ __forceinline__ float scan_max64(float x) { const float ni = -INFINITY;
    x = fmaxf(x, DPPF(ni, x, 0x111, 0xf)); x = fmaxf(x, DPPF(ni, x, 0x112, 0xf)); x = fmaxf(x, DPPF(ni, x, 0x114, 0xf)); x = fmaxf(x, DPPF(ni, x, 0x118, 0xf));
    x = fmaxf(x, DPPF(ni, x, 0x142, 0xa)); x = fmaxf(x, DPPF(ni, x, 0x143, 0xc)); return x; }
__device__ __forceinline__ float lane63(float x) { return __builtin_bit_cast(float, __builtin_amdgcn_readlane(__builtin_bit_cast(int, x), 63)); }
typedef short v4i16 __attribute__((ext_vector_type(4)));
__device__ __forceinline__ bf16x8 tr_frag(const LAS unsigned char* base, int pitch, int k0, int col0, int fr) {
    const LAS unsigned char* a = base + (k0 + (fr >> 2)) * pitch + (col0 + 4 * (fr & 3)) * 2;
    const v4i16 lo = __builtin_amdgcn_ds_read_tr16_b64_v4i16((LAS v4i16*)a), hi = __builtin_amdgcn_ds_read_tr16_b64_v4i16((LAS v4i16*)(a + 4 * pitch));
    return __builtin_shufflevector(lo, hi, 0, 1, 2, 3, 4, 5, 6, 7);
}
__device__ __forceinline__ int swz16(int r, int c) { return r * 144 + ((((c >> 3) ^ ((r >> 3) & 7))) << 4) + (c & 7) * 2; }
__device__ __forceinline__ void mlstm_item(Frame& F, const Args& A, int item2) {
    const int item = item2 >> 1, T0 = 32 * (item2 & 1);
    const int b = item >> 2, h = item & 3, tid = F.tid, lane = F.lane, w = F.wave;
    LAS unsigned char* L = F.lds;
    constexpr int P = 144, PO = 272;
    constexpr int QS = 0, KS = QS + 64 * P, VT = KS + 64 * P, KW = VT + 64 * PO, CT = KW + 64 * P, SS = CT + 64 * PO, OS = SS + 64 * P, HS = OS + 64 * PO, FA = HS + 64 * PO;
    LAS float* fa = (LAS float*)(L + FA);
    constexpr int BV = 0, UV = 64, MT = 128, WI = 192, WL = 256, EI = 320, NP = 384, QNP = 448, RS = 960, HSUM = 1216, HSQ = 1344, SCAL = 1472;
    static_assert(FA + 1480 * 4 <= RING_BYTES, "mlstm LDS");
    const bf16* Z = (const bf16*)(F.ws + WS_Z); const float* GATES = (const float*)(F.ws + WS_GATES); bf16* HCAT = (bf16*)(F.ws + WS_HCAT);
    int fr_ = lane & 15, fq_ = lane >> 4; const int fr = lane & 15;
    for (int i = tid; i < 64 * PO / 4; i += 512) ((LAS unsigned*)(L + CT))[i] = 0u;
    if (tid < 64) fa[NP + tid] = 0.f;
    f32x4 accC[4];
#pragma unroll
    for (int j = 0; j < 4; ++j) accC[j] = (f32x4){0.f, 0.f, 0.f, 0.f};
    float m_prev = 0.f;
    float gain[2];
#pragma unroll
    for (int j = 0; j < 2; ++j) gain[j] = A.in[5][h * 128 + 16 * ((w >> 1) * 2 + j) + fr];
    int srow_ = tid >> 3, spc_ = tid & 7;
    int vrow0_ = tid >> 4, vpc_ = tid & 15;
    const int srow = tid >> 3, spc = tid & 7, vrow0 = tid >> 4, vpc = tid & 15;
    struct StageRegs { v4u q, k, v[2], o; float ig, lf; };
    StageRegs sA, sB; sA.ig = sA.lf = sB.ig = sB.lf = 0.f; sA.q = sB.q = (v4u){0u, 0u, 0u, 0u};
    const size_t zb = (size_t)(b * SEQ) * NZ;
#define MLSTM_LOAD(RS, c) do { const size_t t0 = (size_t)(c) * 64; \
        if (tid < 256) RS.q = *(const GAS v4u*)(Z + zb + (t0 + T0 + srow) * NZ + ZQ + h * 64 + spc * 8); \
        RS.k = *(const GAS v4u*)(Z + zb + (t0 + srow) * NZ + ZK + h * 64 + spc * 8); \
        _Pragma("unroll") for (int i = 0; i < 2; ++i) RS.v[i] = *(const GAS v4u*)(Z + zb + (t0 + vrow0 + 32 * i) * NZ + ZV + h * 128 + vpc * 8); \
        RS.o = *(const GAS v4u*)(Z + zb + (t0 + T0 + vrow0) * NZ + ZO + h * 128 + vpc * 8); \
        if (tid < 64) { RS.ig = GATES[((size_t)(b * SEQ) + t0 + tid) * 8 + h]; RS.lf = GATES[((size_t)(b * SEQ) + t0 + tid) * 8 + 4 + h]; } } while (0)
#define MLSTM_SCALARS(RS) do { if (w == 0) { \
            const float bcum = scan_add64(RS.lf); \
            const float g_ = lane63(bcum); const float u_ = RS.ig - bcum; const float cm = scan_max64(u_); \
            const float a_ = g_ + u_, amax = lane63(scan_max64(a_)); const float m_new = fmaxf(g_ + m_prev, amax); const float mt_ = bcum + fmaxf(m_prev, cm); \
            fa[BV + lane] = bcum; fa[UV + lane] = u_; fa[MT + lane] = mt_; fa[WI + lane] = __expf(bcum + m_prev - mt_); fa[WL + lane] = __expf(a_ - m_new); fa[EI + lane] = __expf(-mt_); \
            if (lane == 0) fa[SCAL] = __expf(g_ + m_prev - m_new); \
            m_prev = m_new; } } while (0)
    MLSTM_LOAD(sA, 0); MLSTM_LOAD(sB, 1);
    MLSTM_SCALARS(sA);
    __syncthreads();
    auto chunk = [&](StageRegs& RSC, StageRegs& RSN, const int cc) __attribute__((always_inline)) {
        asm volatile("" : "+v"(fr_), "+v"(fq_), "+v"(srow_), "+v"(spc_), "+v"(vrow0_), "+v"(vpc_));
        const int fr = fr_, fq = fq_, srow = srow_, spc = spc_, vrow0 = vrow0_, vpc = vpc_;
        if (tid < 256) *(LAS v4u*)(L + QS + srow * P + spc * 16) = RSC.q;
        *(LAS v4u*)(L + KS + srow * P + spc * 16) = RSC.k;
        *(LAS v4u*)(L + OS + vrow0 * PO + vpc * 16) = RSC.o;
#pragma unroll
        for (int i = 0; i < 2; ++i) *(LAS v4u*)(L + VT + (vrow0 + 32 * i) * PO + vpc * 16) = RSC.v[i];
        if (cc + 2 < 32) MLSTM_LOAD(RSC, cc + 2);
        LBAR();
        { const v4u kk = *(const LAS v4u*)(L + KS + srow * P + spc * 16); const float wl = fa[WL + srow]; v4u kw;
          kw.x = cvt_pk_bf16(bflo(kk.x) * wl, bfhi(kk.x) * wl); kw.y = cvt_pk_bf16(bflo(kk.y) * wl, bfhi(kk.y) * wl); kw.z = cvt_pk_bf16(bflo(kk.z) * wl, bfhi(kk.z) * wl); kw.w = cvt_pk_bf16(bflo(kk.w) * wl, bfhi(kk.w) * wl);
          *(LAS v4u*)(L + KW + srow * P + spc * 16) = kw; }
        { const int tr = w >> 2, tc = w & 3; f32x4 acc = (f32x4){0.f, 0.f, 0.f, 0.f};
#pragma unroll
          for (int ks = 0; ks < 2; ++ks) { const bf16x8 qa = *(const LAS bf16x8*)(L + QS + (16 * tr + fr) * P + ks * 64 + fq * 16); const bf16x8 kb = *(const LAS bf16x8*)(L + KS + (16 * tc + fr) * P + ks * 64 + fq * 16);
              acc = __builtin_amdgcn_mfma_f32_16x16x32_bf16(qa, kb, acc, 0, 0, 0); }
          const int s = 16 * tc + fr; const float us = fa[UV + s]; float rs[4];
#pragma unroll
          for (int r = 0; r < 4; ++r) { const int tl = 16 * tr + 4 * fq + r, t = T0 + tl; const float wgt = (s <= t) ? __expf(fa[BV + t] - fa[MT + t] + us) : 0.f; const float val = acc[r] * wgt;
              *(LAS unsigned short*)(L + SS + tl * P + s * 2) = (unsigned short)f2bf(val); rs[r] = val; }
#pragma unroll
          for (int r = 0; r < 4; ++r) rs[r] = row16_sum(rs[r]);
          if (fr == 0) {
#pragma unroll
              for (int r = 0; r < 4; ++r) fa[RS + tc * 64 + 16 * tr + 4 * fq + r] = rs[r]; } }
        if (tid < 256) { const int t = tid & 31, p = tid >> 5; const v4u qq = *(const LAS v4u*)(L + QS + t * P + p * 16); const unsigned ww[4] = {qq.x, qq.y, qq.z, qq.w}; float s = 0.f;
#pragma unroll
          for (int e = 0; e < 8; ++e) s += ((e & 1) ? bfhi(ww[e >> 1]) : bflo(ww[e >> 1])) * fa[NP + 8 * p + e];
          fa[QNP + p * 64 + t] = s; }
        LBAR();
        const int tr4 = w & 1, hf = w >> 1;
        f32x4 hv[2];
        { f32x4 ai_[2], as_[2];
#pragma unroll
          for (int j = 0; j < 2; ++j) { ai_[j] = (f32x4){0.f, 0.f, 0.f, 0.f}; as_[j] = (f32x4){0.f, 0.f, 0.f, 0.f}; }
#pragma unroll
          for (int ks = 0; ks < 2; ++ks) { const bf16x8 qa = *(const LAS bf16x8*)(L + QS + (16 * tr4 + fr) * P + ks * 64 + fq * 16); const bf16x8 sa = *(const LAS bf16x8*)(L + SS + (16 * tr4 + fr) * P + ks * 64 + fq * 16);
#pragma unroll
            for (int j = 0; j < 2; ++j) { const bf16x8 cb = tr_frag(L + CT, PO, ks * 32 + 8 * fq, 16 * (hf * 2 + j), fr); const bf16x8 vb = tr_frag(L + VT, PO, ks * 32 + 8 * fq, 16 * (hf * 2 + j), fr);
                ai_[j] = __builtin_amdgcn_mfma_f32_16x16x32_bf16(qa, cb, ai_[j], 0, 0, 0); as_[j] = __builtin_amdgcn_mfma_f32_16x16x32_bf16(sa, vb, as_[j], 0, 0, 0); } }
          float s1[4], s2[4];
#pragma unroll
          for (int r = 0; r < 4; ++r) { const int tl = 16 * tr4 + 4 * fq + r, t = T0 + tl; float qn = 0.f;
#pragma unroll
            for (int p = 0; p < 8; ++p) qn += fa[QNP + p * 64 + tl];
            const float wi = fa[WI + t]; const float den = wi * qn + ((fa[RS + tl] + fa[RS + 64 + tl]) + (fa[RS + 128 + tl] + fa[RS + 192 + tl]));
            const float inv = 1.0f / fmaxf(fabsf(den), fa[EI + t]); float a1 = 0.f, a2 = 0.f;
#pragma unroll
            for (int j = 0; j < 2; ++j) { const float x = (wi * ai_[j][r] + as_[j][r]) * inv; hv[j][r] = x; a1 += x; a2 += x * x; }
            s1[r] = a1; s2[r] = a2; }
#pragma unroll
          for (int r = 0; r < 4; ++r) { float x = s1[r], y = s2[r];
            s1[r] = row16_sum(x); s2[r] = row16_sum(y); }
          if (fr == 0) {
#pragma unroll
            for (int r = 0; r < 4; ++r) { fa[HSUM + hf * 32 + 16 * tr4 + 4 * fq + r] = s1[r]; fa[HSQ + hf * 32 + 16 * tr4 + 4 * fq + r] = s2[r]; } } }
        LBAR();
#pragma unroll
        for (int r = 0; r < 4; ++r) { const int tl = 16 * tr4 + 4 * fq + r; const float mean = ((fa[HSUM + tl] + fa[HSUM + 32 + tl]) + (fa[HSUM + 64 + tl] + fa[HSUM + 96 + tl])) * (1.0f / 128.0f);
            const float var = fmaxf(((fa[HSQ + tl] + fa[HSQ + 32 + tl]) + (fa[HSQ + 64 + tl] + fa[HSQ + 96 + tl])) * (1.0f / 128.0f) - mean * mean, 0.f);
            const float rstd = 1.0f / sqrtf(var + HEAD_EPS);
#pragma unroll
            for (int j = 0; j < 2; ++j) { const int dv = 16 * (hf * 2 + j) + fr; const float og = bf1(*(const LAS unsigned short*)(L + OS + tl * PO + dv * 2));
                *(LAS unsigned short*)(L + HS + tl * PO + dv * 2) = (unsigned short)f2bf((hv[j][r] - mean) * rstd * gain[j] * sigmoidf_(og)); } }
        const float decay = fa[SCAL];
#pragma unroll
        for (int j = 0; j < 4; ++j) accC[j] = accC[j] * decay;
#pragma unroll
        for (int ks = 0; ks < 2; ++ks) { const bf16x8 va = tr_frag(L + VT, PO, ks * 32 + 8 * fq, 16 * w, fr);
#pragma unroll
            for (int j = 0; j < 4; ++j) { const bf16x8 kb = tr_frag(L + KW, P, ks * 32 + 8 * fq, 16 * j, fr);
                accC[j] = __builtin_amdgcn_mfma_f32_16x16x32_bf16(va, kb, accC[j], 0, 0, 0); } }
        { const int dk = tid & 63; float s = 0.f;
#pragma unroll
          for (int e = 0; e < 8; ++e) s += fa[WL + 8 * w + e] * bf1(*(const LAS unsigned short*)(L + KS + (8 * w + e) * P + dk * 2));
          fa[QNP + w * 64 + dk] = s; }
        LBAR();
        float nnew = 0.f;
        if (tid < 64) { float s = 0.f;
#pragma unroll
            for (int p = 0; p < 8; ++p) s += fa[QNP + p * 64 + tid];
            nnew = decay * fa[NP + tid] + s; }
#pragma unroll
        for (int j = 0; j < 4; ++j) { v2u cw; cw.x = cvt_pk_bf16(accC[j][0], accC[j][1]); cw.y = cvt_pk_bf16(accC[j][2], accC[j][3]);
            *(LAS v2u*)(L + CT + (16 * j + fr) * PO + (16 * w + 4 * fq) * 2) = cw; }
        if (tid < 64) fa[NP + tid] = nnew;
        { const v4u hh = *(const LAS v4u*)(L + HS + vrow0 * PO + vpc * 16);
          *(GAS v4u*)(HCAT + ((size_t)(b * SEQ) + (size_t)(cc) * 64 + T0 + vrow0) * D + h * 128 + vpc * 8) = hh; }
        if (cc + 1 < 32) MLSTM_SCALARS(RSN);
    };
#pragma nounroll
    for (int c = 0; c < 32; c += 2) { chunk(sA, sB, c); chunk(sB, sA, c + 1); }
#undef MLSTM_LOAD
#undef MLSTM_SCALARS
    __syncthreads();
}
__device__ __forceinline__ void sconv_units(Frame& F, const Args& A, int first, int stride) {
    const bf16* Z = (const bf16*)(F.ws + WS_Z); bf16* HCAT = (bf16*)(F.ws + WS_HCAT);
    const int c0 = F.lane * 8;
    float w0[8], w1[8], w2[8];
#pragma unroll
    for (int e = 0; e < 8; ++e) { w0[e] = A.in[4][c0 + e]; w1[e] = A.in[4][512 + c0 + e]; w2[e] = A.in[4][1024 + c0 + e]; }
    for (int wu = first; wu < T / 32; wu += stride) {
        const int t0 = wu * 32; float p2[8], p1[8];
#pragma unroll
        for (int e = 0; e < 8; ++e) { p2[e] = 0.f; p1[e] = 0.f; }
        if ((t0 & (SEQ - 1)) != 0) {
#pragma unroll
            for (int back = 2; back >= 1; --back) { const v4u a = *(const GAS v4u*)(Z + (size_t)(t0 - back) * NZ + ZSC + c0), x = *(const GAS v4u*)(Z + (size_t)(t0 - back) * NZ + ZSX + c0);
                const unsigned aw[4] = {a.x, a.y, a.z, a.w}, xw[4] = {x.x, x.y, x.z, x.w};
#pragma unroll
                for (int e = 0; e < 8; ++e) { const float pv = ((e & 1) ? bfhi(aw[e >> 1]) : bflo(aw[e >> 1])) * ((e & 1) ? bfhi(xw[e >> 1]) : bflo(xw[e >> 1])); if (back == 2) p2[e] = pv; else p1[e] = pv; } } }
#pragma nounroll
        for (int i0 = 0; i0 < 32; i0 += 4) {
            v4u bq[4], a[4], x[4];
#pragma unroll
            for (int i = 0; i < 4; ++i) { const size_t t = (size_t)(t0 + i0 + i); bq[i] = *(const GAS v4u*)(Z + t * NZ + ZSB + c0); a[i] = *(const GAS v4u*)(Z + t * NZ + ZSC + c0); x[i] = *(const GAS v4u*)(Z + t * NZ + ZSX + c0); }
#pragma unroll
            for (int i = 0; i < 4; ++i) { const size_t t = (size_t)(t0 + i0 + i);
                const unsigned bw[4] = {bq[i].x, bq[i].y, bq[i].z, bq[i].w}, aw[4] = {a[i].x, a[i].y, a[i].z, a[i].w}, xw[4] = {x[i].x, x[i].y, x[i].z, x[i].w}; float y[8];
#pragma unroll
                for (int e = 0; e < 8; ++e) { const float pv = ((e & 1) ? bfhi(aw[e >> 1]) : bflo(aw[e >> 1])) * ((e & 1) ? bfhi(xw[e >> 1]) : bflo(xw[e >> 1]));
                    y[e] = ((e & 1) ? bfhi(bw[e >> 1]) : bflo(bw[e >> 1])) * (w0[e] * p2[e] + w1[e] * p1[e] + w2[e] * pv); p2[e] = p1[e]; p1[e] = pv; }
                v4u o; o.x = cvt_pk_bf16(y[0], y[1]); o.y = cvt_pk_bf16(y[2], y[3]); o.z = cvt_pk_bf16(y[4], y[5]); o.w = cvt_pk_bf16(y[6], y[7]);
                *(GAS v4u*)(HCAT + t * D + 512 + c0) = o; } }
    }
}
__device__ __forceinline__ void p2_mixer_ab(Frame& F, const Args& A) {
    const int nm = F.G < 128 ? F.G : 128; const int bx = (int)blockIdx.x;
    if (F.own) {
        const int x = bx & 7, j = (bx & 127) >> 3;
        if (bx < 128) mlstm_item(F, A, ((((2 * x + (j >> 3)) * 4 + ((j >> 1) & 3)) << 1) | (j & 1)));
        else sconv_units(F, A, 128 * x + j * NWAVES + F.wave, T / 32);
    } else {
    if (bx < nm) { for (int item2 = bx; item2 < 128; item2 += nm) mlstm_item(F, A, item2); }
    if (F.G > nm) { if (bx >= nm) sconv_units(F, A, (bx - nm) * NWAVES + F.wave, (F.G - nm) * NWAVES); }
    else sconv_units(F, A, bx * NWAVES + F.wave, F.G * NWAVES);
    }
    convert_queue(F, A, 0, 0, NSMALL + XT_ALL - (F.own ? XT_DEFER : 0));
}

__device__ __forceinline__ void p_router(Frame& F, const Args& A, int layer) {
    LAS unsigned char* L = F.lds;
    constexpr int PW = 2064, WHO = 0, WLO = 32 * PW, CNTO = 64 * PW;
    static_assert(CNTO + 128 <= LDSCTL_OFF, "router LDS");
    LAS int* cnt = (LAS int*)(L + CNTO);
    const bf16* RWH = (const bf16*)(F.ws + WS_RWH) + (size_t)layer * 32 * 1024; const bf16* RWL = (const bf16*)(F.ws + WS_RWL) + (size_t)layer * 32 * 1024; const float* RGB = (const float*)(F.ws + WS_RGB) + layer * 64;
    __syncthreads();
    for (int i = 0; i < 8; ++i) { const int idx = F.tid + 512 * i, e = idx >> 7, pc = idx & 127;
        *(LAS v4u*)(L + WHO + e * PW + pc * 16) = *(const GAS v4u*)(RWH + e * 1024 + pc * 8); *(LAS v4u*)(L + WLO + e * PW + pc * 16) = *(const GAS v4u*)(RWL + e * 1024 + pc * 8); }
    const int lane = F.lane, n = lane & 15, q = lane >> 4;
    const bf16* R = (const bf16*)(F.ws + WS_R); int* TOPI = (int*)(F.ws + WS_TOPI); float* TOPG = (float*)(F.ws + WS_TOPG); int* CNTT = (int*)(F.ws + WS_CNTT); float* STATS = (float*)(F.ws + WS_STATS);
    for (int tile = F.vcu; tile < T / 128; tile += F.G) {
        const size_t t = (size_t)tile * 128 + F.wave * 16 + n;
        const bf16* rowp = R + t * D + 8 * q;
        v4u h0[8], h1[8];
#pragma unroll
        for (int s = 0; s < 8; ++s) { h0[s] = *(const GAS v4u*)(rowp + 32 * s); h1[s] = *(const GAS v4u*)(rowp + 32 * (8 + s)); }
        __syncthreads();
        if (F.tid < 32) cnt[F.tid] = 0;
        __syncthreads();
        f32x4 acc[2]; acc[0] = (f32x4){0.f, 0.f, 0.f, 0.f}; acc[1] = (f32x4){0.f, 0.f, 0.f, 0.f};
        float s1 = 0.f, s2 = 0.f;
#define RT_STEPS(HB_, s0_) do { _Pragma("unroll") for (int s_ = 0; s_ < 8; ++s_) { const int s = (s0_) + s_; const v4u h = HB_[s_]; \
            const float x0 = bflo(h.x), x1 = bfhi(h.x), x2 = bflo(h.y), x3 = bfhi(h.y), x4 = bflo(h.z), x5 = bfhi(h.z), x6 = bflo(h.w), x7 = bfhi(h.w); \
            s1 += ((x0 + x1) + (x2 + x3)) + ((x4 + x5) + (x6 + x7)); \
            s2 += ((x0 * x0 + x1 * x1) + (x2 * x2 + x3 * x3)) + ((x4 * x4 + x5 * x5) + (x6 * x6 + x7 * x7)); \
            const bf16x8 bh = __builtin_bit_cast(bf16x8, h); \
            _Pragma("unroll") for (int et = 0; et < 2; ++et) { const bf16x8 wh = *(const LAS bf16x8*)(L + WHO + (16 * et + n) * PW + s * 64 + q * 16), wl = *(const LAS bf16x8*)(L + WLO + (16 * et + n) * PW + s * 64 + q * 16); \
                acc[et] = __builtin_amdgcn_mfma_f32_16x16x32_bf16(wh, bh, acc[et], 0, 0, 0); acc[et] = __builtin_amdgcn_mfma_f32_16x16x32_bf16(wl, bh, acc[et], 0, 0, 0); } \
            } } while (0)
        RT_STEPS(h0, 0);
#pragma unroll
        for (int s = 0; s < 8; ++s) h0[s] = *(const GAS v4u*)(rowp + 32 * (16 + s));
        RT_STEPS(h1, 8);
#pragma unroll
        for (int s = 0; s < 8; ++s) h1[s] = *(const GAS v4u*)(rowp + 32 * (24 + s));
        RT_STEPS(h0, 16); RT_STEPS(h1, 24);
#undef RT_STEPS
        float Gv[8], Bv[8];
#pragma unroll
        for (int m = 0; m < 8; ++m) { const int e = 16 * (m >> 2) + 4 * q + (m & 3); Gv[m] = RGB[e]; Bv[m] = RGB[32 + e]; }
        s1 += __shfl_xor(s1, 16); s1 += __shfl_xor(s1, 32); s2 += __shfl_xor(s2, 16); s2 += __shfl_xor(s2, 32);
        const float mean = s1 * (1.0f / D), var = fmaxf(s2 * (1.0f / D) - mean * mean, 0.f), rstd = 1.0f / sqrtf(var + LN_EPS);
        float val[8];
#pragma unroll
        for (int m = 0; m < 8; ++m) val[m] = rstd * (acc[m >> 2][m & 3] - mean * Gv[m]) + Bv[m];
        float tv[4]; int ti[4];
#pragma unroll
        for (int k = 0; k < 4; ++k) { float bv = val[0]; int bi = 4 * q;
#pragma unroll
            for (int m = 1; m < 8; ++m) { const int e = 16 * (m >> 2) + 4 * q + (m & 3); if (val[m] > bv) { bv = val[m]; bi = e; } }
#pragma unroll
            for (int o = 16; o < 64; o <<= 1) { const float ov = __shfl_xor(bv, o); const int oi = __shfl_xor(bi, o); const bool take = (ov > bv) || (ov == bv && oi < bi); bv = take ? ov : bv; bi = take ? oi : bi; }
            tv[k] = bv; ti[k] = bi;
#pragma unroll
            for (int m = 0; m < 8; ++m) { const int e = 16 * (m >> 2) + 4 * q + (m & 3); if (e == bi) val[m] = -INFINITY; } }
        const float e1 = __expf(tv[1] - tv[0]), e2 = __expf(tv[2] - tv[0]), e3 = __expf(tv[3] - tv[0]); const float inv = 1.0f / (1.0f + e1 + e2 + e3);
        if (q == 0) { *(GAS i32x4*)(TOPI + t * 4) = (i32x4){ti[0], ti[1], ti[2], ti[3]}; *(GAS f32x4*)(TOPG + t * 4) = (f32x4){inv, e1 * inv, e2 * inv, e3 * inv}; *(GAS f32x2*)(STATS + t * 2) = (f32x2){mean, rstd};
            __hip_atomic_fetch_add(&cnt[ti[0]], 1, __ATOMIC_RELAXED, __HIP_MEMORY_SCOPE_WORKGROUP); __hip_atomic_fetch_add(&cnt[ti[1]], 1, __ATOMIC_RELAXED, __HIP_MEMORY_SCOPE_WORKGROUP);
            __hip_atomic_fetch_add(&cnt[ti[2]], 1, __ATOMIC_RELAXED, __HIP_MEMORY_SCOPE_WORKGROUP); __hip_atomic_fetch_add(&cnt[ti[3]], 1, __ATOMIC_RELAXED, __HIP_MEMORY_SCOPE_WORKGROUP); }
        __syncthreads();
        if (F.tid < 32) CNTT[tile * 32 + F.tid] = cnt[F.tid];
    }
    __syncthreads();
}

__device__ __forceinline__ void p_slots(Frame& F, const Args& A, int layer) {
    LAS int* li = (LAS int*)F.lds;
    LAS int* redA = li;
    LAS int* redP = li + 512;
    LAS int* tot = li + 1024;
    LAS int* pre = li + 1056;
    LAS int* base = li + 1088;
    LAS int* wcn = li + 1152;
    const int* CNTT = (const int*)(F.ws + WS_CNTT); const int* TOPI = (const int*)(F.ws + WS_TOPI); int* SLOT = (int*)(F.ws + WS_SLOT); int* META = (int*)(F.ws + WS_META);
    const bf16* R = (const bf16*)(F.ws + WS_R); const float* STATS = (const float*)(F.ws + WS_STATS); unsigned char* X1B = (unsigned char*)(F.ws + WS_X1B); int* ROWTOK = (int*)(F.ws + WS_ROWTOK);
    const float* lg = A.in[19] + (size_t)(layer * 2) * D; const float* lb = A.in[20] + (size_t)(layer * 2) * D;
    f32x4 g4[4], b4[4];
#pragma unroll
    for (int j = 0; j < 4; ++j) { g4[j] = *(const GAS f32x4*)(lg + 4 * F.lane + 256 * j); b4[j] = *(const GAS f32x4*)(lb + 4 * F.lane + 256 * j); }
    const int tid = F.tid, lane = F.lane, e_ = tid & 31, part = tid >> 5;
    int cv[16];
#pragma unroll
    for (int k = 0; k < 16; ++k) cv[k] = CNTT[(part + 16 * k) * 32 + e_];
    { int sa = 0;
#pragma unroll
      for (int k = 0; k < 16; ++k) sa += cv[k];
      redA[part * 32 + e_] = sa; }
    __syncthreads();
    if (tid < 32) { int s = 0; for (int p = 0; p < 16; ++p) s += redA[p * 32 + tid]; tot[tid] = s; }
    __syncthreads();
    if (tid == 0) { int bsum = 0; for (int e = 0; e < 32; ++e) { base[e] = bsum; bsum += (tot[e] + 255) & ~255; } base[32] = bsum; }
    __syncthreads();
    for (int tile = F.vcu; tile < T / 128; tile += F.G) {
        v2u rw[16][4];
#pragma unroll
        for (int i = 0; i < 16; ++i) { const GAS v2u* rr = (const GAS v2u*)(R + ((size_t)tile * 128 + F.wave * 16 + i) * D) + lane;
#pragma unroll
            for (int j = 0; j < 4; ++j) rw[i][j] = rr[64 * j]; }
        const float mean_l = STATS[((size_t)tile * 128 + F.wave * 16 + (lane & 15)) * 2], rstd_l = STATS[((size_t)tile * 128 + F.wave * 16 + (lane & 15)) * 2 + 1];
        { int sp = 0;
#pragma unroll
          for (int k = 0; k < 16; ++k) sp += (part + 16 * k < tile) ? cv[k] : 0;
          redP[part * 32 + e_] = sp; }
        __syncthreads();
        if (tid < 32) { int s = 0; for (int p = 0; p < 16; ++p) s += redP[p * 32 + tid]; pre[tid] = s; }
        const int tok = tile * 128 + (tid >> 2); const int e = TOPI[(size_t)tile * 512 + tid];
        int rank = 0;
        for (int ee = 0; ee < 32; ++ee) { const unsigned long long mask = __ballot(e == ee); if (e == ee) rank = __builtin_amdgcn_mbcnt_hi((unsigned)(mask >> 32), __builtin_amdgcn_mbcnt_lo((unsigned)mask, 0u)); if (lane == 0) wcn[F.wave * 32 + ee] = __popcll(mask); }
        __syncthreads();
        for (int ww = 0; ww < F.wave; ++ww) rank += wcn[ww * 32 + e];
        const int slot = base[e] + pre[e] + rank;
        SLOT[(size_t)tile * 512 + tid] = slot; ROWTOK[slot] = tok;
#pragma unroll
        for (int i = 0; i < 16; ++i) { const size_t tk = (size_t)tile * 128 + F.wave * 16 + i;
            const float mean = __builtin_bit_cast(float, __builtin_amdgcn_readlane(__builtin_bit_cast(int, mean_l), i)), rstd = __builtin_bit_cast(float, __builtin_amdgcn_readlane(__builtin_bit_cast(int, rstd_l), i));
            GAS unsigned* dst = (GAS unsigned*)(X1B + tk * D) + lane;
#pragma unroll
            for (int j = 0; j < 4; ++j) { const v2u r2 = rw[i][j]; const f32x4 y = ((f32x4){bflo(r2.x), bfhi(r2.x), bflo(r2.y), bfhi(r2.y)} - mean) * rstd * g4[j] + b4[j]; dst[64 * j] = pk4_fp8(y[0], y[1], y[2], y[3]); } }
        __syncthreads();
    }
    for (int e = F.vcu; e < 32; e += F.G) { const int r0 = base[e] + tot[e], r1 = base[e + 1]; for (int i = r0 + tid; i < r1; i += 512) ROWTOK[i] = 0; }
    if (F.vcu == 0) { const int nMt = base[32] >> 8; if (tid == 0) META[0] = nMt;
        for (int gm = tid; gm < nMt; gm += 512) { int e = 0; for (int q = 0; q < 32; ++q) if (base[q] <= gm * 256 && gm * 256 < base[q + 1]) e = q; META[16 + gm] = e; } }
    __syncthreads();
}
__device__ __forceinline__ int load_texp(Frame& F) {
    const int* META = (const int*)(F.ws + WS_META); LAS int* texp = (LAS int*)(F.lds + TEXP_OFF);
    const int nMt = __builtin_amdgcn_readfirstlane(*(const GAS int*)META);
    for (int i = F.tid; i < 1024; i += 512) texp[i] = (i < nMt) ? *(const GAS int*)(META + 16 + i) : 0;
    __syncthreads();
    return nMt;
}
template <class Sched> __device__ __forceinline__ void load_rowtab(Frame& F, const Sched& S) {
    const int* ROWTOK = (const int*)(F.ws + WS_ROWTOK); LAS unsigned short* tab = (LAS unsigned short*)(F.lds + ROWTAB_OFF);
    const int half = F.tid >> 8, r = F.tid & 255; int val[10];
#pragma unroll
    for (int j = 0; j < 10; ++j) { pg8::Unit u; const bool ok = S.next(2 * j + half, u); val[j] = ok ? *(const GAS int*)(ROWTOK + u.pm * 256 + r) : 0; }
#pragma unroll
    for (int j = 0; j < 10; ++j) tab[(2 * j + half) * 256 + r] = (unsigned short)val[j];
    __syncthreads();
}

__device__ __forceinline__ void p_combine(Frame& F, const Args& A, int layer) {
    const bf16* R = (const bf16*)(F.ws + WS_R); const float* STATS = (const float*)(F.ws + WS_STATS); const unsigned char* YS = (const unsigned char*)(F.ws + WS_YS); const int* SLOT = (const int*)(F.ws + WS_SLOT); const float* TOPG = (const float*)(F.ws + WS_TOPG);
    bf16* OB = (bf16*)(F.ws + WS_ABF);
    const float* lg = A.in[19] + (size_t)(layer * 2 + 1) * D; const float* lb = A.in[20] + (size_t)(layer * 2 + 1) * D;
    const float* lg0 = A.in[19] + (size_t)(layer * 2) * D; const float* lb0 = A.in[20] + (size_t)(layer * 2) * D;
    const int lane = F.lane; f32x4 g4[4], b4[4], g0[4], b0[4];
#pragma unroll
    for (int j = 0; j < 4; ++j) { g4[j] = *(const GAS f32x4*)(lg + 4 * lane + 256 * j); b4[j] = *(const GAS f32x4*)(lb + 4 * lane + 256 * j); g0[j] = *(const GAS f32x4*)(lg0 + 4 * lane + 256 * j) * ALPHA; b0[j] = *(const GAS f32x4*)(lb0 + 4 * lane + 256 * j) * ALPHA; }
    const int gw = F.vcu * NWAVES + F.wave, NGW = F.G * NWAVES;
    struct CMeta { i32x4 sl; f32x4 gt; f32x2 st; };
    struct CData { unsigned yw[4][4]; v2u xr[4]; f32x4 gt; f32x2 st; };
#define CMB_META(M_, t_) do { M_.st = *(const GAS f32x2*)(STATS + (size_t)(t_) * 2); M_.sl = *(const GAS i32x4*)(SLOT + (size_t)(t_) * 4); M_.gt = *(const GAS f32x4*)(TOPG + (size_t)(t_) * 4); } while (0)
#define CMB_DATA(D_, M_, t_) do { const int sls_[4] = {M_.sl[0], M_.sl[1], M_.sl[2], M_.sl[3]}; D_.gt = M_.gt * (1.0f / 16.0f); D_.st = M_.st;     \
        _Pragma("unroll") for (int k = 0; k < 4; ++k) { const GAS unsigned* yr = (const GAS unsigned*)(YS + (size_t)sls_[k] * D) + lane; _Pragma("unroll") for (int j = 0; j < 4; ++j) D_.yw[k][j] = yr[64 * j]; } \
        { const GAS v2u* xr_ = (const GAS v2u*)(R + (size_t)(t_) * D) + lane; _Pragma("unroll") for (int j = 0; j < 4; ++j) D_.xr[j] = xr_[64 * j]; } } while (0)
#define CMB_COMPUTE(D_, t_) do { f32x4 v[4]; \
        _Pragma("unroll") for (int j = 0; j < 4; ++j) { const v2u rw = D_.xr[j]; v[j] = ((f32x4){bflo(rw.x), bfhi(rw.x), bflo(rw.y), bfhi(rw.y)} - D_.st[0]) * D_.st[1] * g0[j] + b0[j]; } \
        _Pragma("unroll") for (int k = 0; k < 4; ++k) { const float gk = D_.gt[k]; \
            _Pragma("unroll") for (int j = 0; j < 4; ++j) { const f32x2 lo = __builtin_amdgcn_cvt_pk_f32_fp8((int)D_.yw[k][j], false), hi = __builtin_amdgcn_cvt_pk_f32_fp8((int)D_.yw[k][j], true); \
                v[j][0] += gk * lo[0]; v[j][1] += gk * lo[1]; v[j][2] += gk * hi[0]; v[j][3] += gk * hi[1]; } } \
        float s = 0.f; \
        _Pragma("unroll") for (int j = 0; j < 4; ++j) s += (v[j][0] + v[j][1]) + (v[j][2] + v[j][3]); \
        const float mean = wave_sum(s) * (1.0f / D); float s2 = 0.f; \
        _Pragma("unroll") for (int j = 0; j < 4; ++j) { v[j] = v[j] - mean; s2 += (v[j][0] * v[j][0] + v[j][1] * v[j][1]) + (v[j][2] * v[j][2] + v[j][3] * v[j][3]); } \
        const float rstd = 1.0f / sqrtf(wave_sum(s2) * (1.0f / D) + LN_EPS); \
        if (layer == 0) { GAS v2u* xb = (GAS v2u*)(OB + (size_t)(t_) * D) + lane; \
            _Pragma("unroll") for (int j = 0; j < 4; ++j) { v[j] = v[j] * rstd * g4[j] + b4[j]; v2u wv; wv.x = cvt_pk_bf16(v[j][0], v[j][1]); wv.y = cvt_pk_bf16(v[j][2], v[j][3]); xb[64 * j] = wv; } } \
        else { GAS f32x4* xo = (GAS f32x4*)(A.out + (size_t)(t_) * D) + lane; \
            _Pragma("unroll") for (int j = 0; j < 4; ++j) { v[j] = v[j] * rstd * g4[j] + b4[j]; xo[64 * j] = v[j]; } } } while (0)
    const int tb = F.own ? 128 * F.vcu + 16 * F.wave : gw, ts = F.own ? 1 : NGW, tn = F.own ? 16 : (gw < T ? (T - 1 - gw) / NGW + 1 : 0);
    if (tn > 0) {
        CMeta m; CData dA, dB;
        CMB_META(m, tb); CMB_DATA(dA, m, tb);
        if (1 < tn) CMB_META(m, tb + ts);
        for (int i = 0; i < tn; i += 2) {
            const int t = tb + ts * i, t1 = t + ts, t2 = t + 2 * ts, t3 = t + 3 * ts;
            if (i + 1 < tn) { CMB_DATA(dB, m, t1); if (i + 2 < tn) CMB_META(m, t2); }
            CMB_COMPUTE(dA, t);
            if (i + 1 < tn) {
                if (i + 2 < tn) { CMB_DATA(dA, m, t2); if (i + 3 < tn) CMB_META(m, t3); }
                CMB_COMPUTE(dB, t1); }
        }
    }
#undef CMB_META
#undef CMB_DATA
#undef CMB_COMPUTE
}

__device__ __forceinline__ void p_conv31(Frame& F, const Args& A) {
    const bf16* U = (const bf16*)(F.ws + WS_U); bf16* V = (bf16*)(F.ws + WS_V);
    LAS unsigned char* L = F.lds;
    constexpr int RED = 62 * 2048, STAT = RED + 8 * 32 * 4;
    static_assert(STAT + 128 <= RING_BYTES, "conv31 LDS");
    LAS float* red = (LAS float*)(L + RED); LAS float* stat = (LAS float*)(L + STAT);
    const int tid = F.tid, lane = F.lane, ch = 2 * tid;
    f32x2 wt[31];
#pragma unroll
    for (int j = 0; j < 31; ++j) wt[j] = *(const GAS f32x2*)(A.in[8] + j * 1024 + ch);
    const f32x2 bdw = *(const GAS f32x2*)(A.in[9] + ch), lg = *(const GAS f32x2*)(A.in[10] + ch), lb = *(const GAS f32x2*)(A.in[11] + ch);
    v4u pre[16];
#define CONV_LOAD(unit_) do { const int bq_ = (unit_) >> 6, tk0_ = ((unit_) & 63) * 32; _Pragma("unroll") for (int i = 0; i < 16; ++i) { const int idx = tid + 512 * i, r = idx >> 7, pc = idx & 127, tok = tk0_ - 30 + r; \
        pre[i] = (v4u){0u, 0u, 0u, 0u}; if (idx < 62 * 128 && tok >= 0) pre[i] = *(const GAS v4u*)(U + ((size_t)bq_ * SEQ + tok) * D + pc * 8); } } while (0)
    const int u0 = F.own ? 4 * F.vcu : F.vcu, ustep = F.own ? 1 : F.G, uend = F.own ? 4 * F.vcu + 4 : T / 32;
    if (u0 < uend) CONV_LOAD(u0);
    for (int unit = u0; unit < uend; unit += ustep) {
        const int bq = unit >> 6, tok0 = (unit & 63) * 32; const size_t row0 = (size_t)bq * SEQ + tok0;
        __syncthreads();
#pragma unroll
        for (int i = 0; i < 16; ++i) { const int idx = tid + 512 * i; if (idx < 62 * 128) *(LAS v4u*)(L + (idx >> 7) * 2048 + (idx & 127) * 16) = pre[i]; }
        __syncthreads();
        if (unit + ustep < uend) CONV_LOAD(unit + ustep);
#pragma nounroll
        for (int half = 0; half < 2; ++half) {
            const LAS unsigned char* Lh = L + half * 16 * 2048 + tid * 4;
            f32x2 acc[16];
#pragma unroll
            for (int t = 0; t < 16; ++t) acc[t] = bdw;
#pragma unroll
            for (int r = 0; r < 46; ++r) { const unsigned uw = *(const LAS unsigned*)(Lh + r * 2048); const f32x2 uu = (f32x2){bflo(uw), bfhi(uw)};
#pragma unroll
                for (int t = 0; t < 16; ++t) { if (r - t >= 0 && r - t <= 30) acc[t] = acc[t] + wt[r - t] * uu; } }
            float v[32];
#pragma unroll
            for (int t = 0; t < 16; ++t) { v[t] = acc[t][0] + acc[t][1]; v[16 + t] = acc[t][0] * acc[t][0] + acc[t][1] * acc[t][1]; }
#pragma unroll
            for (int e = 0; e < 16; ++e) { const bool hi = (lane & 32) != 0; const float send = hi ? v[e] : v[16 + e], keep = hi ? v[16 + e] : v[e]; v[e] = keep + __shfl_xor(send, 32); }
#pragma unroll
            for (int e = 0; e < 8; ++e) { const bool hi = (lane & 16) != 0; const float send = hi ? v[e] : v[8 + e], keep = hi ? v[8 + e] : v[e]; v[e] = keep + __shfl_xor(send, 16); }
#pragma unroll
            for (int e = 0; e < 4; ++e) { const bool hi = (lane & 8) != 0; const float send = hi ? v[e] : v[4 + e], keep = hi ? v[4 + e] : v[e]; v[e] = keep + __shfl_xor(send, 8); }
#pragma unroll
            for (int e = 0; e < 2; ++e) { const bool hi = (lane & 4) != 0; const float send = hi ? v[e] : v[2 + e], keep = hi ? v[2 + e] : v[e]; v[e] = keep + __shfl_xor(send, 4); }
            { const bool hi = (lane & 2) != 0; const float send = hi ? v[0] : v[1], keep = hi ? v[1] : v[0]; v[0] = keep + __shfl_xor(send, 2); }
            v[0] += __shfl_xor(v[0], 1);
            if ((lane & 1) == 0) red[F.wave * 32 + (lane >> 1)] = v[0];
            LBAR();
            if (tid < 32) { float s = 0.f;
#pragma unroll
                for (int ww = 0; ww < 8; ++ww) s += red[ww * 32 + tid];
                const float other = __shfl_xor(s, 16);
                if (tid < 16) { const float mean = s * (1.0f / D); const float var = fmaxf(other * (1.0f / D) - mean * mean, 0.f); stat[tid] = mean; stat[16 + tid] = 1.0f / sqrtf(var + LN_EPS); } }
            LBAR();
#pragma unroll
            for (int t = 0; t < 16; ++t) { const float mean = stat[t], rstd = stat[16 + t]; const float y0 = (acc[t][0] - mean) * rstd * lg[0] + lb[0], y1 = (acc[t][1] - mean) * rstd * lg[1] + lb[1];
                *(GAS unsigned*)(V + (row0 + half * 16 + t) * D + ch) = cvt_pk_bf16(y0 * sigmoidf_(y0), y1 * sigmoidf_(y1)); }
        }
    }
    __syncthreads();
#undef CONV_LOAD
}

#define RUN_GEMM(EpiT, SchedT, S, E) pg8::gemm_phase<EpiT, SchedT, true>(F.lds, S, E)
#ifndef MK_KIND_MASK
#define MK_KIND_MASK 0x7ff
#endif
#define ON(kind) (((MK_KIND_MASK) >> (kind)) & 1)
#ifndef MK_DUP_MASK
#define MK_DUP_MASK 0
#endif
#define DUP(kind) (((MK_DUP_MASK) >> (kind)) & 1)
#define IN(k) (lo <= (k) && (k) < hi)
#define SEAM(k) do { if (IN(k) && IN((k) + 1)) xcd_barrier(bar); } while (0)
#define SEAM_L(k) do { if (IN(k) && IN((k) + 1)) { if (F.own) xcd_local_barrier(bar, (unsigned*)(F.ws + WS_CTL) + CW_LBAR); else xcd_barrier(bar); } } while (0)

template <int LAYER>
__device__ __forceinline__ void run_layer(Frame& F, const Args& args, const XcdBarrier& bar, int lo, int hi) {
    constexpr int pb = 1 + 8 * LAYER;
    const int c_id = (int)blockIdx.x;
    asm volatile("" : "+v"(F.tid));
    LAS int* texp = (LAS int*)(F.lds + TEXP_OFF);
    if constexpr (LAYER == 0) {
        if (ON(1) && IN(1)) { pg8::Order<false> S; S.init(T / 256, NZ / 256, F.G, c_id); S.A = (const char*)(F.ws + WS_ABF); S.Bt = (const char*)(F.ws + WS_WIN); S.bexp = 0; S.texp = nullptr;
            pg8::EpiZ E{(bf16*)(F.ws + WS_Z), NZ}; RUN_GEMM(pg8::EpiZ, pg8::Order<false>, S, E); } SEAM_L(1);
        if (ON(2) && IN(2)) { { p2_mixer_ab(F, args); } if (DUP(2)) { p2_mixer_ab(F, args); } } SEAM_L(2);
    } else {
        if (ON(3) && IN(9)) { pg8::Order<false> S; S.init(T / 256, 2048 / 256, F.G, c_id); S.A = (const char*)(F.ws + WS_ABF); S.Bt = (const char*)(F.ws + WS_PW1); S.bexp = 0; S.texp = nullptr;
            pg8::EpiGlu E{(bf16*)(F.ws + WS_U)}; RUN_GEMM(pg8::EpiGlu, pg8::Order<false>, S, E); if (DUP(3)) { RUN_GEMM(pg8::EpiGlu, pg8::Order<false>, S, E); } } SEAM_L(9);
        if (ON(4) && IN(10)) { { p_conv31(F, args); } if (DUP(4)) { p_conv31(F, args); } } SEAM_L(10);
    }
    if (ON(5) && IN(pb + 2)) { pg8::Order<false> S; S.init(T / 256, D / 256, F.G, c_id); S.A = (const char*)(F.ws + (LAYER == 0 ? WS_HCAT : WS_V)); S.Bt = (const char*)(F.ws + (LAYER == 0 ? WS_WOUT : WS_PW2)); S.bexp = 0; S.texp = nullptr;
        pg8::EpiRes<true> E{(const void*)(F.ws + WS_ABF), (bf16*)(F.ws + WS_R), ALPHA};
        RUN_GEMM(pg8::EpiRes<true>, pg8::Order<false>, S, E); if (DUP(5)) { RUN_GEMM(pg8::EpiRes<true>, pg8::Order<false>, S, E); } } SEAM_L(pb + 2);
    if (ON(6) && IN(pb + 3)) { { p_router(F, args, LAYER); } if (DUP(6)) { p_router(F, args, LAYER); } } SEAM(pb + 3);
    if (ON(7) && IN(pb + 4)) { { p_slots(F, args, LAYER); } if (DUP(7)) { p_slots(F, args, LAYER); } } SEAM(pb + 4);
    asm volatile("" : "+v"(F.tid));
    if (ON(8) && IN(pb + 5)) { const int nMt = load_texp(F); const float* WSC = (const float*)(F.ws + WS_WSC); unsigned* ctl = (unsigned*)(F.ws + WS_CTL);
        const int GD = (LAYER == 0 && F.own && XT_DEFER > 0) ? F.G / 8 : 0, G1 = F.G - GD;
        const pg8::Hand H{ctl + CW_UPCNT + LAYER * UPCNT_LAYER, ctl + CW_UPTOT + LAYER * 64, (unsigned)F.G};
        if (c_id < G1) {
        pg8::Order<true> S; S.init(nMt, 8, G1, c_id); S.tstep = (size_t)256 * 1024; S.A = (const char*)(F.ws + WS_X1B); S.Bt = (const char*)(F.ws + WS_UP) + (size_t)LAYER * 32 * 2048 * 1024; S.bexp = (size_t)2048 * 1024; S.texp = texp;
        load_rowtab(F, S);
        pg8::EpiSwiglu8 E{(unsigned char*)(F.ws + WS_ACT), args.in[16] + (size_t)LAYER * 32 * 2048, texp, 1.0f / WSC[LAYER * 2]};
        pg8::gemm_phase<pg8::EpiSwiglu8, pg8::Order<true>, true, true, true, 1>(F.lds, S, E, (const LAS unsigned short*)(F.lds + ROWTAB_OFF), H);
        __syncthreads(); if (F.tid == 0) __hip_atomic_fetch_add(H.tot, 1u, __ATOMIC_RELAXED, __HIP_MEMORY_SCOPE_AGENT); }
        else { if (F.tid == 0) __hip_atomic_fetch_add(H.tot, 1u, __ATOMIC_RELAXED, __HIP_MEMORY_SCOPE_AGENT);
            convert_queue(F, args, 1, NSMALL + XT_ALL - XT_DEFER, NSMALL + XT_ALL); __syncthreads(); } }
    if (ON(9) && IN(pb + 6)) { const int nMt = load_texp(F); const float* WSC = (const float*)(F.ws + WS_WSC); unsigned* ctl = (unsigned*)(F.ws + WS_CTL);
        pg8::Order<true> S; S.init(nMt, 4, F.G, c_id); S.tstep = (size_t)256 * 1024; S.A = (const char*)(F.ws + WS_ACT); S.Bt = (const char*)(F.ws + WS_DN) + (size_t)LAYER * 32 * 1024 * 1024; S.bexp = (size_t)1024 * 1024; S.texp = texp;
        pg8::EpiBiasG8 E{(unsigned char*)(F.ws + WS_YS), args.in[18] + (size_t)LAYER * 32 * 1024, texp, 0.25f / WSC[LAYER * 2 + 1]};
        const pg8::Hand H{ctl + CW_UPCNT + LAYER * UPCNT_LAYER, ctl + CW_UPTOT + LAYER * 64, (unsigned)F.G};
        pg8::gemm_phase<pg8::EpiBiasG8, pg8::Order<true>, true, true, false, 2>(F.lds, S, E, nullptr, H); } SEAM(pb + 6);
    if (ON(10) && IN(pb + 7)) { { p_combine(F, args, LAYER); } if (DUP(10)) { p_combine(F, args, LAYER); } } if constexpr (LAYER == 0) SEAM_L(pb + 7);
}

__global__ void __launch_bounds__(NWAVES * 64, 2) mk_fwd(Args args) {
    extern __shared__ __attribute__((aligned(16))) unsigned char lds[];
    Frame F;
    F.lds = (LAS unsigned char*)lds;
    F.tid = threadIdx.x; F.lane = (int)__builtin_amdgcn_mbcnt_hi(~0u, __builtin_amdgcn_mbcnt_lo(~0u, 0u));
    F.wave = __builtin_amdgcn_readfirstlane(F.tid >> 6);
    F.G = gridDim.x; { const int bx = blockIdx.x; F.vcu = (F.G % 8 == 0) ? (bx % 8) * (F.G / 8) + bx / 8 : bx; }
    F.ws = args.ws;
    for (int u = F.tid; u < (LDS_BYTES - LDSCTL_OFF) / 4; u += NWAVES * 64) ((LAS unsigned*)(F.lds + LDSCTL_OFF))[u] = 0u;
    __syncthreads();
    unsigned* ctl = (unsigned*)(F.ws + WS_CTL);
    XcdBarrier bar; bar.bar = ctl + CW_BAR; bar.x = 0; bar.st = nullptr;
#if !MK_PER_PHASE
    bar = xcd_barrier_post(ctl + CW_BAR, (volatile LAS unsigned*)(F.lds + MISC_OFF) + 8);
#endif
    const int lo = args.ph_lo, hi = args.ph_hi;
    F.own = false;
    if (F.tid == 0) atomicOr(&ctl[CW_MAPX + 64 * bar.x], 1u << (blockIdx.x & 7));
    if (ON(0) && IN(0)) { p0_prologue(F, args); if (DUP(0)) { p0_prologue(F, args); } } SEAM(0);
    if (IN(0) && IN(1)) { bool ok = (F.G == 256) && (bar.st[0] == 32u) && (bar.st[1] == 8u); unsigned seen = 0u;
#pragma unroll
        for (int j = 0; j < 16; ++j) { const unsigned m = xb_ld(&ctl[CW_MAPX + 64 * j]); if (m != 0u) { ok = ok && (__popc(m) == 1) && ((seen & m) == 0u) && (j < 8 ? true : true); seen |= m; } }
        F.own = ok && (seen == 0xffu); }
    run_layer<0>(F, args, bar, lo, hi);
    run_layer<1>(F, args, bar, lo, hi);
}
#undef IN
#undef SEAM

extern "C" void kernel_launch(void* const* d_in, const int* in_sizes, int n_in, void* d_out, int out_size, void* d_ws, size_t ws_size, hipStream_t stream) {
    static int grid = 0;
    if (grid == 0) {
        if (n_in != 21 || in_sizes[0] != T * D || out_size != T * D || ws_size < WS_END) { fprintf(stderr, "kernel_launch: unexpected shapes (n_in %d, in0 %d, out %d, ws %zu); nothing launched\n", n_in, n_in > 0 ? in_sizes[0] : -1, out_size, ws_size); grid = -1; return; }
        int dev = 0, cus = 0, per_cu = 0;
        if (hipGetDevice(&dev) != hipSuccess || hipDeviceGetAttribute(&cus, hipDeviceAttributeMultiprocessorCount, dev) != hipSuccess) { grid = -1; return; }
        if (hipFuncSetAttribute((const void*)mk_fwd, hipFuncAttributeMaxDynamicSharedMemorySize, LDS_BYTES) != hipSuccess) { fprintf(stderr, "kernel_launch: hipFuncSetAttribute failed\n"); grid = -1; return; }
        if (hipOccupancyMaxActiveBlocksPerMultiprocessor(&per_cu, (const void*)mk_fwd, NWAVES * 64, LDS_BYTES) != hipSuccess || per_cu < 1) { fprintf(stderr, "kernel_launch: occupancy query reports %d workgroups per CU\n", per_cu); }
        (void)hipGetLastError();
        grid = cus;
    }
    if (grid < 0) return;
    if (hipMemsetAsync((char*)d_ws + WS_CTL, 0, CTL_ZERO_BYTES, stream) != hipSuccess) return;
    Args a{};
    for (int i = 0; i < 21; ++i) a.in[i] = (const float*)d_in[i];
    a.out = (float*)d_out; a.ws = (unsigned char*)d_ws;
#if MK_PER_PHASE
    for (int p = 0; p < NPH; ++p) { a.ph_lo = p; a.ph_hi = p + 1; hipLaunchKernelGGL(mk_fwd, dim3(grid), dim3(NWAVES * 64), LDS_BYTES, stream, a); }
#else
    a.ph_lo = 0; a.ph_hi = NPH;
    hipLaunchKernelGGL(mk_fwd, dim3(grid), dim3(NWAVES * 64), LDS_BYTES, stream, a);
#endif
}
```

```cpp
#include <hip/hip_runtime.h>
#include <cstdio>

#ifndef MK_PER_PHASE
#define MK_PER_PHASE 0
#endif
#define GAS __attribute__((address_space(1)))
#define LAS __attribute__((address_space(3)))
typedef unsigned short bf16;
typedef unsigned v4u __attribute__((ext_vector_type(4)));
typedef unsigned v2u __attribute__((ext_vector_type(2)));
typedef float f32x4 __attribute__((ext_vector_type(4)));
typedef float f32x2 __attribute__((ext_vector_type(2)));
typedef short bf16x8 __attribute__((ext_vector_type(8)));
typedef int i32x4 __attribute__((ext_vector_type(4)));
typedef int i32x8 __attribute__((ext_vector_type(8)));
#define LDS_WAIT() asm volatile("s_waitcnt lgkmcnt(0)" ::: "memory")
#define VM_WAIT() asm volatile("s_waitcnt vmcnt(0)" ::: "memory")
#define LBAR() do { asm volatile("s_waitcnt lgkmcnt(0)" ::: "memory"); __builtin_amdgcn_s_barrier(); asm volatile("" ::: "memory"); } while (0)

__device__ __forceinline__ unsigned cvt_pk_bf16(float lo, float hi) { unsigned r; asm volatile("v_cvt_pk_bf16_f32 %0, %1, %2" : "=v"(r) : "v"(lo), "v"(hi)); return r; }
__device__ __forceinline__ unsigned cvt_pk_bf16_nv(float lo, float hi) { unsigned r; asm("v_cvt_pk_bf16_f32 %0, %1, %2" : "=v"(r) : "v"(lo), "v"(hi)); return r; }
__device__ __forceinline__ unsigned pk4_fp8(float a, float b, float c, float d) { unsigned w = 0u; w = (unsigned)__builtin_amdgcn_cvt_pk_fp8_f32(a, b, (int)w, false); w = (unsigned)__builtin_amdgcn_cvt_pk_fp8_f32(c, d, (int)w, true); return w; }
__device__ __forceinline__ __amdgpu_buffer_rsrc_t mk_rsrc(const void* p, unsigned bytes) { return __builtin_amdgcn_make_buffer_rsrc((void*)p, 0, (int)bytes, 0x00020000); }
__device__ __forceinline__ unsigned f2bf(float f) { unsigned u = __builtin_bit_cast(unsigned, f); return (u + 0x7fffu + ((u >> 16) & 1u)) >> 16; }
__device__ __forceinline__ unsigned pk2(float lo, float hi) { return f2bf(lo) | (f2bf(hi) << 16); }
__device__ __forceinline__ float bflo(unsigned w) { return __builtin_bit_cast(float, w << 16); }
__device__ __forceinline__ float bfhi(unsigned w) { return __builtin_bit_cast(float, w & 0xffff0000u); }
__device__ __forceinline__ float bf1(unsigned short b) { return __builtin_bit_cast(float, ((unsigned)b) << 16); }
__device__ __forceinline__ float sigmoidf_(float x) { return __builtin_amdgcn_rcpf(1.0f + __expf(-x)); }

namespace pg8 {
constexpr int BM = 256, BK = 64, HALF = 128, HTB = HALF * BK * 2, STAGE_BYTES = 8 * HTB, NXCD = 8, WGM = 8, KD = 1024;
constexpr int BIAS_OFF = 136192;
__host__ __device__ __forceinline__ int lds_byte(int r, int c) { const int st = (r >> 4) * 2 + (c >> 5), rr = r & 15, cc = c & 31, ob = rr * 64 + cc * 2; return st * 1024 + (ob ^ (((ob >> 9) & 1) << 5)); }
__host__ __device__ __forceinline__ void stage_rc(int b, int& R, int& C) { const int st = b / 1024, sb = b % 1024, swz = sb ^ (((sb >> 9) & 1) << 5); R = (st >> 1) * 16 + swz / 64; C = (st & 1) * 32 + (swz % 64) / 2; }
__host__ __device__ __forceinline__ int perm32(int rho) { const int n = rho >> 4, i = rho & 15; return 8 * (i >> 2) + 4 * n + (i & 3); }
struct Unit { int pm, pn; };

template <bool GROUPED> struct Order {
    int nM, nN, nwg, G, c; const char* A; const char* Bt; size_t bexp, tstep; const LAS int* texp;
    __device__ __forceinline__ void init(int nM_, int nN_, int G_, int c_) { nM = nM_; nN = nN_; nwg = nM * nN; G = G_; c = c_; tstep = (size_t)(BM * KD * 2); }
    __device__ __forceinline__ bool next(int i, Unit& u) const {
        const long L = (long)i * G + c; if (L >= nwg) return false;
        int wgid = (int)L; { const int q = nwg / NXCD, r = nwg % NXCD, xcd = wgid % NXCD, off = wgid / NXCD; wgid = (xcd < r ? xcd * (q + 1) : r * (q + 1) + (xcd - r) * q) + off; }
        const int nig = WGM * nN, gid = wgid / nig, fm = gid * WGM, gsz = (nM - fm) < WGM ? (nM - fm) : WGM;
        u.pm = fm + ((wgid % nig) % gsz); u.pn = (wgid % nig) / gsz; return true;
    }
    __device__ __forceinline__ const char* aptr(const Unit& u) const { return A + (size_t)u.pm * tstep; }
    __device__ __forceinline__ const char* bptr(const Unit& u) const { return Bt + (GROUPED ? (size_t)texp[u.pm] * bexp : (size_t)0) + (size_t)u.pn * tstep; }
};

struct EpiZ {
    static constexpr int PERM = 2, NBIAS = 0;
    bf16* O; int ldc;
    __device__ __forceinline__ void operator()(const f32x4 (&acc)[2][2][4][2], const Unit& u, int wr, int wc, int fr, int fq, const LAS float* lb) const {
        const int row0 = u.pm * BM + wr * 64 + fr, col0 = u.pn * BM + wc * 64 + 16 * fq;
#pragma unroll
        for (int ai = 0; ai < 2; ++ai)
#pragma unroll
            for (int m = 0; m < 4; ++m) { bf16* rowp = O + (size_t)(row0 + ai * HALF + m * 16) * ldc + col0;
#pragma unroll
                for (int bj = 0; bj < 2; ++bj) { const f32x4 v0 = acc[ai][bj][m][0], v1 = acc[ai][bj][m][1];
                    v4u w; w.x = cvt_pk_bf16(v0[0], v0[1]); w.y = cvt_pk_bf16(v0[2], v0[3]); w.z = cvt_pk_bf16(v1[0], v1[1]); w.w = cvt_pk_bf16(v1[2], v1[3]);
                    *(v4u*)(rowp + bj * 8) = w; } }
    }
};
template <bool BASE_BF16> struct EpiRes {
    static constexpr int PERM = 2, NBIAS = 0;
    const void* base; bf16* out; float alpha;
    __device__ __forceinline__ void operator()(const f32x4 (&acc)[2][2][4][2], const Unit& u, int wr, int wc, int fr, int fq, const LAS float* lb) const {
        const int row0 = u.pm * BM + wr * 64 + fr, col0 = u.pn * BM + wc * 64 + 16 * fq;
#pragma unroll
        for (int ai = 0; ai < 2; ++ai) {
            f32x4 b0[4][2], b1[4][2];
#pragma unroll
            for (int m = 0; m < 4; ++m) { const size_t off = (size_t)(row0 + ai * HALF + m * 16) * 1024 + col0;
#pragma unroll
                for (int bj = 0; bj < 2; ++bj) {
                    if constexpr (BASE_BF16) { const v4u bw = *(const v4u*)((const bf16*)base + off + bj * 8); b0[m][bj] = __builtin_bit_cast(f32x4, bw); }
                    else { b0[m][bj] = *(const f32x4*)((const float*)base + off + bj * 8); b1[m][bj] = *(const f32x4*)((const float*)base + off + bj * 8 + 4); } } }
            __builtin_amdgcn_sched_barrier(0);
#pragma unroll
            for (int m = 0; m < 4; ++m) { const size_t off = (size_t)(row0 + ai * HALF + m * 16) * 1024 + col0;
#pragma unroll
                for (int bj = 0; bj < 2; ++bj) { f32x4 c0, c1;
                    if constexpr (BASE_BF16) { const v4u bw = __builtin_bit_cast(v4u, b0[m][bj]); c0 = (f32x4){bflo(bw.x), bfhi(bw.x), bflo(bw.y), bfhi(bw.y)}; c1 = (f32x4){bflo(bw.z), bfhi(bw.z), bflo(bw.w), bfhi(bw.w)}; }
                    else { c0 = b0[m][bj]; c1 = b1[m][bj]; }
                    const f32x4 v0 = c0 * alpha + acc[ai][bj][m][0], v1 = c1 * alpha + acc[ai][bj][m][1];
                    v4u w; w.x = cvt_pk_bf16(v0[0], v0[1]); w.y = cvt_pk_bf16(v0[2], v0[3]); w.z = cvt_pk_bf16(v1[0], v1[1]); w.w = cvt_pk_bf16(v1[2], v1[3]);
                    *(v4u*)(out + off + bj * 8) = w; } }
        }
    }
};
struct EpiSwiglu8 {
    static constexpr int PERM = 1, NBIAS = 256;
    unsigned char* O; const float* bias; const LAS int* texp; float inscale;
    __device__ __forceinline__ const float* bias_src(const Unit& u, int i) const { return bias + (size_t)texp[u.pm] * 2048 + (i >> 7) * 1024 + u.pn * HALF + (i & 127); }
    __device__ __forceinline__ void operator()(const f32x4 (&acc)[2][2][4][2], const Unit& u, int wr, int wc, int fr, int fq, const LAS float* lb) const {
        const int row0 = u.pm * BM + wr * 64 + fr, jc = u.pn * HALF + wc * 32 + 8 * fq;
        const LAS float* bp = lb + wc * 32 + 8 * fq; const float s1 = inscale, s4 = 4.0f * inscale; const __amdgpu_buffer_rsrc_t rs = mk_rsrc(O, 0x7fffff00u);
        f32x4 bg[2], bl[2];
#pragma unroll
        for (int n = 0; n < 2; ++n) { bg[n] = *(const LAS f32x4*)(bp + 4 * n); bl[n] = *(const LAS f32x4*)(bp + 128 + 4 * n) * 4.0f + 4.0f; }
#pragma unroll
        for (int ai = 0; ai < 2; ++ai)
#pragma unroll
            for (int m = 0; m < 4; ++m) { const unsigned ob = (unsigned)(row0 + ai * HALF + m * 16) * 1024u + (unsigned)jc; float r[8];
#pragma unroll
                for (int n = 0; n < 2; ++n) { const f32x4 g4 = acc[ai][0][m][n] * s1 + bg[n], l4 = acc[ai][1][m][n] * s4 + bl[n];
#pragma unroll
                    for (int p = 0; p < 2; ++p) {
                        const f32x2 g2 = (f32x2){fminf(g4[2 * p], 7.0f), fminf(g4[2 * p + 1], 7.0f)}, l2 = (f32x2){__builtin_amdgcn_fmed3f(l4[2 * p], -24.0f, 32.0f), __builtin_amdgcn_fmed3f(l4[2 * p + 1], -24.0f, 32.0f)};
                        const f32x2 t2 = g2 * -2.45546696f; const f32x2 d2 = (f32x2){__builtin_amdgcn_exp2f(t2[0]), __builtin_amdgcn_exp2f(t2[1])} + 1.0f;
                        const f32x2 q2 = (f32x2){__builtin_amdgcn_rcpf(d2[0]), __builtin_amdgcn_rcpf(d2[1])}; const f32x2 r2 = (g2 * l2) * q2;
                        r[4 * n + 2 * p] = r2[0]; r[4 * n + 2 * p + 1] = r2[1]; } }
                v2u w; w.x = pk4_fp8(r[0], r[1], r[2], r[3]); w.y = pk4_fp8(r[4], r[5], r[6], r[7]);
                __builtin_amdgcn_raw_buffer_store_b64(w, rs, (int)ob, 0, 16); }
    }
};
struct EpiBiasG8 {
    static constexpr int PERM = 2, NBIAS = 256;
    unsigned char* O; const float* bias; const LAS int* texp; float inscale;
    __device__ __forceinline__ const float* bias_src(const Unit& u, int i) const { return bias + (size_t)texp[u.pm] * 1024 + u.pn * BM + i; }
    __device__ __forceinline__ void operator()(const f32x4 (&acc)[2][2][4][2], const Unit& u, int wr, int wc, int fr, int fq, const LAS float* lb) const {
        const int row0 = u.pm * BM + wr * 64 + fr, col0 = u.pn * BM + wc * 64 + 16 * fq;
        const LAS float* bp = lb + wc * 64 + 16 * fq; const float s16 = 16.0f * inscale;
        f32x4 bv[2][2];
#pragma unroll
        for (int bj = 0; bj < 2; ++bj)
#pragma unroll
            for (int n = 0; n < 2; ++n) bv[bj][n] = *(const LAS f32x4*)(bp + bj * 8 + 4 * n) * 16.0f;
#pragma unroll
        for (int ai = 0; ai < 2; ++ai)
#pragma unroll
            for (int m = 0; m < 4; ++m) { unsigned char* rowp = O + (size_t)(row0 + ai * HALF + m * 16) * 1024 + col0; v4u w;
                { const f32x4 v0 = acc[ai][0][m][0] * s16 + bv[0][0], v1 = acc[ai][0][m][1] * s16 + bv[0][1]; w.x = pk4_fp8(v0[0], v0[1], v0[2], v0[3]); w.y = pk4_fp8(v1[0], v1[1], v1[2], v1[3]); }
                { const f32x4 v0 = acc[ai][1][m][0] * s16 + bv[1][0], v1 = acc[ai][1][m][1] * s16 + bv[1][1]; w.z = pk4_fp8(v0[0], v0[1], v0[2], v0[3]); w.w = pk4_fp8(v1[0], v1[1], v1[2], v1[3]); }
                *(v4u*)rowp = w; }
    }
};
struct EpiGlu {
    static constexpr int PERM = 1, NBIAS = 0;
    bf16* O;
    __device__ __forceinline__ void operator()(const f32x4 (&acc)[2][2][4][2], const Unit& u, int wr, int wc, int fr, int fq, const LAS float* lb) const {
        const int row0 = u.pm * BM + wr * 64 + fr, jc = u.pn * HALF + wc * 32 + 8 * fq;
#pragma unroll
        for (int ai = 0; ai < 2; ++ai)
#pragma unroll
            for (int m = 0; m < 4; ++m) { bf16* rowp = O + (size_t)(row0 + ai * HALF + m * 16) * 1024 + jc; float r[8];
#pragma unroll
                for (int n = 0; n < 2; ++n) { const f32x4 a4 = acc[ai][0][m][n], g4 = acc[ai][1][m][n];
#pragma unroll
                    for (int p = 0; p < 2; ++p) {
                        const f32x2 t2 = (f32x2){g4[2 * p], g4[2 * p + 1]} * -1.44269504f; const f32x2 d2 = (f32x2){__builtin_amdgcn_exp2f(t2[0]), __builtin_amdgcn_exp2f(t2[1])} + 1.0f;
                        const f32x2 r2 = (f32x2){a4[2 * p], a4[2 * p + 1]} * (f32x2){__builtin_amdgcn_rcpf(d2[0]), __builtin_amdgcn_rcpf(d2[1])};
                        r[4 * n + 2 * p] = r2[0]; r[4 * n + 2 * p + 1] = r2[1]; } }
                v4u w; w.x = cvt_pk_bf16(r[0], r[1]); w.y = cvt_pk_bf16(r[2], r[3]); w.z = cvt_pk_bf16(r[4], r[5]); w.w = cvt_pk_bf16(r[6], r[7]);
                *(v4u*)rowp = w; }
    }
};

__device__ __forceinline__ bf16x8 lo8(i32x8 v) { return __builtin_bit_cast(bf16x8, (i32x4)__builtin_shufflevector(v, v, 0, 1, 2, 3)); }
__device__ __forceinline__ bf16x8 hi8(i32x8 v) { return __builtin_bit_cast(bf16x8, (i32x4)__builtin_shufflevector(v, v, 4, 5, 6, 7)); }
struct Hand { unsigned* cnt; unsigned* tot; unsigned expect; };
template <class Epi, class Sched, bool ALIGN_EPI = true, bool FP8 = false, bool GATHER = false, int HANDOFF = 0  >
__device__ __forceinline__ void gemm_phase(LAS unsigned char* lds, const Sched& S, const Epi& E, const LAS unsigned short* rowtab = nullptr, const Hand hand = Hand{nullptr, nullptr, 0u}) {
    const int tid = threadIdx.x, wid = __builtin_amdgcn_readfirstlane(tid >> 6), lane = tid & 63, wr = wid >> 2, wc = wid & 3, fr = lane & 15, fq = lane >> 4;
    constexpr int ROWB = FP8 ? KD : KD * 2, nt = ROWB / (BK * 2);
    unsigned voffB[2][2], offC[2][2], offN[2][2]; int rA[2], cA2[2];
#pragma unroll
    for (int i = 0; i < 2; ++i) { int R, C; stage_rc(tid * 16 + i * 8192, R, C); const int Rb = (Epi::PERM == 1) ? ((R & ~31) + perm32(R & 31)) : R;
        rA[i] = R; cA2[i] = C * 2;
#pragma unroll
        for (int bj = 0; bj < 2; ++bj) { int grow;
            if constexpr (Epi::PERM == 2) { const int wc_ = R >> 5, rho = R & 31; grow = 64 * wc_ + 16 * ((rho & 15) >> 2) + 8 * bj + 4 * (rho >> 4) + (rho & 3); }
            else grow = bj * HALF + Rb;
            voffB[bj][i] = (unsigned)(grow * ROWB + C * 2); }
#pragma unroll
        for (int h = 0; h < 2; ++h) { offC[h][i] = (unsigned)((h * HALF + R) * ROWB + C * 2); offN[h][i] = offC[h][i]; } }
#define PG8_GOFF(dst, unit_idx) do { if constexpr (GATHER) { _Pragma("unroll") for (int h_ = 0; h_ < 2; ++h_) _Pragma("unroll") for (int i_ = 0; i_ < 2; ++i_) \
        dst[h_][i_] = (unsigned)rowtab[(unit_idx) * 256 + h_ * HALF + rA[i_]] * (unsigned)ROWB + (unsigned)cA2[i_]; } } while (0)
    constexpr size_t kstep = (size_t)(BK * 2);
    constexpr size_t hstep = (size_t)HALF * ROWB;
    const unsigned ldsw = (unsigned)wid * 1024u;
    const int aoff = lds_byte(wr * 64 + fr, fq * 8), boff = lds_byte(wc * 32 + fr, fq * 8);
#define PG8_SA(b, h) (((b) * 2 + (h)) * HTB)
#define PG8_SB(b, h) ((4 + (b) * 2 + (h)) * HTB)
#define PG8_STAGE(bufoff, gbase, voff) do { _Pragma("unroll") for (int _i = 0; _i < 2; ++_i) \
        __builtin_amdgcn_global_load_lds((const unsigned*)((const char*)(gbase) + (voff)[_i]), (LAS unsigned*)(lds + (bufoff) + ldsw + _i * 8192), 16, 0, 0); } while (0)
#define PG8_LDA(dst, b, h) do { _Pragma("unroll") for (int m = 0; m < 4; ++m) { const i32x4 x_ = *(const LAS i32x4*)(lds + PG8_SA(b, h) + aoff + m * 2048), y_ = *(const LAS i32x4*)(lds + PG8_SA(b, h) + aoff + m * 2048 + 1024); dst[m] = __builtin_shufflevector(x_, y_, 0, 1, 2, 3, 4, 5, 6, 7); } } while (0)
#define PG8_LDB(dst, b, h) do { _Pragma("unroll") for (int n = 0; n < 2; ++n) { const i32x4 x_ = *(const LAS i32x4*)(lds + PG8_SB(b, h) + boff + n * 2048), y_ = *(const LAS i32x4*)(lds + PG8_SB(b, h) + boff + n * 2048 + 1024); dst[n] = __builtin_shufflevector(x_, y_, 0, 1, 2, 3, 4, 5, 6, 7); } } while (0)
#define PG8_MMA(ai, bj, At, Bt) do { __builtin_amdgcn_s_setprio(1); _Pragma("unroll") for (int m = 0; m < 4; ++m) _Pragma("unroll") for (int n = 0; n < 2; ++n) { \
        if constexpr (FP8) asm volatile("s_nop 1\n\tv_mfma_scale_f32_16x16x128_f8f6f4 %0, %1, %2, %0, %3, %3 op_sel_hi:[0,0,0]" : "+v"(acc[ai][bj][m][n]) : "v"(Bt[n]), "v"(At[m]), "v"(sc127)); \
        else { acc[ai][bj][m][n] = __builtin_amdgcn_mfma_f32_16x16x32_bf16(lo8(Bt[n]), lo8(At[m]), acc[ai][bj][m][n], 0, 0, 0); acc[ai][bj][m][n] = __builtin_amdgcn_mfma_f32_16x16x32_bf16(hi8(Bt[n]), hi8(At[m]), acc[ai][bj][m][n], 0, 0, 0); } } __builtin_amdgcn_s_setprio(0); } while (0)
#define PG8_WAIT_V(n) asm volatile("s_waitcnt vmcnt(" #n ")" ::: "memory")
#define PG8_WAIT_L(n) asm volatile("s_waitcnt lgkmcnt(" #n ")" ::: "memory")
#define PG8_BAR __builtin_amdgcn_s_barrier()
#define PG8_SCHED __builtin_amdgcn_sched_barrier(0)
#define PG8_SCHED8 do { } while (0)
    Unit cur, nxt; int ui = 0;
    if (!S.next(0, cur)) return;
    int prev_pm = -1; bool all_done = false;
#define PG8_AREADY(u_) do { if constexpr (HANDOFF == 2) { if (wid == 0 && !all_done) { \
            all_done = (unsigned)__builtin_amdgcn_readfirstlane((int)__hip_atomic_load(hand.tot, __ATOMIC_RELAXED, __HIP_MEMORY_SCOPE_AGENT)) >= hand.expect;     \
            if (!all_done) { unsigned spins_ = 0u; \
                while ((unsigned)__builtin_amdgcn_readfirstlane((int)__hip_atomic_load(hand.cnt + 64 * (u_).pm, __ATOMIC_RELAXED, __HIP_MEMORY_SCOPE_AGENT)) < 64u) { __builtin_amdgcn_s_sleep(2); if (++spins_ > (1u << 22)) break; } } } \
        asm volatile("" ::: "memory"); __builtin_amdgcn_s_barrier(); asm volatile("" ::: "memory"); } } while (0)
    f32x4 acc[2][2][4][2];
#pragma unroll
    for (int a = 0; a < 2; ++a)
#pragma unroll
        for (int b = 0; b < 2; ++b)
#pragma unroll
            for (int m = 0; m < 4; ++m)
#pragma unroll
                for (int n = 0; n < 2; ++n) acc[a][b][m][n] = (f32x4){0.f, 0.f, 0.f, 0.f};
    i32x8 At[4], B0[2], B1[2];
    const int sc127 = 127;
    const char* cA = GATHER ? S.A : S.aptr(cur); const char* cB = S.bptr(cur);
    PG8_GOFF(offC, 0);
    PG8_AREADY(cur);
    PG8_STAGE(PG8_SB(0, 0), cB, voffB[0]); PG8_STAGE(PG8_SB(0, 1), cB, voffB[1]); PG8_STAGE(PG8_SA(0, 0), cA, offC[0]); PG8_STAGE(PG8_SA(0, 1), cA, offC[1]);
    if (wr == 1) PG8_BAR;
    PG8_WAIT_V(2); PG8_BAR;
    PG8_STAGE(PG8_SB(1, 0), cB + kstep, voffB[0]); PG8_STAGE(PG8_SA(1, 0), cA + kstep, offC[0]); PG8_STAGE(PG8_SB(1, 1), cB + kstep, voffB[1]);
    PG8_WAIT_V(6); PG8_BAR;
    for (;;) {
        if constexpr (Epi::NBIAS != 0) { if (wid < 4) {
            __builtin_amdgcn_global_load_lds((const unsigned*)E.bias_src(cur, wid * 64 + lane), (LAS unsigned*)(lds + BIAS_OFF + (ui & 1) * 1024 + wid * 256), 4, 0, 0); } }
        const bool has_next = S.next(ui + 1, nxt);
        const char* nA = GATHER ? cA : (has_next ? S.aptr(nxt) : cA); const char* nB = has_next ? S.bptr(nxt) : cB;
        if constexpr (GATHER) { if (has_next) PG8_GOFF(offN, ui + 1); else {
#pragma unroll
            for (int h = 0; h < 2; ++h) { offN[h][0] = offC[h][0]; offN[h][1] = offC[h][1]; } } }
#pragma nounroll
        for (int t = 0; t < nt; t += 2) {
            const bool last = (t == nt - 2);
            if (last && has_next) PG8_AREADY(nxt);
            const char* a1 = cA + (size_t)(t + 1) * kstep;
            const char* a2 = last ? nA : cA + (size_t)(t + 2) * kstep; const char* b2 = last ? nB : cB + (size_t)(t + 2) * kstep;
            const char* a3 = a2 + kstep; const char* b3 = b2 + kstep;
            unsigned o2[2][2];
#pragma unroll
            for (int h = 0; h < 2; ++h) { o2[h][0] = (GATHER && last) ? offN[h][0] : offC[h][0]; o2[h][1] = (GATHER && last) ? offN[h][1] : offC[h][1]; }
            PG8_LDB(B0, 0, 0); PG8_LDB(B1, 0, 1); PG8_SCHED; PG8_LDA(At, 0, 0); PG8_STAGE(PG8_SA(1, 1), a1, offC[1]);
            PG8_WAIT_V(8); PG8_WAIT_L(0); PG8_BAR; PG8_SCHED8; PG8_MMA(0, 0, At, B0); PG8_MMA(0, 1, At, B1); PG8_BAR; PG8_SCHED;
            PG8_LDA(At, 0, 1); PG8_STAGE(PG8_SB(0, 0), b2, voffB[0]); PG8_STAGE(PG8_SB(0, 1), b2, voffB[1]); PG8_STAGE(PG8_SA(0, 0), a2, o2[0]);
            PG8_WAIT_V(8); PG8_WAIT_L(0); PG8_BAR; PG8_SCHED8; PG8_MMA(1, 0, At, B0); PG8_MMA(1, 1, At, B1); PG8_BAR; PG8_SCHED;
            PG8_LDB(B0, 1, 0); PG8_LDB(B1, 1, 1); PG8_SCHED; PG8_LDA(At, 1, 0); PG8_STAGE(PG8_SA(0, 1), a2, o2[1]);
            PG8_WAIT_V(8); PG8_WAIT_L(0); PG8_BAR; PG8_SCHED8; PG8_MMA(0, 0, At, B0); PG8_MMA(0, 1, At, B1); PG8_BAR; PG8_SCHED;
            PG8_LDA(At, 1, 1); PG8_STAGE(PG8_SB(1, 0), b3, voffB[0]); PG8_STAGE(PG8_SB(1, 1), b3, voffB[1]); PG8_STAGE(PG8_SA(1, 0), a3, o2[0]);
            PG8_WAIT_V(8); PG8_WAIT_L(0); PG8_BAR; PG8_SCHED8; PG8_MMA(1, 0, At, B0); PG8_MMA(1, 1, At, B1); PG8_BAR; PG8_SCHED;
        }
        if constexpr (HANDOFF == 1) { if (prev_pm >= 0 && lane == 0) {
            __hip_atomic_fetch_add(hand.cnt + 64 * prev_pm, 1u, __ATOMIC_RELAXED, __HIP_MEMORY_SCOPE_AGENT); } prev_pm = cur.pm; }
        if constexpr (ALIGN_EPI) { if (wr == 0) PG8_BAR; }
        if constexpr (FP8) asm volatile("s_nop 15\n\ts_nop 15" ::: "memory");
        E(acc, cur, wr, wc, fr, fq, (const LAS float*)(lds + BIAS_OFF + (ui & 1) * 1024));
        if (!has_next) break;
#pragma unroll
        for (int a = 0; a < 2; ++a)
#pragma unroll
            for (int b = 0; b < 2; ++b)
#pragma unroll
                for (int m = 0; m < 4; ++m)
#pragma unroll
                    for (int n = 0; n < 2; ++n) acc[a][b][m][n] = (f32x4){0.f, 0.f, 0.f, 0.f};
        cur = nxt; cA = nA; cB = nB; ++ui;
        if constexpr (GATHER) {
#pragma unroll
            for (int h = 0; h < 2; ++h) { offC[h][0] = offN[h][0]; offC[h][1] = offN[h][1]; } }
        if constexpr (ALIGN_EPI) { if (wr == 1) PG8_BAR; }
    }
    PG8_WAIT_V(0);
    if constexpr (HANDOFF == 1) { if (lane == 0) { __hip_atomic_fetch_add(hand.cnt + 64 * prev_pm, 1u, __ATOMIC_RELAXED, __HIP_MEMORY_SCOPE_AGENT); } }
    if constexpr (!ALIGN_EPI) { if (wr == 0) PG8_BAR; }
    PG8_BAR;
#undef PG8_SA
#undef PG8_SB
#undef PG8_STAGE
#undef PG8_LDA
#undef PG8_LDB
#undef PG8_MMA
#undef PG8_WAIT_V
#undef PG8_WAIT_L
#undef PG8_BAR
#undef PG8_SCHED
#undef PG8_SCHED8
#undef PG8_GOFF
#undef PG8_AREADY
}

}

constexpr int NWAVES = 8;
constexpr int T = 32768, D = 1024, SEQ = 2048, NB = 16;
constexpr int NZ = 3072;
constexpr int ZQ = 0, ZK = 256, ZV = 512, ZO = 1024, ZSB = 1536, ZSC = 2048, ZSX = 2560;
constexpr int NE = 32, TOPK = 4;
constexpr int PROWS = 139264;
constexpr float ALPHA = 1.41421356237309515f;
constexpr float LN_EPS = 1e-5f, HEAD_EPS = 1e-6f;
constexpr int NPH = 17;

constexpr size_t MiB = 1u << 20;
constexpr size_t WS_CTL = 0, CTL_ZERO_BYTES = 1 * MiB;
constexpr size_t WS_TOPI = 1 * MiB, WS_TOPG = WS_TOPI + MiB / 2, WS_SLOT = 2 * MiB, WS_CNTT = WS_SLOT + MiB / 2, WS_META = WS_CNTT + MiB / 4, WS_GATES = 3 * MiB;
constexpr size_t WS_RWH = 4 * MiB, WS_RWL = WS_RWH + MiB / 4, WS_RGB = WS_RWL + MiB / 4, WS_STATS = 5 * MiB, WS_WSC = 6 * MiB, WS_ROWTOK = 7 * MiB;
constexpr size_t WS_WIN = 8 * MiB, WS_WOUT = 14 * MiB, WS_PW1 = 16 * MiB, WS_PW2 = 20 * MiB, WS_UP = 22 * MiB, WS_DN = 278 * MiB;
constexpr size_t WS_ABF = 406 * MiB, WS_X1B = 470 * MiB, WS_HCAT = 534 * MiB, WS_R = 598 * MiB;
constexpr size_t WS_ACT = 1254 * MiB, WS_YS = 1526 * MiB, WS_Z = 1798 * MiB, WS_U = 1798 * MiB, WS_V = 1862 * MiB, WS_END = 1990 * MiB;
static_assert((size_t)PROWS * 2048 <= 272 * MiB, "grouped buffers");
constexpr int CW_LBAR = 8192, CW_MAPX = 12288;
constexpr int CW_BAR = 4096, CW_QUEUE = 64, Q_CHUNK = 8, CW_UPCNT = 32768, UPCNT_LAYER = 544 * 64, CW_UPTOT = 110592;

constexpr int RING_BYTES = 131072;
constexpr int LDSCTL_OFF = 139264, MISC_OFF = LDSCTL_OFF + 320;
constexpr int TEXP_OFF = 132096;
constexpr int ROWTAB_OFF = 147456;
constexpr int LDS_BYTES = 147456 + 20 * 512;
static_assert(TEXP_OFF + 4096 <= LDSCTL_OFF && MISC_OFF + 128 <= LDS_BYTES, "LDS map");

#define XB_TMO      128
#define XB_XCNT(j)  (256  + 64 * (j))
#define XB_XSUB(j)  (1280 + 64 * (j))
#define XB_XGEN(j)  (2304 + 64 * (j))
#define XB_TOP      3328
#define XB_TOPGEN   3392
#define XCD_BAR_WORDS 3456
#define XB_SPIN_CAP (1u << 18)
__device__ __forceinline__ unsigned xb_ld(unsigned* p)              { return __hip_atomic_load(p, __ATOMIC_RELAXED, __HIP_MEMORY_SCOPE_AGENT); }
__device__ __forceinline__ unsigned xb_add(unsigned* p, unsigned v) { return __hip_atomic_fetch_add(p, v, __ATOMIC_RELAXED, __HIP_MEMORY_SCOPE_AGENT); }
__device__ __forceinline__ unsigned xb_xcc_id() { return (unsigned)__builtin_amdgcn_s_getreg((3 << 11) | 20) & 0xFu; }
#define XB_SPIN(cond, bar) do { unsigned _sp = 0; while (cond) { __builtin_amdgcn_s_sleep(1); \
    if ((++_sp & 255u) == 0u) { if (xb_ld(&(bar)[XB_TMO])) break; if (_sp > XB_SPIN_CAP) { atomicAdd(&(bar)[XB_TMO], 1u); break; } } } } while (0)
struct XcdBarrier { unsigned* bar; unsigned x; volatile LAS unsigned* st; };
__device__ __forceinline__ XcdBarrier xcd_barrier_post(unsigned* bar, volatile LAS unsigned* st) {
    XcdBarrier b; b.bar = bar; b.x = xb_xcc_id(); b.st = st;
    if (threadIdx.x == 0) (void)xb_add(&bar[XB_XCNT(b.x)], 1u);
    return b;
}
__device__ __forceinline__ void xcd_barrier_complete(unsigned* bar, unsigned x, unsigned& nloc, unsigned& nx) {
    const unsigned G = gridDim.x * gridDim.y * gridDim.z;
    unsigned sum, cnt, mine, sp = 0u;
    for (;;) {
        sum = 0u; cnt = 0u; mine = 0u;
#pragma unroll
        for (unsigned j = 0; j < 16; ++j) { const unsigned c = xb_ld(&bar[XB_XCNT(j)]); sum += c; cnt += (c > 0u) ? 1u : 0u; mine = (j == x) ? c : mine; }
        if (sum == G) break;
        __builtin_amdgcn_s_sleep(1);
        if ((++sp & 255u) == 0u) { if (xb_ld(&bar[XB_TMO])) break; if (sp > XB_SPIN_CAP) { atomicAdd(&bar[XB_TMO], 1u); break; } }
    }
    nloc = mine > 0u ? mine : 1u; nx = cnt > 0u ? cnt : 1u;
}
__device__ __forceinline__ void xcd_barrier(const XcdBarrier& b) {
    asm volatile("s_waitcnt vmcnt(0)" ::: "memory");
    __syncthreads();
    if (threadIdx.x == 0) {
        unsigned* bar = b.bar;
        __builtin_amdgcn_s_waitcnt(0);
        unsigned nloc = b.st[0], nx = b.st[1];
        if (nloc == 0u) { xcd_barrier_complete(bar, b.x, nloc, nx); b.st[0] = nloc; b.st[1] = nx; }
        const unsigned old = xb_add(&bar[XB_XSUB(b.x)], 1u);
        const unsigned gen = old / nloc;
        if (old + 1u == (gen + 1u) * nloc) {
            __builtin_amdgcn_fence(__ATOMIC_RELEASE, "agent");
            asm volatile("s_waitcnt vmcnt(0)" ::: "memory");
            const unsigned og = xb_add(&bar[XB_TOP], 1u);
            const unsigned tg = og / nx;
            if (og + 1u == (tg + 1u) * nx) xb_add(&bar[XB_TOPGEN], 1u);
            else XB_SPIN(xb_ld(&bar[XB_TOPGEN]) == tg, bar);
            __builtin_amdgcn_fence(__ATOMIC_ACQUIRE, "agent");
            xb_add(&bar[XB_XGEN(b.x)], 1u);
            asm volatile("s_waitcnt vmcnt(0)" ::: "memory");
        } else {
            XB_SPIN(xb_ld(&bar[XB_XGEN(b.x)]) == gen, bar);
            __builtin_amdgcn_fence(__ATOMIC_ACQUIRE, "agent");
            asm volatile("s_waitcnt vmcnt(0)" ::: "memory");
        }
    }
    __syncthreads();
}

__device__ __forceinline__ void xcd_local_barrier(const XcdBarrier& b, unsigned* lb) {
    asm volatile("s_waitcnt vmcnt(0)" ::: "memory");
    __syncthreads();
    if (threadIdx.x == 0) {
        __builtin_amdgcn_s_waitcnt(0);
        const unsigned nloc = b.st[0];
        const unsigned old = xb_add(&lb[64 * b.x], 1u), gen = old / nloc;
        if (old + 1u == (gen + 1u) * nloc) (void)xb_add(&lb[1024 + 64 * b.x], 1u);
        else XB_SPIN(xb_ld(&lb[1024 + 64 * b.x]) == gen, b.bar);
        __builtin_amdgcn_fence(__ATOMIC_ACQUIRE, "agent");
        asm volatile("s_waitcnt vmcnt(0)" ::: "memory");
    }
    __syncthreads();
}

struct Args { const float* in[21]; float* out; unsigned char* ws; int ph_lo, ph_hi; };
struct Frame {
    LAS unsigned char* lds;
    int tid, lane, wave, vcu, G;
    bool own;
    unsigned char* ws;
};
__device__ __forceinline__ float wave_sum(float v) {
#pragma unroll
    for (int o = 1; o < 64; o <<= 1) v += __shfl_xor(v, o);
    return v;
}
__device__ __forceinline__ float wave_max(float v) {
#pragma unroll
    for (int o = 1; o < 64; o <<= 1) v = fmaxf(v, __shfl_xor(v, o));
    return v;
}

struct TrItem { const float* src; bf16* dst; int ld; float scale; int fp8; };
__device__ __forceinline__ void tr_load(const TrItem& I, int lane, f32x4 (&tv)[8]) {
#pragma unroll
    for (int i = 0; i < 8; ++i) tv[i] = *(const GAS f32x4*)(I.src + (size_t)((lane >> 3) + 8 * i) * I.ld + 4 * (lane & 7));
}
__device__ __forceinline__ void tr_store(const TrItem& I, const f32x4 (&tv)[8], LAS float* scr, int lane) {
#pragma unroll
    for (int i = 0; i < 8; ++i) { LAS float* p = scr + ((lane >> 3) + 8 * i) * 33 + 4 * (lane & 7); p[0] = tv[i][0]; p[1] = tv[i][1]; p[2] = tv[i][2]; p[3] = tv[i][3]; }
    LDS_WAIT(); asm volatile("" ::: "memory");
    const int c = lane & 7; const float scale = I.scale;
#pragma unroll
    for (int j = 0; j < 4; ++j) { const int n = (lane >> 3) + 8 * j; const LAS float* s = scr + (8 * c) * 33 + n;
        if (I.fp8) { v2u o; o.x = pk4_fp8(s[0 * 33] * scale, s[1 * 33] * scale, s[2 * 33] * scale, s[3 * 33] * scale); o.y = pk4_fp8(s[4 * 33] * scale, s[5 * 33] * scale, s[6 * 33] * scale, s[7 * 33] * scale);
            *(GAS v2u*)((unsigned char*)I.dst + (size_t)n * 1024 + 8 * c) = o; }
        else { v4u o; o.x = cvt_pk_bf16(s[0 * 33] * scale, s[1 * 33] * scale); o.y = cvt_pk_bf16(s[2 * 33] * scale, s[3 * 33] * scale); o.z = cvt_pk_bf16(s[4 * 33] * scale, s[5 * 33] * scale); o.w = cvt_pk_bf16(s[6 * 33] * scale, s[7 * 33] * scale);
            *(GAS v4u*)(I.dst + (size_t)n * 1024 + 8 * c) = o; } }
    LDS_WAIT(); asm volatile("" ::: "memory");
}
__device__ __forceinline__ int glu_src_col(int d0) { const int pn = d0 >> 8, j0 = d0 & 255; return j0 < 128 ? 128 * pn + j0 : 1024 + 128 * pn + (j0 - 128); }

constexpr int I_IN = 16 * 96, I_OUT = 16 * 32, I_PW1 = 16 * 64, I_PW2 = 16 * 32, I_UP = 64 * 1024, I_DN = 64 * 512;
constexpr int I_EARLY = I_IN + I_OUT, NITEMS = I_IN + I_OUT + I_PW1 + I_PW2 + I_UP + I_DN;
#ifndef MK_P0_ITEMS
#define MK_P0_ITEMS 0
#endif
constexpr int I_P0 = I_EARLY + MK_P0_ITEMS;
__device__ __forceinline__ TrItem tr_decode(Frame& F, const Args& A, int it, const float (&wsc)[4]) {
    bf16* WIN = (bf16*)(F.ws + WS_WIN); bf16* WOUT = (bf16*)(F.ws + WS_WOUT); bf16* PW1 = (bf16*)(F.ws + WS_PW1); bf16* PW2 = (bf16*)(F.ws + WS_PW2);
    bf16* UP = (bf16*)(F.ws + WS_UP); bf16* DN = (bf16*)(F.ws + WS_DN);
    TrItem I; I.scale = 1.0f; I.fp8 = 0; int r = it;
    if (r < I_IN) { const int kb = r / 96, nb = r % 96, d0 = 32 * nb, sc0 = d0 + (d0 >= 1536 ? 8 : 0); I.scale = (d0 >= 256 && d0 < 512) ? 0.125f : 1.0f;
        I.src = A.in[1] + (size_t)kb * 64 * 3080 + sc0; I.ld = 3080; I.dst = WIN + (size_t)d0 * 1024 + kb * 64; return I; } r -= I_IN;
    if (r < I_OUT) { const int kb = r >> 5, nb = r & 31; I.src = A.in[6] + (size_t)kb * 64 * 1024 + 32 * nb; I.ld = 1024; I.dst = WOUT + (size_t)(32 * nb) * 1024 + kb * 64; return I; } r -= I_OUT;
    if (r < I_PW1) { const int kb = r >> 6, nb = r & 63, d0 = 32 * nb; I.src = A.in[7] + (size_t)kb * 64 * 2048 + glu_src_col(d0); I.ld = 2048; I.dst = PW1 + (size_t)d0 * 1024 + kb * 64; return I; } r -= I_PW1;
    if (r < I_PW2) { const int kb = r >> 5, nb = r & 31; I.src = A.in[12] + (size_t)kb * 64 * 1024 + 32 * nb; I.ld = 1024; I.dst = PW2 + (size_t)(32 * nb) * 1024 + kb * 64; return I; } r -= I_PW2;
    if (r < I_UP) { const int le = r >> 10, rr = r & 1023, kb = rr >> 6, nb = rr & 63, d0 = 32 * nb;
        I.src = A.in[15] + (size_t)le * 1024 * 2048 + (size_t)kb * 64 * 2048 + glu_src_col(d0); I.ld = 2048;
        I.fp8 = 1; I.scale = (le >> 5) ? wsc[2] : wsc[0]; I.dst = (bf16*)((unsigned char*)UP + (size_t)le * 2048 * 1024 + (size_t)d0 * 1024 + kb * 64); return I; } r -= I_UP;
    { const int le = r >> 9, rr = r & 511, kb = rr >> 5, nb = rr & 31;
        I.src = A.in[17] + (size_t)le * 1024 * 1024 + (size_t)kb * 64 * 1024 + 32 * nb; I.ld = 1024;
        I.fp8 = 1; I.scale = (le >> 5) ? wsc[3] : wsc[1]; I.dst = (bf16*)((unsigned char*)DN + (size_t)le * 1024 * 1024 + (size_t)(32 * nb) * 1024 + kb * 64); return I; }
}
__device__ __forceinline__ void convert_items(Frame& F, const Args& A, int first, int last, int w0, int nw, const float (&wsc)[4]) {
    LAS float* scr = (LAS float*)(F.lds + F.wave * 17408); LAS float* scr2 = scr + 2176;
    int it = first + w0; if (it >= last) return;
    f32x4 ta[8], tb[8];
    TrItem a = tr_decode(F, A, it, wsc), b = a; tr_load(a, F.lane, ta);
    for (;;) {
        const int itb = it + nw; const bool hb = itb < last;
        b = tr_decode(F, A, hb ? itb : it, wsc); tr_load(b, F.lane, tb);
        tr_store(a, ta, scr, F.lane);
        if (!hb) break;
        const int ita = itb + nw; const bool ha = ita < last;
        a = tr_decode(F, A, ha ? ita : itb, wsc); tr_load(a, F.lane, ta);
        tr_store(b, tb, scr2, F.lane);
        if (!ha) break;
        it = ita;
    }
}

constexpr int XT_UP = 64 * 128, XT_DN = 64 * 64, XT_ALL = XT_UP + XT_DN;
struct XTask { const float* lsrc; unsigned char* dst; int N; float scale; };
__device__ __forceinline__ int xt_task(int q) { return q < 4096 ? q : (q < 6144 ? XT_UP + (q - 4096) : (q < 10240 ? 4096 + (q - 6144) : q)); }
__device__ __forceinline__ XTask xt_setup(Frame& F, const Args& A, int t, float sc_up0, float sc_dn0, float sc_up1, float sc_dn1) {
    XTask X; const float* src; const int r2 = F.lane >> 5, c = F.lane & 31;
    if (t < XT_UP) { const int le = t >> 7, r = t & 127, ks = r >> 4, nb = r & 15, c0 = nb * 128; X.N = 2048; X.scale = (le >> 5) ? sc_up1 : sc_up0;
        const int d0 = (c0 < 1024) ? 2 * c0 : 2 * (c0 - 1024) + 128;
        src = A.in[15] + (size_t)le * 1024 * 2048 + (size_t)(ks * 128) * 2048 + c0;
        X.dst = (unsigned char*)(F.ws + WS_UP) + (size_t)le * 2048 * 1024 + (size_t)d0 * 1024 + ks * 128; }
    else { const int tt = t - XT_UP, le = tt >> 6, r = tt & 63, ks = r >> 3, nb = r & 7; X.N = 1024; X.scale = (le >> 5) ? sc_dn1 : sc_dn0;
        src = A.in[17] + (size_t)le * 1024 * 1024 + (size_t)(ks * 128) * 1024 + nb * 128;
        X.dst = (unsigned char*)(F.ws + WS_DN) + (size_t)le * 1024 * 1024 + (size_t)(nb * 128) * 1024 + ks * 128; }
    X.lsrc = src + (size_t)(64 * r2) * X.N + 4 * c;
    return X;
}

__device__ __forceinline__ float sample_scale(const float* w, int lane) {
    float a = 0.f;
#pragma unroll 4
    for (int i = 0; i < 16; ++i) { const f32x4 v = *(const GAS f32x4*)(w + 4 * lane + 256 * i); a = fmaxf(a, fmaxf(fmaxf(fabsf(v[0]), fabsf(v[1])), fmaxf(fabsf(v[2]), fabsf(v[3])))); }
    a = wave_max(a); return (a > 0.f) ? ldexpf(1.0f, 4 - ilogbf(a)) : 1.0f;
}
constexpr int NSMALL = (I_PW1 + I_PW2) / Q_CHUNK;
#ifndef MK_XT_DEFER
#define MK_XT_DEFER 5200
#endif
constexpr int XT_DEFER = MK_XT_DEFER;
static_assert(XT_DEFER >= 0 && XT_DEFER <= 6144, "only layer-1 tasks can be deferred");
static_assert(MK_P0_ITEMS == 0 && (I_PW1 + I_PW2) % Q_CHUNK == 0, "queue layout");
__device__ __forceinline__ void convert_queue(Frame& F, const Args& A, int qword, int qbase, int QEND) {
    unsigned* qhead = (unsigned*)(F.ws + WS_CTL) + CW_QUEUE + 16 * qword;
    float wsc[4];
#pragma unroll
    for (int i = 0; i < 4; ++i) wsc[i] = ((const float*)(F.ws + WS_WSC))[i];
    int pos;
    for (;;) { unsigned pos_ = 0u; if (F.lane == 0) pos_ = __hip_atomic_fetch_add(qhead, 1u, __ATOMIC_RELAXED, __HIP_MEMORY_SCOPE_AGENT);
        pos = qbase + (int)__builtin_amdgcn_readfirstlane(pos_); if (pos >= NSMALL || pos >= QEND) break;
        convert_items(F, A, I_EARLY + pos * Q_CHUNK, I_EARLY + (pos + 1) * Q_CHUNK, 0, 1, wsc); }
    if (pos >= QEND) return;
    const int lane = F.lane, r2 = lane >> 5, c = lane & 31;
    LAS unsigned char* tile = F.lds + F.wave * 17408;
    f32x4 va[16], vb[16];
#define XT_LOAD(v_, X_, st_) do { _Pragma("unroll") for (int i_ = 0; i_ < 16; ++i_) v_[i_] = __builtin_nontemporal_load((const GAS f32x4*)(X_.lsrc + (size_t)((st_) * 16 + i_) * X_.N)); } while (0)
#define XT_PUT(v_, X_, st_) do { const float sc_ = X_.scale; _Pragma("unroll") for (int j_ = 0; j_ < 4; ++j_) { v4u o_; \
        o_.x = pk4_fp8(v_[0][j_] * sc_, v_[1][j_] * sc_, v_[2][j_] * sc_, v_[3][j_] * sc_); o_.y = pk4_fp8(v_[4][j_] * sc_, v_[5][j_] * sc_, v_[6][j_] * sc_, v_[7][j_] * sc_); \
        o_.z = pk4_fp8(v_[8][j_] * sc_, v_[9][j_] * sc_, v_[10][j_] * sc_, v_[11][j_] * sc_); o_.w = pk4_fp8(v_[12][j_] * sc_, v_[13][j_] * sc_, v_[14][j_] * sc_, v_[15][j_] * sc_); \
        *(LAS v4u*)(tile + (4 * c + j_) * 128 + (((4 * r2 + (st_)) ^ (c & 7)) << 4)) = o_; } } while (0)
    XTask cur = xt_setup(F, A, xt_task(pos - NSMALL), wsc[0], wsc[1], wsc[2], wsc[3]);
    XT_LOAD(va, cur, 0); XT_LOAD(vb, cur, 1);
    for (;;) {
        unsigned np_ = (unsigned)QEND; if (lane == 0) np_ = (unsigned)qbase + __hip_atomic_fetch_add(qhead, 1u, __ATOMIC_RELAXED, __HIP_MEMORY_SCOPE_AGENT);
        XT_PUT(va, cur, 0); XT_LOAD(va, cur, 2); XT_PUT(vb, cur, 1); XT_LOAD(vb, cur, 3); XT_PUT(va, cur, 2); XT_PUT(vb, cur, 3);
        const int npos = (int)__builtin_amdgcn_readfirstlane(np_); const bool has_next = npos < QEND;
        XTask nxt = cur;
        if (has_next) { nxt = xt_setup(F, A, xt_task(npos - NSMALL), wsc[0], wsc[1], wsc[2], wsc[3]); XT_LOAD(va, nxt, 0); XT_LOAD(vb, nxt, 1); }
        LDS_WAIT(); asm volatile("" ::: "memory");
#pragma unroll
        for (int i = 0; i < 16; ++i) { const int n = 8 * i + (lane >> 3), ch = lane & 7;
            const v4u w_ = *(const LAS v4u*)(tile + n * 128 + ((ch ^ ((n >> 2) & 7)) << 4));
            __builtin_nontemporal_store(w_, (GAS v4u*)(cur.dst + (size_t)n * 1024 + ch * 16)); }
        LDS_WAIT(); asm volatile("" ::: "memory");
        if (!has_next) break;
        cur = nxt; pos = npos;
    }
#undef XT_LOAD
#undef XT_PUT
}
__device__ __forceinline__ void p0_prologue(Frame& F, const Args& A) {
    const int gw = F.vcu * NWAVES + F.wave, NGW = F.G * NWAVES;
    for (int le = gw; le < 64; le += NGW) { const int l = le >> 5, e = le & 31; const float* rw = A.in[13] + (size_t)l * 1024 * 32; const float* lg = A.in[19] + (size_t)(l * 2) * D; const float* lb = A.in[20] + (size_t)(l * 2) * D;
        bf16* RWH = (bf16*)(F.ws + WS_RWH) + (size_t)le * 1024; bf16* RWL = (bf16*)(F.ws + WS_RWL) + (size_t)le * 1024; float sG = 0.f, sB = 0.f;
        for (int i = 0; i < 16; ++i) { const int d = F.lane + 64 * i; const float w0 = rw[d * 32 + e]; const float wv = lg[d] * w0; const unsigned hi = f2bf(wv); const unsigned lo = f2bf(wv - bf1((unsigned short)hi));
            RWH[d] = (unsigned short)hi; RWL[d] = (unsigned short)lo; sG += wv; sB += lb[d] * w0; }
        sG = wave_sum(sG); sB = wave_sum(sB);
        if (F.lane == 0) { float* RGB = (float*)(F.ws + WS_RGB); RGB[l * 64 + e] = sG; RGB[l * 64 + 32 + e] = sB + A.in[14][l * 32 + e]; } }
    static_assert(MK_P0_ITEMS <= I_PW1 + I_PW2 + 32 * 1024, "P0 may only convert layer-0 up-projection weights among the expert weights");
    if (gw >= 64 && gw < 68) { const int l = (gw - 64) >> 1, dn = (gw - 64) & 1; const float sc = sample_scale(dn ? A.in[17] + (size_t)l * 32 * 1024 * 1024 : A.in[15] + (size_t)l * 32 * 1024 * 2048, F.lane);
        if (F.lane == 0) ((float*)(F.ws + WS_WSC))[l * 2 + dn] = sc; }
    { const float w0s = sample_scale(A.in[15], F.lane); const float wsc[4] = {w0s, 0.f, 0.f, 0.f};
      convert_items(F, A, 0, I_P0, gw, NGW, wsc); }
    __syncthreads();
    LAS float* Wg = (LAS float*)F.lds;
    for (int idx = F.tid; idx < 8192; idx += NWAVES * 64) { const int k = idx >> 3, g = idx & 7; Wg[g * 1024 + k] = A.in[1][(size_t)k * 3080 + 1536 + g]; }
    __syncthreads();
    bf16* XB = (bf16*)(F.ws + WS_ABF); float* GATES = (float*)(F.ws + WS_GATES);
    const float bias_l = F.lane < 4 ? A.in[2][F.lane & 3] : A.in[3][F.lane & 3];
    f32x4 vn[4];
    if (gw < T) { const GAS f32x4* xr = (const GAS f32x4*)(A.in[0] + (size_t)gw * D) + F.lane;
#pragma unroll
        for (int j = 0; j < 4; ++j) vn[j] = xr[64 * j]; }
    for (int m = gw; m < T; m += NGW) {
        f32x4 v[4];
#pragma unroll
        for (int j = 0; j < 4; ++j) v[j] = vn[j];
        if (m + NGW < T) { const GAS f32x4* xr = (const GAS f32x4*)(A.in[0] + (size_t)(m + NGW) * D) + F.lane;
#pragma unroll
            for (int j = 0; j < 4; ++j) vn[j] = xr[64 * j]; }
        GAS v2u* o8 = (GAS v2u*)(XB + (size_t)m * D) + F.lane;
#pragma unroll
        for (int j = 0; j < 4; ++j) { v2u w; w.x = cvt_pk_bf16(v[j][0], v[j][1]); w.y = cvt_pk_bf16(v[j][2], v[j][3]); o8[64 * j] = w; }
        float mine = 0.f;
#pragma unroll
        for (int g = 0; g < 8; ++g) { float s = 0.f;
#pragma unroll
            for (int j = 0; j < 4; ++j) { const f32x4 w = *(const LAS f32x4*)(Wg + g * 1024 + 4 * F.lane + 256 * j); s += (v[j][0] * w[0] + v[j][1] * w[1]) + (v[j][2] * w[2] + v[j][3] * w[3]); }
            s = wave_sum(s); mine = (F.lane == g) ? s : mine; }
        if (F.lane < 8) { float val = mine + bias_l; if (F.lane >= 4) val = fminf(val, 0.f) - log1pf(__expf(-fabsf(val))); GATES[(size_t)m * 8 + F.lane] = val; }
    }
}

#define DPPF(old_, src_, ctrl_, rmask_) __builtin_bit_cast(float, __builtin_amdgcn_update_dpp(__builtin_bit_cast(int, (float)(old_)), __builtin_bit_cast(int, (float)(src_)), (ctrl_), (rmask_), 0xf, false))
__device__ __forceinline__ float row16_sum(float x) { x += DPPF(0.f, x, 0x128, 0xf); x += DPPF(0.f, x, 0x124, 0xf); x += DPPF(0.f, x, 0x122, 0xf); x += DPPF(0.f, x, 0x121, 0xf); return x; }
__device__ __forceinline__ float scan_add64(float x) { x += DPPF(0.f, x, 0x111, 0xf); x += DPPF(0.f, x, 0x112, 0xf); x += DPPF(0.f, x, 0x114, 0xf); x += DPPF(0.f, x, 0x118, 0xf);
    x += DPPF(0.f, x, 0x142, 0xa); x += DPPF(0.f, x, 0x143, 0xc); return x; }
__device__ __forceinline__ float scan_max64(float x) { const float ni = -INFINITY;
    x = fmaxf(x, DPPF(ni, x, 0x111, 0xf)); x = fmaxf(x, DPPF(ni, x, 0x112, 0xf)); x = fmaxf(x, DPPF(ni, x, 0x114, 0xf)); x = fmaxf(x, DPPF(ni, x, 0x118, 0xf));
    x = fmaxf(x, DPPF(ni, x, 0x142, 0xa)); x = fmaxf(x, DPPF(ni, x, 0x143, 0xc)); return x; }
__device__ __forceinline__ float lane63(float x) { return __builtin_bit_cast(float, __builtin_amdgcn_readlane(__builtin_bit_cast(int, x), 63)); }
typedef short v4i16 __attribute__((ext_vector_type(4)));
__device__ __forceinline__ bf16x8 tr_frag(const LAS unsigned char* base, int pitch, int k0, int col0, int fr) {
    const LAS unsigned char* a = base + (k0 + (fr >> 2)) * pitch + (col0 + 4 * (fr & 3)) * 2;
    const v4i16 lo = __builtin_amdgcn_ds_read_tr16_b64_v4i16((LAS v4i16*)a), hi = __builtin_amdgcn_ds_read_tr16_b64_v4i16((LAS v4i16*)(a + 4 * pitch));
    return __builtin_shufflevector(lo, hi, 0, 1, 2, 3, 4, 5, 6, 7);
}
__device__ __forceinline__ int swz16(int r, int c) { return r * 144 + ((((c >> 3) ^ ((r >> 3) & 7))) << 4) + (c & 7) * 2; }
__device__ __forceinline__ void mlstm_item(Frame& F, const Args& A, int item2) {
    const int item = item2 >> 1, T0 = 32 * (item2 & 1);
    const int b = item >> 2, h = item & 3, tid = F.tid, lane = F.lane, w = F.wave;
    LAS unsigned char* L = F.lds;
    constexpr int P = 144, PO = 272;
    constexpr int QS = 0, KS = QS + 64 * P, VT = KS + 64 * P, KW = VT + 64 * PO, CT = KW + 64 * P, SS = CT + 64 * PO, OS = SS + 64 * P, HS = OS + 64 * PO, FA = HS + 64 * PO;
    LAS float* fa = (LAS float*)(L + FA);
    constexpr int BV = 0, UV = 64, MT = 128, WI = 192, WL = 256, EI = 320, NP = 384, QNP = 448, RS = 960, HSUM = 1216, HSQ = 1344, SCAL = 1472;
    static_assert(FA + 1480 * 4 <= RING_BYTES, "mlstm LDS");
    const bf16* Z = (const bf16*)(F.ws + WS_Z); const float* GATES = (const float*)(F.ws + WS_GATES); bf16* HCAT = (bf16*)(F.ws + WS_HCAT);
    int fr_ = lane & 15, fq_ = lane >> 4; const int fr = lane & 15;
    for (int i = tid; i < 64 * PO / 4; i += 512) ((LAS unsigned*)(L + CT))[i] = 0u;
    if (tid < 64) fa[NP + tid] = 0.f;
    f32x4 accC[4];
#pragma unroll
    for (int j = 0; j < 4; ++j) accC[j] = (f32x4){0.f, 0.f, 0.f, 0.f};
    float m_prev = 0.f;
    float gain[2];
#pragma unroll
    for (int j = 0; j < 2; ++j) gain[j] = A.in[5][h * 128 + 16 * ((w >> 1) * 2 + j) + fr];
    int srow_ = tid >> 3, spc_ = tid & 7;
    int vrow0_ = tid >> 4, vpc_ = tid & 15;
    const int srow = tid >> 3, spc = tid & 7, vrow0 = tid >> 4, vpc = tid & 15;
    struct StageRegs { v4u q, k, v[2], o; float ig, lf; };
    StageRegs sA, sB; sA.ig = sA.lf = sB.ig = sB.lf = 0.f; sA.q = sB.q = (v4u){0u, 0u, 0u, 0u};
    const size_t zb = (size_t)(b * SEQ) * NZ;
#define MLSTM_LOAD(RS, c) do { const size_t t0 = (size_t)(c) * 64; \
        if (tid < 256) RS.q = *(const GAS v4u*)(Z + zb + (t0 + T0 + srow) * NZ + ZQ + h * 64 + spc * 8); \
        RS.k = *(const GAS v4u*)(Z + zb + (t0 + srow) * NZ + ZK + h * 64 + spc * 8); \
        _Pragma("unroll") for (int i = 0; i < 2; ++i) RS.v[i] = *(const GAS v4u*)(Z + zb + (t0 + vrow0 + 32 * i) * NZ + ZV + h * 128 + vpc * 8); \
        RS.o = *(const GAS v4u*)(Z + zb + (t0 + T0 + vrow0) * NZ + ZO + h * 128 + vpc * 8); \
        if (tid < 64) { RS.ig = GATES[((size_t)(b * SEQ) + t0 + tid) * 8 + h]; RS.lf = GATES[((size_t)(b * SEQ) + t0 + tid) * 8 + 4 + h]; } } while (0)
#define MLSTM_SCALARS(RS) do { if (w == 0) { \
            const float bcum = scan_add64(RS.lf); \
            const float g_ = lane63(bcum); const float u_ = RS.ig - bcum; const float cm = scan_max64(u_); \
            const float a_ = g_ + u_, amax = lane63(scan_max64(a_)); const float m_new = fmaxf(g_ + m_prev, amax); const float mt_ = bcum + fmaxf(m_prev, cm); \
            fa[BV + lane] = bcum; fa[UV + lane] = u_; fa[MT + lane] = mt_; fa[WI + lane] = __expf(bcum + m_prev - mt_); fa[WL + lane] = __expf(a_ - m_new); fa[EI + lane] = __expf(-mt_); \
            if (lane == 0) fa[SCAL] = __expf(g_ + m_prev - m_new); \
            m_prev = m_new; } } while (0)
    MLSTM_LOAD(sA, 0); MLSTM_LOAD(sB, 1);
    MLSTM_SCALARS(sA);
    __syncthreads();
    auto chunk = [&](StageRegs& RSC, StageRegs& RSN, const int cc) __attribute__((always_inline)) {
        asm volatile("" : "+v"(fr_), "+v"(fq_), "+v"(srow_), "+v"(spc_), "+v"(vrow0_), "+v"(vpc_));
        const int fr = fr_, fq = fq_, srow = srow_, spc = spc_, vrow0 = vrow0_, vpc = vpc_;
        if (tid < 256) *(LAS v4u*)(L + QS + srow * P + spc * 16) = RSC.q;
        *(LAS v4u*)(L + KS + srow * P + spc * 16) = RSC.k;
        *(LAS v4u*)(L + OS + vrow0 * PO + vpc * 16) = RSC.o;
#pragma unroll
        for (int i = 0; i < 2; ++i) *(LAS v4u*)(L + VT + (vrow0 + 32 * i) * PO + vpc * 16) = RSC.v[i];
        if (cc + 2 < 32) MLSTM_LOAD(RSC, cc + 2);
        LBAR();
        { const v4u kk = *(const LAS v4u*)(L + KS + srow * P + spc * 16); const float wl = fa[WL + srow]; v4u kw;
          kw.x = cvt_pk_bf16(bflo(kk.x) * wl, bfhi(kk.x) * wl); kw.y = cvt_pk_bf16(bflo(kk.y) * wl, bfhi(kk.y) * wl); kw.z = cvt_pk_bf16(bflo(kk.z) * wl, bfhi(kk.z) * wl); kw.w = cvt_pk_bf16(bflo(kk.w) * wl, bfhi(kk.w) * wl);
          *(LAS v4u*)(L + KW + srow * P + spc * 16) = kw; }
        { const int tr = w >> 2, tc = w & 3; f32x4 acc = (f32x4){0.f, 0.f, 0.f, 0.f};
#pragma unroll
          for (int ks = 0; ks < 2; ++ks) { const bf16x8 qa = *(const LAS bf16x8*)(L + QS + (16 * tr + fr) * P + ks * 64 + fq * 16); const bf16x8 kb = *(const LAS bf16x8*)(L + KS + (16 * tc + fr) * P + ks * 64 + fq * 16);
              acc = __builtin_amdgcn_mfma_f32_16x16x32_bf16(qa, kb, acc, 0, 0, 0); }
          const int s = 16 * tc + fr; const float us = fa[UV + s]; float rs[4];
#pragma unroll
          for (int r = 0; r < 4; ++r) { const int tl = 16 * tr + 4 * fq + r, t = T0 + tl; const float wgt = (s <= t) ? __expf(fa[BV + t] - fa[MT + t] + us) : 0.f; const float val = acc[r] * wgt;
              *(LAS unsigned short*)(L + SS + tl * P + s * 2) = (unsigned short)f2bf(val); rs[r] = val; }
#pragma unroll
          for (int r = 0; r < 4; ++r) rs[r] = row16_sum(rs[r]);
          if (fr == 0) {
#pragma unroll
              for (int r = 0; r < 4; ++r) fa[RS + tc * 64 + 16 * tr + 4 * fq + r] = rs[r]; } }
        if (tid < 256) { const int t = tid & 31, p = tid >> 5; const v4u qq = *(const LAS v4u*)(L + QS + t * P + p * 16); const unsigned ww[4] = {qq.x, qq.y, qq.z, qq.w}; float s = 0.f;
#pragma unroll
          for (int e = 0; e < 8; ++e) s += ((e & 1) ? bfhi(ww[e >> 1]) : bflo(ww[e >> 1])) * fa[NP + 8 * p + e];
          fa[QNP + p * 64 + t] = s; }
        LBAR();
        const int tr4 = w & 1, hf = w >> 1;
        f32x4 hv[2];
        { f32x4 ai_[2], as_[2];
#pragma unroll
          for (int j = 0; j < 2; ++j) { ai_[j] = (f32x4){0.f, 0.f, 0.f, 0.f}; as_[j] = (f32x4){0.f, 0.f, 0.f, 0.f}; }
#pragma unroll
          for (int ks = 0; ks < 2; ++ks) { const bf16x8 qa = *(const LAS bf16x8*)(L + QS + (16 * tr4 + fr) * P + ks * 64 + fq * 16); const bf16x8 sa = *(const LAS bf16x8*)(L + SS + (16 * tr4 + fr) * P + ks * 64 + fq * 16);
#pragma unroll
            for (int j = 0; j < 2; ++j) { const bf16x8 cb = tr_frag(L + CT, PO, ks * 32 + 8 * fq, 16 * (hf * 2 + j), fr); const bf16x8 vb = tr_frag(L + VT, PO, ks * 32 + 8 * fq, 16 * (hf * 2 + j), fr);
                ai_[j] = __builtin_amdgcn_mfma_f32_16x16x32_bf16(qa, cb, ai_[j], 0, 0, 0); as_[j] = __builtin_amdgcn_mfma_f32_16x16x32_bf16(sa, vb, as_[j], 0, 0, 0); } }
          float s1[4], s2[4];
#pragma unroll
          for (int r = 0; r < 4; ++r) { const int tl = 16 * tr4 + 4 * fq + r, t = T0 + tl; float qn = 0.f;
#pragma unroll
            for (int p = 0; p < 8; ++p) qn += fa[QNP + p * 64 + tl];
            const float wi = fa[WI + t]; const float den = wi * qn + ((fa[RS + tl] + fa[RS + 64 + tl]) + (fa[RS + 128 + tl] + fa[RS + 192 + tl]));
            const float inv = 1.0f / fmaxf(fabsf(den), fa[EI + t]); float a1 = 0.f, a2 = 0.f;
#pragma unroll
            for (int j = 0; j < 2; ++j) { const float x = (wi * ai_[j][r] + as_[j][r]) * inv; hv[j][r] = x; a1 += x; a2 += x * x; }
            s1[r] = a1; s2[r] = a2; }
#pragma unroll
          for (int r = 0; r < 4; ++r) { float x = s1[r], y = s2[r];
            s1[r] = row16_sum(x); s2[r] = row16_sum(y); }
          if (fr == 0) {
#pragma unroll
            for (int r = 0; r < 4; ++r) { fa[HSUM + hf * 32 + 16 * tr4 + 4 * fq + r] = s1[r]; fa[HSQ + hf * 32 + 16 * tr4 + 4 * fq + r] = s2[r]; } } }
        LBAR();
#pragma unroll
        for (int r = 0; r < 4; ++r) { const int tl = 16 * tr4 + 4 * fq + r; const float mean = ((fa[HSUM + tl] + fa[HSUM + 32 + tl]) + (fa[HSUM + 64 + tl] + fa[HSUM + 96 + tl])) * (1.0f / 128.0f);
            const float var = fmaxf(((fa[HSQ + tl] + fa[HSQ + 32 + tl]) + (fa[HSQ + 64 + tl] + fa[HSQ + 96 + tl])) * (1.0f / 128.0f) - mean * mean, 0.f);
            const float rstd = 1.0f / sqrtf(var + HEAD_EPS);
#pragma unroll
            for (int j = 0; j < 2; ++j) { const int dv = 16 * (hf * 2 + j) + fr; const float og = bf1(*(const LAS unsigned short*)(L + OS + tl * PO + dv * 2));
                *(LAS unsigned short*)(L + HS + tl * PO + dv * 2) = (unsigned short)f2bf((hv[j][r] - mean) * rstd * gain[j] * sigmoidf_(og)); } }
        const float decay = fa[SCAL];
#pragma unroll
        for (int j = 0; j < 4; ++j) accC[j] = accC[j] * decay;
#pragma unroll
        for (int ks = 0; ks < 2; ++ks) { const bf16x8 va = tr_frag(L + VT, PO, ks * 32 + 8 * fq, 16 * w, fr);
#pragma unroll
            for (int j = 0; j < 4; ++j) { const bf16x8 kb = tr_frag(L + KW, P, ks * 32 + 8 * fq, 16 * j, fr);
                accC[j] = __builtin_amdgcn_mfma_f32_16x16x32_bf16(va, kb, accC[j], 0, 0, 0); } }
        { const int dk = tid & 63; float s = 0.f;
#pragma unroll
          for (int e = 0; e < 8; ++e) s += fa[WL + 8 * w + e] * bf1(*(const LAS unsigned short*)(L + KS + (8 * w + e) * P + dk * 2));
          fa[QNP + w * 64 + dk] = s; }
        LBAR();
        float nnew = 0.f;
        if (tid < 64) { float s = 0.f;
#pragma unroll
            for (int p = 0; p < 8; ++p) s += fa[QNP + p * 64 + tid];
            nnew = decay * fa[NP + tid] + s; }
#pragma unroll
        for (int j = 0; j < 4; ++j) { v2u cw; cw.x = cvt_pk_bf16(accC[j][0], accC[j][1]); cw.y = cvt_pk_bf16(accC[j][2], accC[j][3]);
            *(LAS v2u*)(L + CT + (16 * j + fr) * PO + (16 * w + 4 * fq) * 2) = cw; }
        if (tid < 64) fa[NP + tid] = nnew;
        { const v4u hh = *(const LAS v4u*)(L + HS + vrow0 * PO + vpc * 16);
          *(GAS v4u*)(HCAT + ((size_t)(b * SEQ) + (size_t)(cc) * 64 + T0 + vrow0) * D + h * 128 + vpc * 8) = hh; }
        if (cc + 1 < 32) MLSTM_SCALARS(RSN);
    };
#pragma nounroll
    for (int c = 0; c < 32; c += 2) { chunk(sA, sB, c); chunk(sB, sA, c + 1); }
#undef MLSTM_LOAD
#undef MLSTM_SCALARS
    __syncthreads();
}
__device__ __forceinline__ void sconv_units(Frame& F, const Args& A, int first, int stride) {
    const bf16* Z = (const bf16*)(F.ws + WS_Z); bf16* HCAT = (bf16*)(F.ws + WS_HCAT);
    const int c0 = F.lane * 8;
    float w0[8], w1[8], w2[8];
#pragma unroll
    for (int e = 0; e < 8; ++e) { w0[e] = A.in[4][c0 + e]; w1[e] = A.in[4][512 + c0 + e]; w2[e] = A.in[4][1024 + c0 + e]; }
    for (int wu = first; wu < T / 32; wu += stride) {
        const int t0 = wu * 32; float p2[8], p1[8];
#pragma unroll
        for (int e = 0; e < 8; ++e) { p2[e] = 0.f; p1[e] = 0.f; }
        if ((t0 & (SEQ - 1)) != 0) {
#pragma unroll
            for (int back = 2; back >= 1; --back) { const v4u a = *(const GAS v4u*)(Z + (size_t)(t0 - back) * NZ + ZSC + c0), x = *(const GAS v4u*)(Z + (size_t)(t0 - back) * NZ + ZSX + c0);
                const unsigned aw[4] = {a.x, a.y, a.z, a.w}, xw[4] = {x.x, x.y, x.z, x.w};
#pragma unroll
                for (int e = 0; e < 8; ++e) { const float pv = ((e & 1) ? bfhi(aw[e >> 1]) : bflo(aw[e >> 1])) * ((e & 1) ? bfhi(xw[e >> 1]) : bflo(xw[e >> 1])); if (back == 2) p2[e] = pv; else p1[e] = pv; } } }
#pragma nounroll
        for (int i0 = 0; i0 < 32; i0 += 4) {
            v4u bq[4], a[4], x[4];
#pragma unroll
            for (int i = 0; i < 4; ++i) { const size_t t = (size_t)(t0 + i0 + i); bq[i] = *(const GAS v4u*)(Z + t * NZ + ZSB + c0); a[i] = *(const GAS v4u*)(Z + t * NZ + ZSC + c0); x[i] = *(const GAS v4u*)(Z + t * NZ + ZSX + c0); }
#pragma unroll
            for (int i = 0; i < 4; ++i) { const size_t t = (size_t)(t0 + i0 + i);
                const unsigned bw[4] = {bq[i].x, bq[i].y, bq[i].z, bq[i].w}, aw[4] = {a[i].x, a[i].y, a[i].z, a[i].w}, xw[4] = {x[i].x, x[i].y, x[i].z, x[i].w}; float y[8];
#pragma unroll
                for (int e = 0; e < 8; ++e) { const float pv = ((e & 1) ? bfhi(aw[e >> 1]) : bflo(aw[e >> 1])) * ((e & 1) ? bfhi(xw[e >> 1]) : bflo(xw[e >> 1]));
                    y[e] = ((e & 1) ? bfhi(bw[e >> 1]) : bflo(bw[e >> 1])) * (w0[e] * p2[e] + w1[e] * p1[e] + w2[e] * pv); p2[e] = p1[e]; p1[e] = pv; }
                v4u o; o.x = cvt_pk_bf16(y[0], y[1]); o.y = cvt_pk_bf16(y[2], y[3]); o.z = cvt_pk_bf16(y[4], y[5]); o.w = cvt_pk_bf16(y[6], y[7]);
                *(GAS v4u*)(HCAT + t * D + 512 + c0) = o; } }
    }
}
__device__ __forceinline__ void p2_mixer_ab(Frame& F, const Args& A) {
    const int nm = F.G < 128 ? F.G : 128; const int bx = (int)blockIdx.x;
    if (F.own) {
        const int x = bx & 7, j = (bx & 127) >> 3;
        if (bx < 128) mlstm_item(F, A, ((((2 * x + (j >> 3)) * 4 + ((j >> 1) & 3)) << 1) | (j & 1)));
        else sconv_units(F, A, 128 * x + j * NWAVES + F.wave, T / 32);
    } else {
    if (bx < nm) { for (int item2 = bx; item2 < 128; item2 += nm) mlstm_item(F, A, item2); }
    if (F.G > nm) { if (bx >= nm) sconv_units(F, A, (bx - nm) * NWAVES + F.wave, (F.G - nm) * NWAVES); }
    else sconv_units(F, A, bx * NWAVES + F.wave, F.G * NWAVES);
    }
    convert_queue(F, A, 0, 0, NSMALL + XT_ALL - (F.own ? XT_DEFER : 0));
}

__device__ __forceinline__ void p_router(Frame& F, const Args& A, int layer) {
    LAS unsigned char* L = F.lds;
    constexpr int PW = 2064, WHO = 0, WLO = 32 * PW, CNTO = 64 * PW;
    static_assert(CNTO + 128 <= LDSCTL_OFF, "router LDS");
    LAS int* cnt = (LAS int*)(L + CNTO);
    const bf16* RWH = (const bf16*)(F.ws + WS_RWH) + (size_t)layer * 32 * 1024; const bf16* RWL = (const bf16*)(F.ws + WS_RWL) + (size_t)layer * 32 * 1024; const float* RGB = (const float*)(F.ws + WS_RGB) + layer * 64;
    __syncthreads();
    for (int i = 0; i < 8; ++i) { const int idx = F.tid + 512 * i, e = idx >> 7, pc = idx & 127;
        *(LAS v4u*)(L + WHO + e * PW + pc * 16) = *(const GAS v4u*)(RWH + e * 1024 + pc * 8); *(LAS v4u*)(L + WLO + e * PW + pc * 16) = *(const GAS v4u*)(RWL + e * 1024 + pc * 8); }
    const int lane = F.lane, n = lane & 15, q = lane >> 4;
    const bf16* R = (const bf16*)(F.ws + WS_R); int* TOPI = (int*)(F.ws + WS_TOPI); float* TOPG = (float*)(F.ws + WS_TOPG); int* CNTT = (int*)(F.ws + WS_CNTT); float* STATS = (float*)(F.ws + WS_STATS);
    for (int tile = F.vcu; tile < T / 128; tile += F.G) {
        const size_t t = (size_t)tile * 128 + F.wave * 16 + n;
        const bf16* rowp = R + t * D + 8 * q;
        v4u h0[8], h1[8];
#pragma unroll
        for (int s = 0; s < 8; ++s) { h0[s] = *(const GAS v4u*)(rowp + 32 * s); h1[s] = *(const GAS v4u*)(rowp + 32 * (8 + s)); }
        __syncthreads();
        if (F.tid < 32) cnt[F.tid] = 0;
        __syncthreads();
        f32x4 acc[2]; acc[0] = (f32x4){0.f, 0.f, 0.f, 0.f}; acc[1] = (f32x4){0.f, 0.f, 0.f, 0.f};
        float s1 = 0.f, s2 = 0.f;
#define RT_STEPS(HB_, s0_) do { _Pragma("unroll") for (int s_ = 0; s_ < 8; ++s_) { const int s = (s0_) + s_; const v4u h = HB_[s_]; \
            const float x0 = bflo(h.x), x1 = bfhi(h.x), x2 = bflo(h.y), x3 = bfhi(h.y), x4 = bflo(h.z), x5 = bfhi(h.z), x6 = bflo(h.w), x7 = bfhi(h.w); \
            s1 += ((x0 + x1) + (x2 + x3)) + ((x4 + x5) + (x6 + x7)); \
            s2 += ((x0 * x0 + x1 * x1) + (x2 * x2 + x3 * x3)) + ((x4 * x4 + x5 * x5) + (x6 * x6 + x7 * x7)); \
            const bf16x8 bh = __builtin_bit_cast(bf16x8, h); \
            _Pragma("unroll") for (int et = 0; et < 2; ++et) { const bf16x8 wh = *(const LAS bf16x8*)(L + WHO + (16 * et + n) * PW + s * 64 + q * 16), wl = *(const LAS bf16x8*)(L + WLO + (16 * et + n) * PW + s * 64 + q * 16); \
                acc[et] = __builtin_amdgcn_mfma_f32_16x16x32_bf16(wh, bh, acc[et], 0, 0, 0); acc[et] = __builtin_amdgcn_mfma_f32_16x16x32_bf16(wl, bh, acc[et], 0, 0, 0); } \
            } } while (0)
        RT_STEPS(h0, 0);
#pragma unroll
        for (int s = 0; s < 8; ++s) h0[s] = *(const GAS v4u*)(rowp + 32 * (16 + s));
        RT_STEPS(h1, 8);
#pragma unroll
        for (int s = 0; s < 8; ++s) h1[s] = *(const GAS v4u*)(rowp + 32 * (24 + s));
        RT_STEPS(h0, 16); RT_STEPS(h1, 24);
#undef RT_STEPS
        float Gv[8], Bv[8];
#pragma unroll
        for (int m = 0; m < 8; ++m) { const int e = 16 * (m >> 2) + 4 * q + (m & 3); Gv[m] = RGB[e]; Bv[m] = RGB[32 + e]; }
        s1 += __shfl_xor(s1, 16); s1 += __shfl_xor(s1, 32); s2 += __shfl_xor(s2, 16); s2 += __shfl_xor(s2, 32);
        const float mean = s1 * (1.0f / D), var = fmaxf(s2 * (1.0f / D) - mean * mean, 0.f), rstd = 1.0f / sqrtf(var + LN_EPS);
        float val[8];
#pragma unroll
        for (int m = 0; m < 8; ++m) val[m] = rstd * (acc[m >> 2][m & 3] - mean * Gv[m]) + Bv[m];
        float tv[4]; int ti[4];
#pragma unroll
        for (int k = 0; k < 4; ++k) { float bv = val[0]; int bi = 4 * q;
#pragma unroll
            for (int m = 1; m < 8; ++m) { const int e = 16 * (m >> 2) + 4 * q + (m & 3); if (val[m] > bv) { bv = val[m]; bi = e; } }
#pragma unroll
            for (int o = 16; o < 64; o <<= 1) { const float ov = __shfl_xor(bv, o); const int oi = __shfl_xor(bi, o); const bool take = (ov > bv) || (ov == bv && oi < bi); bv = take ? ov : bv; bi = take ? oi : bi; }
            tv[k] = bv; ti[k] = bi;
#pragma unroll
            for (int m = 0; m < 8; ++m) { const int e = 16 * (m >> 2) + 4 * q + (m & 3); if (e == bi) val[m] = -INFINITY; } }
        const float e1 = __expf(tv[1] - tv[0]), e2 = __expf(tv[2] - tv[0]), e3 = __expf(tv[3] - tv[0]); const float inv = 1.0f / (1.0f + e1 + e2 + e3);
        if (q == 0) { *(GAS i32x4*)(TOPI + t * 4) = (i32x4){ti[0], ti[1], ti[2], ti[3]}; *(GAS f32x4*)(TOPG + t * 4) = (f32x4){inv, e1 * inv, e2 * inv, e3 * inv}; *(GAS f32x2*)(STATS + t * 2) = (f32x2){mean, rstd};
            __hip_atomic_fetch_add(&cnt[ti[0]], 1, __ATOMIC_RELAXED, __HIP_MEMORY_SCOPE_WORKGROUP); __hip_atomic_fetch_add(&cnt[ti[1]], 1, __ATOMIC_RELAXED, __HIP_MEMORY_SCOPE_WORKGROUP);
            __hip_atomic_fetch_add(&cnt[ti[2]], 1, __ATOMIC_RELAXED, __HIP_MEMORY_SCOPE_WORKGROUP); __hip_atomic_fetch_add(&cnt[ti[3]], 1, __ATOMIC_RELAXED, __HIP_MEMORY_SCOPE_WORKGROUP); }
        __syncthreads();
        if (F.tid < 32) CNTT[tile * 32 + F.tid] = cnt[F.tid];
    }
    __syncthreads();
}

__device__ __forceinline__ void p_slots(Frame& F, const Args& A, int layer) {
    LAS int* li = (LAS int*)F.lds;
    LAS int* redA = li;
    LAS int* redP = li + 512;
    LAS int* tot = li + 1024;
    LAS int* pre = li + 1056;
    LAS int* base = li + 1088;
    LAS int* wcn = li + 1152;
    const int* CNTT = (const int*)(F.ws + WS_CNTT); const int* TOPI = (const int*)(F.ws + WS_TOPI); int* SLOT = (int*)(F.ws + WS_SLOT); int* META = (int*)(F.ws + WS_META);
    const bf16* R = (const bf16*)(F.ws + WS_R); const float* STATS = (const float*)(F.ws + WS_STATS); unsigned char* X1B = (unsigned char*)(F.ws + WS_X1B); int* ROWTOK = (int*)(F.ws + WS_ROWTOK);
    const float* lg = A.in[19] + (size_t)(layer * 2) * D; const float* lb = A.in[20] + (size_t)(layer * 2) * D;
    f32x4 g4[4], b4[4];
#pragma unroll
    for (int j = 0; j < 4; ++j) { g4[j] = *(const GAS f32x4*)(lg + 4 * F.lane + 256 * j); b4[j] = *(const GAS f32x4*)(lb + 4 * F.lane + 256 * j); }
    const int tid = F.tid, lane = F.lane, e_ = tid & 31, part = tid >> 5;
    int cv[16];
#pragma unroll
    for (int k = 0; k < 16; ++k) cv[k] = CNTT[(part + 16 * k) * 32 + e_];
    { int sa = 0;
#pragma unroll
      for (int k = 0; k < 16; ++k) sa += cv[k];
      redA[part * 32 + e_] = sa; }
    __syncthreads();
    if (tid < 32) { int s = 0; for (int p = 0; p < 16; ++p) s += redA[p * 32 + tid]; tot[tid] = s; }
    __syncthreads();
    if (tid == 0) { int bsum = 0; for (int e = 0; e < 32; ++e) { base[e] = bsum; bsum += (tot[e] + 255) & ~255; } base[32] = bsum; }
    __syncthreads();
    for (int tile = F.vcu; tile < T / 128; tile += F.G) {
        v2u rw[16][4];
#pragma unroll
        for (int i = 0; i < 16; ++i) { const GAS v2u* rr = (const GAS v2u*)(R + ((size_t)tile * 128 + F.wave * 16 + i) * D) + lane;
#pragma unroll
            for (int j = 0; j < 4; ++j) rw[i][j] = rr[64 * j]; }
        const float mean_l = STATS[((size_t)tile * 128 + F.wave * 16 + (lane & 15)) * 2], rstd_l = STATS[((size_t)tile * 128 + F.wave * 16 + (lane & 15)) * 2 + 1];
        { int sp = 0;
#pragma unroll
          for (int k = 0; k < 16; ++k) sp += (part + 16 * k < tile) ? cv[k] : 0;
          redP[part * 32 + e_] = sp; }
        __syncthreads();
        if (tid < 32) { int s = 0; for (int p = 0; p < 16; ++p) s += redP[p * 32 + tid]; pre[tid] = s; }
        const int tok = tile * 128 + (tid >> 2); const int e = TOPI[(size_t)tile * 512 + tid];
        int rank = 0;
        for (int ee = 0; ee < 32; ++ee) { const unsigned long long mask = __ballot(e == ee); if (e == ee) rank = __builtin_amdgcn_mbcnt_hi((unsigned)(mask >> 32), __builtin_amdgcn_mbcnt_lo((unsigned)mask, 0u)); if (lane == 0) wcn[F.wave * 32 + ee] = __popcll(mask); }
        __syncthreads();
        for (int ww = 0; ww < F.wave; ++ww) rank += wcn[ww * 32 + e];
        const int slot = base[e] + pre[e] + rank;
        SLOT[(size_t)tile * 512 + tid] = slot; ROWTOK[slot] = tok;
#pragma unroll
        for (int i = 0; i < 16; ++i) { const size_t tk = (size_t)tile * 128 + F.wave * 16 + i;
            const float mean = __builtin_bit_cast(float, __builtin_amdgcn_readlane(__builtin_bit_cast(int, mean_l), i)), rstd = __builtin_bit_cast(float, __builtin_amdgcn_readlane(__builtin_bit_cast(int, rstd_l), i));
            GAS unsigned* dst = (GAS unsigned*)(X1B + tk * D) + lane;
#pragma unroll
            for (int j = 0; j < 4; ++j) { const v2u r2 = rw[i][j]; const f32x4 y = ((f32x4){bflo(r2.x), bfhi(r2.x), bflo(r2.y), bfhi(r2.y)} - mean) * rstd * g4[j] + b4[j]; dst[64 * j] = pk4_fp8(y[0], y[1], y[2], y[3]); } }
        __syncthreads();
    }
    for (int e = F.vcu; e < 32; e += F.G) { const int r0 = base[e] + tot[e], r1 = base[e + 1]; for (int i = r0 + tid; i < r1; i += 512) ROWTOK[i] = 0; }
    if (F.vcu == 0) { const int nMt = base[32] >> 8; if (tid == 0) META[0] = nMt;
        for (int gm = tid; gm < nMt; gm += 512) { int e = 0; for (int q = 0; q < 32; ++q) if (base[q] <= gm * 256 && gm * 256 < base[q + 1]) e = q; META[16 + gm] = e; } }
    __syncthreads();
}
__device__ __forceinline__ int load_texp(Frame& F) {
    const int* META = (const int*)(F.ws + WS_META); LAS int* texp = (LAS int*)(F.lds + TEXP_OFF);
    const int nMt = __builtin_amdgcn_readfirstlane(*(const GAS int*)META);
    for (int i = F.tid; i < 1024; i += 512) texp[i] = (i < nMt) ? *(const GAS int*)(META + 16 + i) : 0;
    __syncthreads();
    return nMt;
}
template <class Sched> __device__ __forceinline__ void load_rowtab(Frame& F, const Sched& S) {
    const int* ROWTOK = (const int*)(F.ws + WS_ROWTOK); LAS unsigned short* tab = (LAS unsigned short*)(F.lds + ROWTAB_OFF);
    const int half = F.tid >> 8, r = F.tid & 255; int val[10];
#pragma unroll
    for (int j = 0; j < 10; ++j) { pg8::Unit u; const bool ok = S.next(2 * j + half, u); val[j] = ok ? *(const GAS int*)(ROWTOK + u.pm * 256 + r) : 0; }
#pragma unroll
    for (int j = 0; j < 10; ++j) tab[(2 * j + half) * 256 + r] = (unsigned short)val[j];
    __syncthreads();
}

__device__ __forceinline__ void p_combine(Frame& F, const Args& A, int layer) {
    const bf16* R = (const bf16*)(F.ws + WS_R); const float* STATS = (const float*)(F.ws + WS_STATS); const unsigned char* YS = (const unsigned char*)(F.ws + WS_YS); const int* SLOT = (const int*)(F.ws + WS_SLOT); const float* TOPG = (const float*)(F.ws + WS_TOPG);
    bf16* OB = (bf16*)(F.ws + WS_ABF);
    const float* lg = A.in[19] + (size_t)(layer * 2 + 1) * D; const float* lb = A.in[20] + (size_t)(layer * 2 + 1) * D;
    const float* lg0 = A.in[19] + (size_t)(layer * 2) * D; const float* lb0 = A.in[20] + (size_t)(layer * 2) * D;
    const int lane = F.lane; f32x4 g4[4], b4[4], g0[4], b0[4];
#pragma unroll
    for (int j = 0; j < 4; ++j) { g4[j] = *(const GAS f32x4*)(lg + 4 * lane + 256 * j); b4[j] = *(const GAS f32x4*)(lb + 4 * lane + 256 * j); g0[j] = *(const GAS f32x4*)(lg0 + 4 * lane + 256 * j) * ALPHA; b0[j] = *(const GAS f32x4*)(lb0 + 4 * lane + 256 * j) * ALPHA; }
    const int gw = F.vcu * NWAVES + F.wave, NGW = F.G * NWAVES;
    struct CMeta { i32x4 sl; f32x4 gt; f32x2 st; };
    struct CData { unsigned yw[4][4]; v2u xr[4]; f32x4 gt; f32x2 st; };
#define CMB_META(M_, t_) do { M_.st = *(const GAS f32x2*)(STATS + (size_t)(t_) * 2); M_.sl = *(const GAS i32x4*)(SLOT + (size_t)(t_) * 4); M_.gt = *(const GAS f32x4*)(TOPG + (size_t)(t_) * 4); } while (0)
#define CMB_DATA(D_, M_, t_) do { const int sls_[4] = {M_.sl[0], M_.sl[1], M_.sl[2], M_.sl[3]}; D_.gt = M_.gt * (1.0f / 16.0f); D_.st = M_.st;     \
        _Pragma("unroll") for (int k = 0; k < 4; ++k) { const GAS unsigned* yr = (const GAS unsigned*)(YS + (size_t)sls_[k] * D) + lane; _Pragma("unroll") for (int j = 0; j < 4; ++j) D_.yw[k][j] = yr[64 * j]; } \
        { const GAS v2u* xr_ = (const GAS v2u*)(R + (size_t)(t_) * D) + lane; _Pragma("unroll") for (int j = 0; j < 4; ++j) D_.xr[j] = xr_[64 * j]; } } while (0)
#define CMB_COMPUTE(D_, t_) do { f32x4 v[4]; \
        _Pragma("unroll") for (int j = 0; j < 4; ++j) { const v2u rw = D_.xr[j]; v[j] = ((f32x4){bflo(rw.x), bfhi(rw.x), bflo(rw.y), bfhi(rw.y)} - D_.st[0]) * D_.st[1] * g0[j] + b0[j]; } \
        _Pragma("unroll") for (int k = 0; k < 4; ++k) { const float gk = D_.gt[k]; \
            _Pragma("unroll") for (int j = 0; j < 4; ++j) { const f32x2 lo = __builtin_amdgcn_cvt_pk_f32_fp8((int)D_.yw[k][j], false), hi = __builtin_amdgcn_cvt_pk_f32_fp8((int)D_.yw[k][j], true); \
                v[j][0] += gk * lo[0]; v[j][1] += gk * lo[1]; v[j][2] += gk * hi[0]; v[j][3] += gk * hi[1]; } } \
        float s = 0.f; \
        _Pragma("unroll") for (int j = 0; j < 4; ++j) s += (v[j][0] + v[j][1]) + (v[j][2] + v[j][3]); \
        const float mean = wave_sum(s) * (1.0f / D); float s2 = 0.f; \
        _Pragma("unroll") for (int j = 0; j < 4; ++j) { v[j] = v[j] - mean; s2 += (v[j][0] * v[j][0] + v[j][1] * v[j][1]) + (v[j][2] * v[j][2] + v[j][3] * v[j][3]); } \
        const float rstd = 1.0f / sqrtf(wave_sum(s2) * (1.0f / D) + LN_EPS); \
        if (layer == 0) { GAS v2u* xb = (GAS v2u*)(OB + (size_t)(t_) * D) + lane; \
            _Pragma("unroll") for (int j = 0; j < 4; ++j) { v[j] = v[j] * rstd * g4[j] + b4[j]; v2u wv; wv.x = cvt_pk_bf16(v[j][0], v[j][1]); wv.y = cvt_pk_bf16(v[j][2], v[j][3]); xb[64 * j] = wv; } } \
        else { GAS f32x4* xo = (GAS f32x4*)(A.out + (size_t)(t_) * D) + lane; \
            _Pragma("unroll") for (int j = 0; j < 4; ++j) { v[j] = v[j] * rstd * g4[j] + b4[j]; xo[64 * j] = v[j]; } } } while (0)
    const int tb = F.own ? 128 * F.vcu + 16 * F.wave : gw, ts = F.own ? 1 : NGW, tn = F.own ? 16 : (gw < T ? (T - 1 - gw) / NGW + 1 : 0);
    if (tn > 0) {
        CMeta m; CData dA, dB;
        CMB_META(m, tb); CMB_DATA(dA, m, tb);
        if (1 < tn) CMB_META(m, tb + ts);
        for (int i = 0; i < tn; i += 2) {
            const int t = tb + ts * i, t1 = t + ts, t2 = t + 2 * ts, t3 = t + 3 * ts;
            if (i + 1 < tn) { CMB_DATA(dB, m, t1); if (i + 2 < tn) CMB_META(m, t2); }
            CMB_COMPUTE(dA, t);
            if (i + 1 < tn) {
                if (i + 2 < tn) { CMB_DATA(dA, m, t2); if (i + 3 < tn) CMB_META(m, t3); }
                CMB_COMPUTE(dB, t1); }
        }
    }
#undef CMB_META
#undef CMB_DATA
#undef CMB_COMPUTE
}

__device__ __forceinline__ void p_conv31(Frame& F, const Args& A) {
    const bf16* U = (const bf16*)(F.ws + WS_U); bf16* V = (bf16*)(F.ws + WS_V);
    LAS unsigned char* L = F.lds;
    constexpr int RED = 62 * 2048, STAT = RED + 8 * 32 * 4;
    static_assert(STAT + 128 <= RING_BYTES, "conv31 LDS");
    LAS float* red = (LAS float*)(L + RED); LAS float* stat = (LAS float*)(L + STAT);
    const int tid = F.tid, lane = F.lane, ch = 2 * tid;
    f32x2 wt[31];
#pragma unroll
    for (int j = 0; j < 31; ++j) wt[j] = *(const GAS f32x2*)(A.in[8] + j * 1024 + ch);
    const f32x2 bdw = *(const GAS f32x2*)(A.in[9] + ch), lg = *(const GAS f32x2*)(A.in[10] + ch), lb = *(const GAS f32x2*)(A.in[11] + ch);
    v4u pre[16];
#define CONV_LOAD(unit_) do { const int bq_ = (unit_) >> 6, tk0_ = ((unit_) & 63) * 32; _Pragma("unroll") for (int i = 0; i < 16; ++i) { const int idx = tid + 512 * i, r = idx >> 7, pc = idx & 127, tok = tk0_ - 30 + r; \
        pre[i] = (v4u){0u, 0u, 0u, 0u}; if (idx < 62 * 128 && tok >= 0) pre[i] = *(const GAS v4u*)(U + ((size_t)bq_ * SEQ + tok) * D + pc * 8); } } while (0)
    const int u0 = F.own ? 4 * F.vcu : F.vcu, ustep = F.own ? 1 : F.G, uend = F.own ? 4 * F.vcu + 4 : T / 32;
    if (u0 < uend) CONV_LOAD(u0);
    for (int unit = u0; unit < uend; unit += ustep) {
        const int bq = unit >> 6, tok0 = (unit & 63) * 32; const size_t row0 = (size_t)bq * SEQ + tok0;
        __syncthreads();
#pragma unroll
        for (int i = 0; i < 16; ++i) { const int idx = tid + 512 * i; if (idx < 62 * 128) *(LAS v4u*)(L + (idx >> 7) * 2048 + (idx & 127) * 16) = pre[i]; }
        __syncthreads();
        if (unit + ustep < uend) CONV_LOAD(unit + ustep);
#pragma nounroll
        for (int half = 0; half < 2; ++half) {
            const LAS unsigned char* Lh = L + half * 16 * 2048 + tid * 4;
            f32x2 acc[16];
#pragma unroll
            for (int t = 0; t < 16; ++t) acc[t] = bdw;
#pragma unroll
            for (int r = 0; r < 46; ++r) { const unsigned uw = *(const LAS unsigned*)(Lh + r * 2048); const f32x2 uu = (f32x2){bflo(uw), bfhi(uw)};
#pragma unroll
                for (int t = 0; t < 16; ++t) { if (r - t >= 0 && r - t <= 30) acc[t] = acc[t] + wt[r - t] * uu; } }
            float v[32];
#pragma unroll
            for (int t = 0; t < 16; ++t) { v[t] = acc[t][0] + acc[t][1]; v[16 + t] = acc[t][0] * acc[t][0] + acc[t][1] * acc[t][1]; }
#pragma unroll
            for (int e = 0; e < 16; ++e) { const bool hi = (lane & 32) != 0; const float send = hi ? v[e] : v[16 + e], keep = hi ? v[16 + e] : v[e]; v[e] = keep + __shfl_xor(send, 32); }
#pragma unroll
            for (int e = 0; e < 8; ++e) { const bool hi = (lane & 16) != 0; const float send = hi ? v[e] : v[8 + e], keep = hi ? v[8 + e] : v[e]; v[e] = keep + __shfl_xor(send, 16); }
#pragma unroll
            for (int e = 0; e < 4; ++e) { const bool hi = (lane & 8) != 0; const float send = hi ? v[e] : v[4 + e], keep = hi ? v[4 + e] : v[e]; v[e] = keep + __shfl_xor(send, 8); }
#pragma unroll
            for (int e = 0; e < 2; ++e) { const bool hi = (lane & 4) != 0; const float send = hi ? v[e] : v[2 + e], keep = hi ? v[2 + e] : v[e]; v[e] = keep + __shfl_xor(send, 4); }
            { const bool hi = (lane & 2) != 0; const float send = hi ? v[0] : v[1], keep = hi ? v[1] : v[0]; v[0] = keep + __shfl_xor(send, 2); }
            v[0] += __shfl_xor(v[0], 1);
            if ((lane & 1) == 0) red[F.wave * 32 + (lane >> 1)] = v[0];
            LBAR();
            if (tid < 32) { float s = 0.f;
#pragma unroll
                for (int ww = 0; ww < 8; ++ww) s += red[ww * 32 + tid];
                const float other = __shfl_xor(s, 16);
                if (tid < 16) { const float mean = s * (1.0f / D); const float var = fmaxf(other * (1.0f / D) - mean * mean, 0.f); stat[tid] = mean; stat[16 + tid] = 1.0f / sqrtf(var + LN_EPS); } }
            LBAR();
#pragma unroll
            for (int t = 0; t < 16; ++t) { const float mean = stat[t], rstd = stat[16 + t]; const float y0 = (acc[t][0] - mean) * rstd * lg[0] + lb[0], y1 = (acc[t][1] - mean) * rstd * lg[1] + lb[1];
                *(GAS unsigned*)(V + (row0 + half * 16 + t) * D + ch) = cvt_pk_bf16(y0 * sigmoidf_(y0), y1 * sigmoidf_(y1)); }
        }
    }
    __syncthreads();
#undef CONV_LOAD
}

#define RUN_GEMM(EpiT, SchedT, S, E) pg8::gemm_phase<EpiT, SchedT, true>(F.lds, S, E)
#ifndef MK_KIND_MASK
#define MK_KIND_MASK 0x7ff
#endif
#define ON(kind) (((MK_KIND_MASK) >> (kind)) & 1)
#ifndef MK_DUP_MASK
#define MK_DUP_MASK 0
#endif
#define DUP(kind) (((MK_DUP_MASK) >> (kind)) & 1)
#define IN(k) (lo <= (k) && (k) < hi)
#define SEAM(k) do { if (IN(k) && IN((k) + 1)) xcd_barrier(bar); } while (0)
#define SEAM_L(k) do { if (IN(k) && IN((k) + 1)) { if (F.own) xcd_local_barrier(bar, (unsigned*)(F.ws + WS_CTL) + CW_LBAR); else xcd_barrier(bar); } } while (0)

template <int LAYER>
__device__ __forceinline__ void run_layer(Frame& F, const Args& args, const XcdBarrier& bar, int lo, int hi) {
    constexpr int pb = 1 + 8 * LAYER;
    const int c_id = (int)blockIdx.x;
    asm volatile("" : "+v"(F.tid));
    LAS int* texp = (LAS int*)(F.lds + TEXP_OFF);
    if constexpr (LAYER == 0) {
        if (ON(1) && IN(1)) { pg8::Order<false> S; S.init(T / 256, NZ / 256, F.G, c_id); S.A = (const char*)(F.ws + WS_ABF); S.Bt = (const char*)(F.ws + WS_WIN); S.bexp = 0; S.texp = nullptr;
            pg8::EpiZ E{(bf16*)(F.ws + WS_Z), NZ}; RUN_GEMM(pg8::EpiZ, pg8::Order<false>, S, E); } SEAM_L(1);
        if (ON(2) && IN(2)) { { p2_mixer_ab(F, args); } if (DUP(2)) { p2_mixer_ab(F, args); } } SEAM_L(2);
    } else {
        if (ON(3) && IN(9)) { pg8::Order<false> S; S.init(T / 256, 2048 / 256, F.G, c_id); S.A = (const char*)(F.ws + WS_ABF); S.Bt = (const char*)(F.ws + WS_PW1); S.bexp = 0; S.texp = nullptr;
            pg8::EpiGlu E{(bf16*)(F.ws + WS_U)}; RUN_GEMM(pg8::EpiGlu, pg8::Order<false>, S, E); if (DUP(3)) { RUN_GEMM(pg8::EpiGlu, pg8::Order<false>, S, E); } } SEAM_L(9);
        if (ON(4) && IN(10)) { { p_conv31(F, args); } if (DUP(4)) { p_conv31(F, args); } } SEAM_L(10);
    }
    if (ON(5) && IN(pb + 2)) { pg8::Order<false> S; S.init(T / 256, D / 256, F.G, c_id); S.A = (const char*)(F.ws + (LAYER == 0 ? WS_HCAT : WS_V)); S.Bt = (const char*)(F.ws + (LAYER == 0 ? WS_WOUT : WS_PW2)); S.bexp = 0; S.texp = nullptr;
        pg8::EpiRes<true> E{(const void*)(F.ws + WS_ABF), (bf16*)(F.ws + WS_R), ALPHA};
        RUN_GEMM(pg8::EpiRes<true>, pg8::Order<false>, S, E); if (DUP(5)) { RUN_GEMM(pg8::EpiRes<true>, pg8::Order<false>, S, E); } } SEAM_L(pb + 2);
    if (ON(6) && IN(pb + 3)) { { p_router(F, args, LAYER); } if (DUP(6)) { p_router(F, args, LAYER); } } SEAM(pb + 3);
    if (ON(7) && IN(pb + 4)) { { p_slots(F, args, LAYER); } if (DUP(7)) { p_slots(F, args, LAYER); } } SEAM(pb + 4);
    asm volatile("" : "+v"(F.tid));
    if (ON(8) && IN(pb + 5)) { const int nMt = load_texp(F); const float* WSC = (const float*)(F.ws + WS_WSC); unsigned* ctl = (unsigned*)(F.ws + WS_CTL);
        const int GD = (LAYER == 0 && F.own && XT_DEFER > 0) ? F.G / 8 : 0, G1 = F.G - GD;
        const pg8::Hand H{ctl + CW_UPCNT + LAYER * UPCNT_LAYER, ctl + CW_UPTOT + LAYER * 64, (unsigned)F.G};
        if (c_id < G1) {
        pg8::Order<true> S; S.init(nMt, 8, G1, c_id); S.tstep = (size_t)256 * 1024; S.A = (const char*)(F.ws + WS_X1B); S.Bt = (const char*)(F.ws + WS_UP) + (size_t)LAYER * 32 * 2048 * 1024; S.bexp = (size_t)2048 * 1024; S.texp = texp;
        load_rowtab(F, S);
        pg8::EpiSwiglu8 E{(unsigned char*)(F.ws + WS_ACT), args.in[16] + (size_t)LAYER * 32 * 2048, texp, 1.0f / WSC[LAYER * 2]};
        pg8::gemm_phase<pg8::EpiSwiglu8, pg8::Order<true>, true, true, true, 1>(F.lds, S, E, (const LAS unsigned short*)(F.lds + ROWTAB_OFF), H);
        __syncthreads(); if (F.tid == 0) __hip_atomic_fetch_add(H.tot, 1u, __ATOMIC_RELAXED, __HIP_MEMORY_SCOPE_AGENT); }
        else { if (F.tid == 0) __hip_atomic_fetch_add(H.tot, 1u, __ATOMIC_RELAXED, __HIP_MEMORY_SCOPE_AGENT);
            convert_queue(F, args, 1, NSMALL + XT_ALL - XT_DEFER, NSMALL + XT_ALL); __syncthreads(); } }
    if (ON(9) && IN(pb + 6)) { const int nMt = load_texp(F); const float* WSC = (const float*)(F.ws + WS_WSC); unsigned* ctl = (unsigned*)(F.ws + WS_CTL);
        pg8::Order<true> S; S.init(nMt, 4, F.G, c_id); S.tstep = (size_t)256 * 1024; S.A = (const char*)(F.ws + WS_ACT); S.Bt = (const char*)(F.ws + WS_DN) + (size_t)LAYER * 32 * 1024 * 1024; S.bexp = (size_t)1024 * 1024; S.texp = texp;
        pg8::EpiBiasG8 E{(unsigned char*)(F.ws + WS_YS), args.in[18] + (size_t)LAYER * 32 * 1024, texp, 0.25f / WSC[LAYER * 2 + 1]};
        const pg8::Hand H{ctl + CW_UPCNT + LAYER * UPCNT_LAYER, ctl + CW_UPTOT + LAYER * 64, (unsigned)F.G};
        pg8::gemm_phase<pg8::EpiBiasG8, pg8::Order<true>, true, true, false, 2>(F.lds, S, E, nullptr, H); } SEAM(pb + 6);
    if (ON(10) && IN(pb + 7)) { { p_combine(F, args, LAYER); } if (DUP(10)) { p_combine(F, args, LAYER); } } if constexpr (LAYER == 0) SEAM_L(pb + 7);
}

__global__ void __launch_bounds__(NWAVES * 64, 2) mk_fwd(Args args) {
    extern __shared__ __attribute__((aligned(16))) unsigned char lds[];
    Frame F;
    F.lds = (LAS unsigned char*)lds;
    F.tid = threadIdx.x; F.lane = (int)__builtin_amdgcn_mbcnt_hi(~0u, __builtin_amdgcn_mbcnt_lo(~0u, 0u));
    F.wave = __builtin_amdgcn_readfirstlane(F.tid >> 6);
    F.G = gridDim.x; { const int bx = blockIdx.x; F.vcu = (F.G % 8 == 0) ? (bx % 8) * (F.G / 8) + bx / 8 : bx; }
    F.ws = args.ws;
    for (int u = F.tid; u < (LDS_BYTES - LDSCTL_OFF) / 4; u += NWAVES * 64) ((LAS unsigned*)(F.lds + LDSCTL_OFF))[u] = 0u;
    __syncthreads();
    unsigned* ctl = (unsigned*)(F.ws + WS_CTL);
    XcdBarrier bar; bar.bar = ctl + CW_BAR; bar.x = 0; bar.st = nullptr;
#if !MK_PER_PHASE
    bar = xcd_barrier_post(ctl + CW_BAR, (volatile LAS unsigned*)(F.lds + MISC_OFF) + 8);
#endif
    const int lo = args.ph_lo, hi = args.ph_hi;
    F.own = false;
    if (F.tid == 0) atomicOr(&ctl[CW_MAPX + 64 * bar.x], 1u << (blockIdx.x & 7));
    if (ON(0) && IN(0)) { p0_prologue(F, args); if (DUP(0)) { p0_prologue(F, args); } } SEAM(0);
    if (IN(0) && IN(1)) { bool ok = (F.G == 256) && (bar.st[0] == 32u) && (bar.st[1] == 8u); unsigned seen = 0u;
#pragma unroll
        for (int j = 0; j < 16; ++j) { const unsigned m = xb_ld(&ctl[CW_MAPX + 64 * j]); if (m != 0u) { ok = ok && (__popc(m) == 1) && ((seen & m) == 0u) && (j < 8 ? true : true); seen |= m; } }
        F.own = ok && (seen == 0xffu); }
    run_layer<0>(F, args, bar, lo, hi);
    run_layer<1>(F, args, bar, lo, hi);
}
#undef IN
#undef SEAM

extern "C" void kernel_launch(void* const* d_in, const int* in_sizes, int n_in, void* d_out, int out_size, void* d_ws, size_t ws_size, hipStream_t stream) {
    static int grid = 0;
    if (grid == 0) {
        if (n_in != 21 || in_sizes[0] != T * D || out_size != T * D || ws_size < WS_END) { fprintf(stderr, "kernel_launch: unexpected shapes (n_in %d, in0 %d, out %d, ws %zu); nothing launched\n", n_in, n_in > 0 ? in_sizes[0] : -1, out_size, ws_size); grid = -1; return; }
        int dev = 0, cus = 0, per_cu = 0;
        if (hipGetDevice(&dev) != hipSuccess || hipDeviceGetAttribute(&cus, hipDeviceAttributeMultiprocessorCount, dev) != hipSuccess) { grid = -1; return; }
        if (hipFuncSetAttribute((const void*)mk_fwd, hipFuncAttributeMaxDynamicSharedMemorySize, LDS_BYTES) != hipSuccess) { fprintf(stderr, "kernel_launch: hipFuncSetAttribute failed\n"); grid = -1; return; }
        if (hipOccupancyMaxActiveBlocksPerMultiprocessor(&per_cu, (const void*)mk_fwd, NWAVES * 64, LDS_BYTES) != hipSuccess || per_cu < 1) { fprintf(stderr, "kernel_launch: occupancy query reports %d workgroups per CU\n", per_cu); }
        (void)hipGetLastError();
        grid = cus;
    }
    if (grid < 0) return;
    if (hipMemsetAsync((char*)d_ws + WS_CTL, 0, CTL_ZERO_BYTES, stream) != hipSuccess) return;
    Args a{};
    for (int i = 0; i < 21; ++i) a.in[i] = (const float*)d_in[i];
    a.out = (float*)d_out; a.ws = (unsigned char*)d_ws;
#if MK_PER_PHASE
    for (int p = 0; p < NPH; ++p) { a.ph_lo = p; a.ph_hi = p + 1; hipLaunchKernelGGL(mk_fwd, dim3(grid), dim3(NWAVES * 64), LDS_BYTES, stream, a); }
#else
    a.ph_lo = 0; a.ph_hi = NPH;
    hipLaunchKernelGGL(mk_fwd, dim3(grid), dim3(NWAVES * 64), LDS_BYTES, stream, a);
#endif
}
```
